# Optimizing an MI355X kernel written in HIP

```python
import math
import jax, jax.numpy as jnp
from jax import lax
import numpy as np

D_MODEL = 1024
BATCH = 2
SEQ = 8192
DEPTH = 4

GRID_W = 64
CTX_LEN = 256
N_MIXERS = 3
EPS = 1e-6

CHUNK = 128
SG_WIDTH = 2 * D_MODEL
SG_GROUPS = 8

HY_ORDER = 2
HY_SHORT = 3
HY_POS_EMB = 33
HY_FILTER_HIDDEN = 64
HY_TARGET = 1e-2
HY_FAST_DECAY_PCT = 0.3
HY_SLOW_DECAY_PCT = 1.5
HY_MAX_DECAY = math.log(HY_TARGET) / HY_FAST_DECAY_PCT
HY_MIN_DECAY = math.log(HY_TARGET) / HY_SLOW_DECAY_PCT

DA_HEADS = 8
DA_HEAD_DIM = D_MODEL // (2 * DA_HEADS)
DA_V_DIM = 2 * DA_HEAD_DIM
DA_QK = DA_HEADS * 2 * DA_HEAD_DIM
Q_BLOCK = 128
ROPE_HALF = DA_HEAD_DIM // 4
ROPE_BASE = 10000.0

N_EXPERTS = 16
EC_CAPACITY = 2
EXPERT_FF = 2 * D_MODEL

N_SG = (DEPTH + 2) // 3
N_HY = (DEPTH + 1) // 3
N_DA = DEPTH // 3

kernel_name = 'hybrid_diffusion_sg_hyena_diffattn_ecmoe'


def rms_norm(h, eps=EPS):
    hf = h.astype(jnp.float32)
    return (hf * lax.rsqrt(jnp.mean(hf * hf, axis=-1, keepdims=True) + eps)).astype(h.dtype)


def modulation(cond, w, b):
    m = jax.nn.silu(cond) @ w + b
    return jnp.split(m[..., None, :], 6, axis=-1)


def ada_norm(h, shift, scale):
    return rms_norm(h) * (1.0 + scale) + shift


def spatial_gating_mixer(h, w_in, b_in, v_gain, w_s, b_s, w_out, b_out):
    bsz, n, _ = h.shape
    zz = jax.nn.gelu(h @ w_in + b_in, approximate=False)
    u, v = jnp.split(zz, 2, axis=-1)
    v = rms_norm(v) * v_gain
    vb = v.reshape(bsz, n // CHUNK, CHUNK, SG_GROUPS, SG_WIDTH // SG_GROUPS)
    s = jnp.einsum('gpq,bnqgc->bnpgc', w_s, vb) + jnp.swapaxes(b_s, 0, 1)[:, :, None]
    return (u * s.reshape(bsz, n, SG_WIDTH)) @ w_out + b_out


def hyena_filter_spectra(n, w1, b1, w2, b2, w3, b3, freq, w_out):
    f32 = jnp.float32
    t = jnp.linspace(0.0, 1.0, n, dtype=f32)[:, None]
    bands = (HY_POS_EMB - 1) // 2
    f = jnp.linspace(1e-4, bands - 1, bands, dtype=f32)
    w = (2.0 * math.pi / n) * jnp.arange(n, dtype=f32)[:, None]
    z = jnp.concatenate([t, jnp.cos(f * w), -jnp.sin(f * w)], axis=-1)
    fr = freq.astype(f32)
    hid = jnp.sin(fr * (z @ w1.astype(f32) + b1.astype(f32)))
    hid = jnp.sin(fr * (hid @ w2.astype(f32) + b2.astype(f32)))
    hid = jnp.sin(fr * (hid @ w3.astype(f32) + b3.astype(f32)))
    h = (hid @ w_out.astype(f32)).reshape(n, HY_ORDER, 2, D_MODEL)
    deltas = jnp.abs(jnp.linspace(HY_MIN_DECAY, HY_MAX_DECAY, D_MODEL, dtype=f32))
    h = h * jnp.exp(-t * deltas)[:, None, None, :]
    full = jnp.concatenate([h[:, :, 0], jnp.zeros((1, HY_ORDER, D_MODEL), f32), h[:0:-1, :, 1]], axis=0)
    full = full * lax.rsqrt(jnp.sum(full * full, axis=0, keepdims=True) + EPS)
    return jnp.fft.rfft(full, axis=0)


def long_conv(z, spec):
    n = z.shape[1]
    return jnp.fft.irfft(jnp.fft.rfft(z, n=2 * n, axis=1) * spec, n=2 * n, axis=1)[:, :n]


def short_conv(u, w, b):
    n = u.shape[1]
    pad = HY_SHORT // 2
    up = jnp.pad(u, ((0, 0), (pad, pad), (0, 0)))
    out = up[:, 0:n] * w[0]
    for k in range(1, HY_SHORT):
        out = out + up[:, k:k + n] * w[k]
    return out + b


def hyena_mixer(h, w_in, b_in, conv_w, conv_b, f_w1, f_b1, f_w2, f_b2, f_w3, f_b3, f_freq, f_wout, skip, w_out, b_out):
    n = h.shape[1]
    spec = hyena_filter_spectra(n, f_w1, f_b1, f_w2, f_b2, f_w3, f_b3, f_freq, f_wout)
    u = short_conv(h @ w_in + b_in, conv_w, conv_b)
    v, x1, x2 = jnp.split(u, 3, axis=-1)
    z = v.astype(jnp.float32)
    for o, gate in enumerate((x1, x2)):
        z = gate.astype(jnp.float32) * (long_conv(z, spec[:, o]) + skip[o].astype(jnp.float32) * z)
    return z.astype(h.dtype) @ w_out + b_out


def axial_rope_tables(n):
    rows = n // GRID_W
    row = jnp.broadcast_to(jnp.arange(rows, dtype=jnp.float32)[:, None], (rows, GRID_W)).reshape(n)
    col = jnp.broadcast_to(jnp.arange(GRID_W, dtype=jnp.float32)[None, :], (rows, GRID_W)).reshape(n)
    inv = ROPE_BASE ** (-jnp.arange(ROPE_HALF, dtype=jnp.float32) / ROPE_HALF)
    ang = jnp.stack([row[:, None] * inv, col[:, None] * inv], axis=1)
    return jnp.cos(ang), jnp.sin(ang)


def apply_axial_rope(x, cos, sin):
    xr = x.reshape(*x.shape[:-1], 2, 2, ROPE_HALF)
    x1, x2 = xr[..., 0, :], xr[..., 1, :]
    c = cos.astype(x.dtype)[:, None, None]
    s = sin.astype(x.dtype)[:, None, None]
    return jnp.stack([x1 * c - x2 * s, x2 * c + x1 * s], axis=-2).reshape(x.shape)


def diff_attn_block(q, k, v, lam):
    s = jnp.einsum('bqhmd,bkhmd->bhmqk', q, k).astype(jnp.float32) * (DA_HEAD_DIM ** -0.5)
    p = jax.nn.softmax(s, axis=-1)
    a = p[:, :, 0] - lam * p[:, :, 1]
    return jnp.einsum('bhqk,bkhe->bqhe', a.astype(v.dtype), v)


def diff_attention(hx, hc, ctx_out, cos, sin, layer_idx, w_in, q_gain, k_gain, lam_q1, lam_k1, lam_q2, lam_k2, subln_gain, w_out):
    f32 = jnp.float32
    lam_init = 0.8 - 0.6 * math.exp(-0.3 * layer_idx)
    lam = (jnp.exp(jnp.sum(lam_q1.astype(f32) * lam_k1.astype(f32)))
           - jnp.exp(jnp.sum(lam_q2.astype(f32) * lam_k2.astype(f32))) + lam_init)

    def project(h):
        bsz, n, _ = h.shape
        q, k, v = jnp.split(h @ w_in, [DA_QK, 2 * DA_QK], axis=-1)
        q = rms_norm(q.reshape(bsz, n, DA_HEADS, 2, DA_HEAD_DIM)) * q_gain
        k = rms_norm(k.reshape(bsz, n, DA_HEADS, 2, DA_HEAD_DIM)) * k_gain
        return q, k, v.reshape(bsz, n, DA_HEADS, DA_V_DIM)

    def merge(o):
        bsz, n = o.shape[:2]
        o = rms_norm(o) * subln_gain * (1.0 - lam_init)
        return o.reshape(bsz, n, DA_HEADS * DA_V_DIM) @ w_out

    qx, kx, vx = project(hx)
    qx = apply_axial_rope(qx, cos, sin)
    kx = apply_axial_rope(kx, cos, sin)
    qc, kc, vc = project(hc)
    k_all = jnp.concatenate([kc, kx], axis=1)
    v_all = jnp.concatenate([vc, vx], axis=1)
    bsz, n = qx.shape[:2]
    qb = jnp.moveaxis(qx.reshape(bsz, n // Q_BLOCK, Q_BLOCK, DA_HEADS, 2, DA_HEAD_DIM), 1, 0)
    ox = lax.map(lambda qblk: diff_attn_block(qblk, k_all, v_all, lam), qb)
    ox = jnp.moveaxis(ox, 0, 1).reshape(bsz, n, DA_HEADS, DA_V_DIM)
    yx = merge(ox)
    yc = merge(diff_attn_block(qc, kc, vc, lam)) if ctx_out else None
    return yx, yc


def ec_moe(h, w_router, w_gate, w_up, w_down):
    bsz, n, d = h.shape
    cap = EC_CAPACITY * n // N_EXPERTS
    aff = jax.nn.softmax((h @ w_router).astype(jnp.float32), axis=-1)
    g, idx = lax.top_k(jnp.swapaxes(aff, 1, 2), cap)
    xs = jax.vmap(lambda hb, ib: hb[ib])(h, idx)
    a = jnp.einsum('becd,edf->becf', xs, w_gate)
    b = jnp.einsum('becd,edf->becf', xs, w_up)
    ye = jnp.einsum('becf,efd->becd', jax.nn.silu(a) * b, w_down) * g[..., None].astype(h.dtype)
    return jax.vmap(lambda yb, ib: jnp.zeros((n, d), h.dtype).at[ib.reshape(-1)].add(yb.reshape(-1, d)))(ye, idx)


def setup_inputs(seed: int = 0) -> dict:
    key = jax.random.key(seed)
    ks = iter(jax.random.split(key, 64))
    f32 = jnp.float32
    D = D_MODEL

    def nrm(shape, scale):
        return jax.random.normal(next(ks), shape, f32) * scale

    def gain(shape):
        return 1.0 + nrm(shape, 0.02)

    HID = HY_FILTER_HIDDEN
    return {
        'x': nrm((BATCH, SEQ, D), 1.0),
        'c': nrm((BATCH, D), 1.0),
        'ctx': nrm((BATCH, CTX_LEN, D), 1.0),
        'c_ctx': nrm((D,), 1.0),
        'ada_w': nrm((DEPTH, D, 6 * D), 0.5 * D ** -0.5),
        'ada_b': nrm((DEPTH, 6 * D), 0.02),
        'sg_w_in': nrm((N_SG, D, 2 * SG_WIDTH), D ** -0.5),
        'sg_b_in': nrm((N_SG, 2 * SG_WIDTH), 0.02),
        'sg_v_gain': gain((N_SG, SG_WIDTH)),
        'sg_w_s': nrm((N_SG, SG_GROUPS, CHUNK, CHUNK), CHUNK ** -0.5),
        'sg_b_s': gain((N_SG, SG_GROUPS, CHUNK)),
        'sg_w_out': nrm((N_SG, SG_WIDTH, D), SG_WIDTH ** -0.5),
        'sg_b_out': nrm((N_SG, D), 0.02),
        'hy_w_in': nrm((N_HY, D, 3 * D), D ** -0.5),
        'hy_b_in': nrm((N_HY, 3 * D), 0.02),
        'hy_conv_w': nrm((N_HY, HY_SHORT, 3 * D), HY_SHORT ** -0.5),
        'hy_conv_b': nrm((N_HY, 3 * D), 0.02),
        'hy_f_w1': nrm((N_HY, HY_POS_EMB, HID), HY_POS_EMB ** -0.5),
        'hy_f_b1': nrm((N_HY, HID), 0.02),
        'hy_f_w2': nrm((N_HY, HID, HID), HID ** -0.5),
        'hy_f_b2': nrm((N_HY, HID), 0.02),
        'hy_f_w3': nrm((N_HY, HID, HID), HID ** -0.5),
        'hy_f_b3': nrm((N_HY, HID), 0.02),
        'hy_f_freq': gain((N_HY, HID)),
        'hy_f_wout': nrm((N_HY, HID, HY_ORDER * 2 * D), HID ** -0.5),
        'hy_skip': nrm((N_HY, HY_ORDER, D), 0.5),
        'hy_w_out': nrm((N_HY, D, D), D ** -0.5),
        'hy_b_out': nrm((N_HY, D), 0.02),
        'da_w_in': nrm((N_DA, D, 2 * DA_QK + DA_HEADS * DA_V_DIM), D ** -0.5),
        'da_q_gain': gain((N_DA, DA_HEAD_DIM)),
        'da_k_gain': gain((N_DA, DA_HEAD_DIM)),
        'da_lam_q1': nrm((N_DA, DA_HEAD_DIM), 0.1),
        'da_lam_k1': nrm((N_DA, DA_HEAD_DIM), 0.1),
        'da_lam_q2': nrm((N_DA, DA_HEAD_DIM), 0.1),
        'da_lam_k2': nrm((N_DA, DA_HEAD_DIM), 0.1),
        'da_subln_gain': gain((N_DA, DA_V_DIM)),
        'da_w_out': nrm((N_DA, DA_HEADS * DA_V_DIM, D), (DA_HEADS * DA_V_DIM) ** -0.5),
        'moe_router': nrm((DEPTH, D, N_EXPERTS), D ** -0.5),
        'moe_w_gate': nrm((DEPTH, N_EXPERTS, D, EXPERT_FF), D ** -0.5),
        'moe_w_up': nrm((DEPTH, N_EXPERTS, D, EXPERT_FF), D ** -0.5),
        'moe_w_down': nrm((DEPTH, N_EXPERTS, EXPERT_FF, D), EXPERT_FF ** -0.5),
    }


def reference(x, c, ctx, c_ctx, ada_w, ada_b,
              sg_w_in, sg_b_in, sg_v_gain, sg_w_s, sg_b_s, sg_w_out, sg_b_out,
              hy_w_in, hy_b_in, hy_conv_w, hy_conv_b, hy_f_w1, hy_f_b1, hy_f_w2, hy_f_b2, hy_f_w3, hy_f_b3,
              hy_f_freq, hy_f_wout, hy_skip, hy_w_out, hy_b_out,
              da_w_in, da_q_gain, da_k_gain, da_lam_q1, da_lam_k1, da_lam_q2, da_lam_k2, da_subln_gain, da_w_out,
              moe_router, moe_w_gate, moe_w_up, moe_w_down):
    cos, sin = axial_rope_tables(x.shape[1])
    for i in range(DEPTH):
        kind = i % N_MIXERS
        j = i // N_MIXERS
        ctx_live = any(l % N_MIXERS == 2 for l in range(i + 1, DEPTH))
        sh1, sc1, g1, sh2, sc2, g2 = modulation(c, ada_w[i], ada_b[i])
        hx = ada_norm(x, sh1, sc1)
        hc = None
        if kind == 2 or ctx_live:
            csh1, csc1, cg1, csh2, csc2, cg2 = modulation(c_ctx, ada_w[i], ada_b[i])
            hc = ada_norm(ctx, csh1, csc1)
        yc = None
        if kind == 0:
            sg_args = (sg_w_in[j], sg_b_in[j], sg_v_gain[j], sg_w_s[j], sg_b_s[j], sg_w_out[j], sg_b_out[j])
            yx = spatial_gating_mixer(hx, *sg_args)
            if ctx_live:
                yc = spatial_gating_mixer(hc, *sg_args)
        elif kind == 1:
            hy_args = (hy_w_in[j], hy_b_in[j], hy_conv_w[j], hy_conv_b[j], hy_f_w1[j], hy_f_b1[j],
                       hy_f_w2[j], hy_f_b2[j], hy_f_w3[j], hy_f_b3[j], hy_f_freq[j], hy_f_wout[j],
                       hy_skip[j], hy_w_out[j], hy_b_out[j])
            yx = hyena_mixer(hx, *hy_args)
            if ctx_live:
                yc = hyena_mixer(hc, *hy_args)
        else:
            yx, yc = diff_attention(hx, hc, ctx_live, cos, sin, i, da_w_in[j], da_q_gain[j], da_k_gain[j],
                                    da_lam_q1[j], da_lam_k1[j], da_lam_q2[j], da_lam_k2[j],
                                    da_subln_gain[j], da_w_out[j])
        x = x + g1 * yx
        x = x + g2 * ec_moe(ada_norm(x, sh2, sc2), moe_router[i], moe_w_gate[i], moe_w_up[i], moe_w_down[i])
        if ctx_live:
            ctx = ctx + cg1 * yc
            ctx = ctx + cg2 * ec_moe(ada_norm(ctx, csh2, csc2), moe_router[i], moe_w_gate[i], moe_w_up[i], moe_w_down[i])
    return x
```

```cpp
#include <hip/hip_runtime.h>
#include <stdint.h>
#include <stdio.h>
#include <math.h>

#ifndef MK_LAUNCHES
#define MK_LAUNCHES 1
#endif

#define GAS __attribute__((address_space(1)))
#define LAS __attribute__((address_space(3)))
typedef unsigned short bf16_t;
typedef float f32x4 __attribute__((ext_vector_type(4)));
typedef float f32x2 __attribute__((ext_vector_type(2)));
typedef float f32x16 __attribute__((ext_vector_type(16)));
typedef unsigned u32x4 __attribute__((ext_vector_type(4)));
typedef unsigned u32x2 __attribute__((ext_vector_type(2)));
typedef short bf16x8 __attribute__((ext_vector_type(8)));
#define DI __device__ __forceinline__

DI unsigned pkbf(float lo, float hi) { unsigned r; asm volatile("v_cvt_pk_bf16_f32 %0, %1, %2" : "=v"(r) : "v"(lo), "v"(hi)); return r; }
DI float bflo(unsigned w) { return __uint_as_float(w << 16); }
DI float bfhi(unsigned w) { return __uint_as_float(w & 0xffff0000u); }
DI float bf1(bf16_t h) { return __uint_as_float(((unsigned)h) << 16); }
DI bf16_t f2bf1(float f) { return (bf16_t)(pkbf(f, 0.f) & 0xffffu); }
DI float wave_sum(float v) {
#pragma unroll
    for (int o = 1; o < 64; o <<= 1) v += __shfl_xor(v, o);
    return v;
}
DI float wave_max(float v) {
#pragma unroll
    for (int o = 1; o < 64; o <<= 1) v = fmaxf(v, __shfl_xor(v, o));
    return v;
}
DI int lane_id() { int l; asm volatile("v_mbcnt_lo_u32_b32 %0, -1, 0\n\tv_mbcnt_hi_u32_b32 %0, -1, %0" : "=v"(l)); return l; }
#define LDS_WAIT() asm volatile("s_waitcnt lgkmcnt(0)" ::: "memory")
#define VM_WAIT() asm volatile("s_waitcnt vmcnt(0)" ::: "memory")

#define XB_TMO      128
#define XB_XCNT(j)  (256  + 64 * (j))
#define XB_XSUB(j)  (1280 + 64 * (j))
#define XB_XGEN(j)  (2304 + 64 * (j))
#define XB_TOP      3328
#define XB_TOPGEN   3392
#define XCD_BAR_WORDS 3456
#define XB_SPIN_CAP (1u << 18)
__device__ __forceinline__ unsigned xb_ld(unsigned* p)              { return __hip_atomic_load(p, __ATOMIC_RELAXED, __HIP_MEMORY_SCOPE_AGENT); }
__device__ __forceinline__ unsigned xb_add(unsigned* p, unsigned v) { return __hip_atomic_fetch_add(p, v, __ATOMIC_RELAXED, __HIP_MEMORY_SCOPE_AGENT); }
__device__ __forceinline__ unsigned xb_xcc_id() { return (unsigned)__builtin_amdgcn_s_getreg((3 << 11) | 20) & 0xFu; }
#define XB_SPIN(cond, bar) do { unsigned _sp = 0; while (cond) { __builtin_amdgcn_s_sleep(1); \
    if ((++_sp & 255u) == 0u) { if (xb_ld(&(bar)[XB_TMO])) break; if (_sp > XB_SPIN_CAP) { atomicAdd(&(bar)[XB_TMO], 1u); break; } } } } while (0)
struct XcdBarrier { unsigned* bar; unsigned x; volatile LAS unsigned* st; };
__device__ __forceinline__ XcdBarrier xcd_barrier_post(unsigned* bar, volatile LAS unsigned* st) {
    XcdBarrier b; b.bar = bar; b.x = xb_xcc_id(); b.st = st;
    if (threadIdx.x == 0) (void)xb_add(&bar[XB_XCNT(b.x)], 1u);
    return b;
}
__device__ __forceinline__ void xcd_barrier_complete(unsigned* bar, unsigned x, unsigned& nloc, unsigned& nx) {
    const unsigned G = gridDim.x * gridDim.y * gridDim.z;
    unsigned sum, cnt, mine, sp = 0u;
    for (;;) {
        sum = 0u; cnt = 0u; mine = 0u;
#pragma unroll
        for (unsigned j = 0; j < 16; ++j) { const unsigned c = xb_ld(&bar[XB_XCNT(j)]); sum += c; cnt += (c > 0u) ? 1u : 0u; mine = (j == x) ? c : mine; }
        if (sum == G) break;
        __builtin_amdgcn_s_sleep(1);
        if ((++sp & 255u) == 0u) { if (xb_ld(&bar[XB_TMO])) break; if (sp > XB_SPIN_CAP) { atomicAdd(&bar[XB_TMO], 1u); break; } }
    }
    nloc = mine > 0u ? mine : 1u; nx = cnt > 0u ? cnt : 1u;
}
__device__ __forceinline__ void xcd_barrier(const XcdBarrier& b) {
    asm volatile("s_waitcnt vmcnt(0)" ::: "memory");
    __syncthreads();
    if (threadIdx.x == 0) {
        unsigned* bar = b.bar;
        __builtin_amdgcn_s_waitcnt(0);
        unsigned nloc = b.st[0], nx = b.st[1];
        if (nloc == 0u) { xcd_barrier_complete(bar, b.x, nloc, nx); b.st[0] = nloc; b.st[1] = nx; }
        const unsigned old = xb_add(&bar[XB_XSUB(b.x)], 1u);
        const unsigned gen = old / nloc;
        if (old + 1u == (gen + 1u) * nloc) {
            __builtin_amdgcn_fence(__ATOMIC_RELEASE, "agent");
            asm volatile("s_waitcnt vmcnt(0)" ::: "memory");
            const unsigned og = xb_add(&bar[XB_TOP], 1u);
            const unsigned tg = og / nx;
            if (og + 1u == (tg + 1u) * nx) xb_add(&bar[XB_TOPGEN], 1u);
            else XB_SPIN(xb_ld(&bar[XB_TOPGEN]) == tg, bar);
            __builtin_amdgcn_fence(__ATOMIC_ACQUIRE, "agent");
            xb_add(&bar[XB_XGEN(b.x)], 1u);
            asm volatile("s_waitcnt vmcnt(0)" ::: "memory");
        } else {
            XB_SPIN(xb_ld(&bar[XB_XGEN(b.x)]) == gen, bar);
            __builtin_amdgcn_fence(__ATOMIC_ACQUIRE, "agent");
            asm volatile("s_waitcnt vmcnt(0)" ::: "memory");
        }
    }
    __syncthreads();
}
namespace pg8 {
#define PG8_LAS __attribute__((address_space(3)))
typedef unsigned short bf16_t;
typedef short bf16x8 __attribute__((ext_vector_type(8)));
typedef float f32x4 __attribute__((ext_vector_type(4)));
typedef unsigned u32x4 __attribute__((ext_vector_type(4)));
constexpr int BM = 256, BK = 64, HALF = 128, HTB = HALF * BK * 2  , STAGE_BYTES = 8 * HTB, NXCD = 8, WGM = 8;

__host__ __device__ __forceinline__ int lds_byte(int r, int c) { const int st = (r >> 4) * 2 + (c >> 5), rr = r & 15, cc = c & 31, ob = rr * 64 + cc * 2; return st * 1024 + (ob ^ (((ob >> 9) & 1) << 5)); }
__host__ __device__ __forceinline__ void stage_rc(int b, int& R, int& C) { const int st = b / 1024, sb = b % 1024, swz = sb ^ (((sb >> 9) & 1) << 5); R = (st >> 1) * 16 + swz / 64; C = (st & 1) * 32 + (swz % 64) / 2; }
__host__ __device__ __forceinline__ int perm32(int rho) { const int n = rho >> 4, i = rho & 15; return 8 * (i >> 2) + 4 * n + (i & 3); }

struct Unit { int pm, pn; };
struct Gemm { const bf16_t* A; const bf16_t* Bt; int M, N, K; };

struct StaticOrder {
    int nM, nN, nwg, G, c;
    __host__ __device__ void init(int M, int N, int G_, int c_) { nM = M / BM; nN = N / BM; nwg = nM * nN; G = G_; c = c_; }
    __host__ __device__ bool next(int i, Unit& u) const {
        const long L = (long)i * G + c; if (L >= nwg) return false;
        int wgid = (int)L; { const int q = nwg / NXCD, r = nwg % NXCD, xcd = wgid % NXCD, off = wgid / NXCD; wgid = (xcd < r ? xcd * (q + 1) : r * (q + 1) + (xcd - r) * q) + off; }
        const int nig = WGM * nN, gid = wgid / nig, fm = gid * WGM, gsz = (nM - fm) < WGM ? (nM - fm) : WGM;
        u.pm = fm + ((wgid % nig) % gsz); u.pn = (wgid % nig) / gsz; return true;
    }
    __device__ __forceinline__ void a_ready(const Unit&) const {}
    __device__ __forceinline__ void done(const Unit&) const {}
};
struct CountedOrder : StaticOrder {
    const unsigned* ready; unsigned need; unsigned* tmo;
    __device__ __forceinline__ void a_ready(const Unit& u) const {
        if (threadIdx.x < 64) {
            const unsigned long long t0 = __builtin_amdgcn_s_memrealtime(); unsigned polls = 0;
            while ((unsigned)__builtin_amdgcn_readfirstlane(__hip_atomic_load(ready + 64 * u.pm, __ATOMIC_RELAXED, __HIP_MEMORY_SCOPE_AGENT)) < need) {
                if ((++polls & 255u) == 0u && __builtin_amdgcn_readfirstlane(__hip_atomic_load(tmo, __ATOMIC_RELAXED, __HIP_MEMORY_SCOPE_AGENT)) != 0u) break;
                if (__builtin_amdgcn_s_memrealtime() - t0 > 2000000ull) {
                    if (threadIdx.x == 0) { unsigned expect = 0u; __hip_atomic_compare_exchange_strong(tmo + 1, &expect, 0x600u | (unsigned)(u.pm & 0xff), __ATOMIC_RELAXED, __ATOMIC_RELAXED, __HIP_MEMORY_SCOPE_AGENT); __hip_atomic_store(tmo, 1u, __ATOMIC_RELAXED, __HIP_MEMORY_SCOPE_AGENT); }
                    break; }
                __builtin_amdgcn_s_sleep(2); }
            __builtin_amdgcn_fence(__ATOMIC_ACQUIRE, "agent");
            asm volatile("s_waitcnt vmcnt(0)" ::: "memory");
        }
#if !defined(BROKEN_HOOK_NO_BARRIER)
        asm volatile("" ::: "memory"); __builtin_amdgcn_s_barrier(); asm volatile("" ::: "memory");
#endif
    }
};

__device__ __forceinline__ unsigned cvt_pk_bf16(float lo, float hi) { unsigned r; asm volatile("v_cvt_pk_bf16_f32 %0, %1, %2" : "=v"(r) : "v"(lo), "v"(hi)); return r; }
typedef float f32x2 __attribute__((ext_vector_type(2)));
__device__ __forceinline__ f32x2 gelu_pk(f32x2 v) {
    const f32x2 av = __builtin_elementwise_abs(v), d = av * 0.2316418882f + 1.0f;
    f32x2 t; t.x = __builtin_amdgcn_rcpf(d.x); t.y = __builtin_amdgcn_rcpf(d.y);
    f32x2 q = t * 0.5307027145f + (-0.7265760135f); q = q * t + 0.7107068705f; q = q * t + (-0.142248368f); q = q * t + 0.127414796f; q = q * t;
    const f32x2 s = (v * v) * (-0.72134752044f);
    f32x2 e; e.x = __builtin_amdgcn_exp2f(s.x); e.y = __builtin_amdgcn_exp2f(s.y);
    const f32x2 m = v * (q * e), r = v - m;
    f32x2 o; o.x = v.x < 0.f ? m.x : r.x; o.y = v.y < 0.f ? m.y : r.y; return o;
}

struct EpiF32 {
    static constexpr bool PERM = false, AFTER_DRAIN = false;
    float* C; int ldc; const float* bias;
    __device__ __forceinline__ void operator()(const f32x4 (&acc)[2][2][4][2], const Unit& u, int wr, int wc, int fr, int fq) const {
        const int row0 = u.pm * BM + wr * 64 + fr, col0 = u.pn * BM + wc * 32 + 4 * fq;
        f32x4 bv[2][2];
#pragma unroll
        for (int bj = 0; bj < 2; ++bj)
#pragma unroll
            for (int n = 0; n < 2; ++n) bv[bj][n] = bias ? *(const f32x4*)(bias + col0 + bj * HALF + n * 16) : (f32x4){0.f, 0.f, 0.f, 0.f};
#pragma unroll
        for (int ai = 0; ai < 2; ++ai)
#pragma unroll
            for (int m = 0; m < 4; ++m) { float* rowp = C + (size_t)(row0 + ai * HALF + m * 16) * ldc + col0;
#pragma unroll
                for (int bj = 0; bj < 2; ++bj)
#pragma unroll
                    for (int n = 0; n < 2; ++n) *(f32x4*)(rowp + bj * HALF + n * 16) = acc[ai][bj][m][n] + bv[bj][n]; }
    }
};
template <int ACT  > struct EpiBf16 {
    static constexpr bool PERM = true, AFTER_DRAIN = false;
    bf16_t* O; int ldc; const float* bias; int split_cols; size_t split_stride;
    __device__ __forceinline__ void operator()(const f32x4 (&acc)[2][2][4][2], const Unit& u, int wr, int wc, int fr, int fq) const {
        const int row0 = u.pm * BM + wr * 64 + fr; int colt = u.pn * BM; bf16_t* base = O;
        if (split_cols) { const int t = colt / split_cols; base += (size_t)t * split_stride; colt -= t * split_cols; }
        const int col0 = colt + wc * 32 + 8 * fq, bcol0 = u.pn * BM + wc * 32 + 8 * fq;
        f32x4 bv[2][2];
#pragma unroll
        for (int bj = 0; bj < 2; ++bj)
#pragma unroll
            for (int n = 0; n < 2; ++n) bv[bj][n] = bias ? *(const f32x4*)(bias + bcol0 + bj * HALF + 4 * n) : (f32x4){0.f, 0.f, 0.f, 0.f};
#pragma unroll
        for (int ai = 0; ai < 2; ++ai)
#pragma unroll
            for (int m = 0; m < 4; ++m) { bf16_t* rowp = base + (size_t)(row0 + ai * HALF + m * 16) * ldc + col0;
#pragma unroll
                for (int bj = 0; bj < 2; ++bj) { f32x4 v0 = acc[ai][bj][m][0] + bv[bj][0], v1 = acc[ai][bj][m][1] + bv[bj][1];
                    if (ACT == 1) { f32x2 a = gelu_pk((f32x2){v0[0], v0[1]}), b = gelu_pk((f32x2){v0[2], v0[3]}), c = gelu_pk((f32x2){v1[0], v1[1]}), d = gelu_pk((f32x2){v1[2], v1[3]});
                        v0 = (f32x4){a.x, a.y, b.x, b.y}; v1 = (f32x4){c.x, c.y, d.x, d.y}; }
                    if (ACT == 2) {
#pragma unroll
                        for (int j = 0; j < 4; ++j) { v0[j] = 0.5f * v0[j] * (1.0f + erff(v0[j] * 0.70710678f)); v1[j] = 0.5f * v1[j] * (1.0f + erff(v1[j] * 0.70710678f)); } }
                    u32x4 w; w.x = cvt_pk_bf16(v0[0], v0[1]); w.y = cvt_pk_bf16(v0[2], v0[3]); w.z = cvt_pk_bf16(v1[0], v1[1]); w.w = cvt_pk_bf16(v1[2], v1[3]);
                    *(u32x4*)(rowp + bj * HALF) = w; } }
    }
};

struct PanelStats {
    unsigned* xbuf;
    unsigned* cnt;
    unsigned* tmo;
    int ntn; float eps;
    unsigned code;
    __device__ __forceinline__ bool run(const f32x4 (&v)[2][2][4][2], const Unit& u, int wr, int wc, int fr, int fq, PG8_LAS unsigned char* lds, int wid, int lane) const {
        typedef float f32x2v __attribute__((ext_vector_type(2)));
        PG8_LAS f32x2v* P = (PG8_LAS f32x2v*)lds;
        PG8_LAS f32x2v* S = (PG8_LAS f32x2v*)(lds + 8192);
        PG8_LAS unsigned* flag = (PG8_LAS unsigned*)(lds + 8192 + 2048);
#pragma unroll
        for (int ai = 0; ai < 2; ++ai)
#pragma unroll
            for (int m = 0; m < 4; ++m) {
                float s = 0.f;
#pragma unroll
                for (int bj = 0; bj < 2; ++bj)
#pragma unroll
                    for (int n = 0; n < 2; ++n) { const f32x4 x = v[ai][bj][m][n]; s += (x[0] + x[1]) + (x[2] + x[3]); }
                s += __shfl_xor(s, 16); s += __shfl_xor(s, 32);
                const float mw = s * (1.0f / 64.0f); float q = 0.f;
#pragma unroll
                for (int bj = 0; bj < 2; ++bj)
#pragma unroll
                    for (int n = 0; n < 2; ++n) { const f32x4 d = v[ai][bj][m][n] - mw; q += (d[0] * d[0] + d[1] * d[1]) + (d[2] * d[2] + d[3] * d[3]); }
                q += __shfl_xor(q, 16); q += __shfl_xor(q, 32);
                if (fq == 0) P[(ai * HALF + wr * 64 + m * 16 + fr) * 4 + wc] = (f32x2v){mw, q};
            }
        asm volatile("s_waitcnt lgkmcnt(0)" ::: "memory"); __builtin_amdgcn_s_barrier(); asm volatile("" ::: "memory");
#if defined(BROKEN_NO_WAIT)
        if (blockIdx.x >= 64) { const long long t0 = clock64(); while (clock64() - t0 < 60000) __builtin_amdgcn_s_sleep(8); }
#endif
        const int row = wid * 32 + (lane & 31);
        if (lane < 32) {
            const f32x2v a = P[row * 4 + 0], b = P[row * 4 + 1], c = P[row * 4 + 2], d = P[row * 4 + 3];
            const float mt = (a.x + b.x + c.x + d.x) * 0.25f;
            const float da = a.x - mt, db = b.x - mt, dc = c.x - mt, dd = d.x - mt;
            const float m2 = (a.y + b.y) + (c.y + d.y) + 64.0f * ((da * da + db * db) + (dc * dc + dd * dd));
            unsigned long long* slot = (unsigned long long*)xbuf + ((size_t)(u.pm * BM + row) * 4 + u.pn);
            __hip_atomic_store(slot, ((unsigned long long)__float_as_uint(m2) << 32) | __float_as_uint(mt), __ATOMIC_RELAXED, __HIP_MEMORY_SCOPE_AGENT);
        }
        asm volatile("s_waitcnt vmcnt(0)" ::: "memory");
        if (lane == 0) __hip_atomic_fetch_add(cnt + 64 * u.pm, 1u, __ATOMIC_RELAXED, __HIP_MEMORY_SCOPE_AGENT);
        if (wid == 0) {
            bool dead = false; const unsigned long long t0 = __builtin_amdgcn_s_memrealtime(); const unsigned want = 8u * (unsigned)ntn;
            for (;;) {
#if defined(BROKEN_NO_WAIT)
                break;
#endif
                if ((unsigned)__builtin_amdgcn_readfirstlane(__hip_atomic_load(cnt + 64 * u.pm, __ATOMIC_RELAXED, __HIP_MEMORY_SCOPE_AGENT)) >= want) break;
                if (__builtin_amdgcn_s_memrealtime() - t0 > 2000000ull) {
                    if (lane == 0) { unsigned expect = 0u; __hip_atomic_compare_exchange_strong(tmo + 1, &expect, code | (unsigned)(u.pm & 0xff), __ATOMIC_RELAXED, __ATOMIC_RELAXED, __HIP_MEMORY_SCOPE_AGENT);
                                     __hip_atomic_store(tmo, 1u, __ATOMIC_RELAXED, __HIP_MEMORY_SCOPE_AGENT); }
                    dead = true; break; }
                __builtin_amdgcn_s_sleep(2);
            }
            __builtin_amdgcn_fence(__ATOMIC_ACQUIRE, "agent");
            if (lane == 0) flag[0] = dead ? 1u : 0u;
        }
        asm volatile("s_waitcnt vmcnt(0) lgkmcnt(0)" ::: "memory"); __builtin_amdgcn_s_barrier(); asm volatile("" ::: "memory");
        const bool bad = flag[0] != 0u;
        if (lane < 32) {
            const unsigned long long* slot = (const unsigned long long*)xbuf + (size_t)(u.pm * BM + row) * 4; float mt[4], m2[4]; float ms = 0.f;
#pragma unroll
            for (int t = 0; t < 4; ++t) { if (t < ntn) { const unsigned long long w = __hip_atomic_load(slot + t, __ATOMIC_RELAXED, __HIP_MEMORY_SCOPE_AGENT); mt[t] = __uint_as_float((unsigned)w); m2[t] = __uint_as_float((unsigned)(w >> 32)); } else { mt[t] = 0.f; m2[t] = 0.f; } ms += mt[t]; }
            const float mean = ms / (float)ntn; float q = 0.f;
#pragma unroll
            for (int t = 0; t < 4; ++t) if (t < ntn) { const float dm = mt[t] - mean; q += m2[t] + 256.0f * dm * dm; }
            S[row] = (f32x2v){mean, 1.0f / sqrtf(q / (256.0f * (float)ntn) + eps)};
        }
        asm volatile("s_waitcnt lgkmcnt(0)" ::: "memory"); __builtin_amdgcn_s_barrier(); asm volatile("" ::: "memory");
        return bad;
    }
};
struct EpiLnRes {
    static constexpr bool PERM = false, AFTER_DRAIN = true;
    const float* base; float* out; int ldc; const float* bias; PanelStats st; unsigned poison;
    __device__ __forceinline__ void refuse(size_t i0, size_t stride, int M, int N) const { const float q = __builtin_nanf(""); for (size_t i = i0; i < (size_t)M * N; i += stride) out[(i / N) * ldc + i % N] = q;
        if (i0 == 0) { unsigned expect = 0u; __hip_atomic_compare_exchange_strong(st.tmo + 1, &expect, 0x7f0u, __ATOMIC_RELAXED, __ATOMIC_RELAXED, __HIP_MEMORY_SCOPE_AGENT); __hip_atomic_store(st.tmo, 1u, __ATOMIC_RELAXED, __HIP_MEMORY_SCOPE_AGENT); } }
    __device__ __forceinline__ void fused(f32x4 (&acc)[2][2][4][2], const Unit& u, int wr, int wc, int fr, int fq, PG8_LAS unsigned char* lds, int wid, int lane) const {
        typedef float f32x2v __attribute__((ext_vector_type(2)));
        const PG8_LAS f32x2v* S = (const PG8_LAS f32x2v*)(lds + 8192);
        const int col0 = u.pn * BM + wc * 32 + 4 * fq;
#pragma unroll
        for (int bj = 0; bj < 2; ++bj)
#pragma unroll
            for (int n = 0; n < 2; ++n) { const f32x4 bv = bias ? *(const f32x4*)(bias + col0 + bj * HALF + n * 16) : (f32x4){0.f, 0.f, 0.f, 0.f};
#pragma unroll
                for (int ai = 0; ai < 2; ++ai)
#pragma unroll
                    for (int m = 0; m < 4; ++m) acc[ai][bj][m][n] += bv; }
        const bool bad = st.run(acc, u, wr, wc, fr, fq, lds, wid, lane) || poison != 0u;
        const float qnan = __builtin_nanf("");
#pragma unroll
        for (int ai = 0; ai < 2; ++ai)
#pragma unroll
            for (int m = 0; m < 4; ++m) { const int r = ai * HALF + wr * 64 + m * 16 + fr; const f32x2v sr = S[r]; const size_t off = (size_t)(u.pm * BM + r) * ldc + col0;
#pragma unroll
                for (int bj = 0; bj < 2; ++bj)
#pragma unroll
                    for (int n = 0; n < 2; ++n) { const f32x4 bs = *(const f32x4*)(base + off + bj * HALF + n * 16); f32x4 o = bs + (acc[ai][bj][m][n] - sr.x) * sr.y;
                        if (bad) o = (f32x4){qnan, qnan, qnan, qnan}; *(f32x4*)(out + off + bj * HALF + n * 16) = o; }
                asm volatile("" ::: "memory"); }
    }
};
struct EpiLnResLn {
    static constexpr bool PERM = false, AFTER_DRAIN = true;
    const float* base; float* out; bf16_t* xn; int ldc; const float* bias; PanelStats st1, st2; unsigned poison;
    __device__ __forceinline__ void refuse(size_t i0, size_t stride, int M, int N) const { const float q = __builtin_nanf(""); for (size_t i = i0; i < (size_t)M * N; i += stride) { const size_t o = (i / N) * ldc + i % N; out[o] = q; xn[o] = (bf16_t)0x7fc0u; }
        if (i0 == 0) { unsigned expect = 0u; __hip_atomic_compare_exchange_strong(st1.tmo + 1, &expect, 0x7f0u, __ATOMIC_RELAXED, __ATOMIC_RELAXED, __HIP_MEMORY_SCOPE_AGENT); __hip_atomic_store(st1.tmo, 1u, __ATOMIC_RELAXED, __HIP_MEMORY_SCOPE_AGENT); } }
    __device__ __forceinline__ void fused(f32x4 (&acc)[2][2][4][2], const Unit& u, int wr, int wc, int fr, int fq, PG8_LAS unsigned char* lds, int wid, int lane) const {
        typedef float f32x2v __attribute__((ext_vector_type(2))); typedef unsigned u32x2v __attribute__((ext_vector_type(2)));
        const PG8_LAS f32x2v* S = (const PG8_LAS f32x2v*)(lds + 8192);
        const int col0 = u.pn * BM + wc * 32 + 4 * fq;
#pragma unroll
        for (int bj = 0; bj < 2; ++bj)
#pragma unroll
            for (int n = 0; n < 2; ++n) { const f32x4 bv = bias ? *(const f32x4*)(bias + col0 + bj * HALF + n * 16) : (f32x4){0.f, 0.f, 0.f, 0.f};
#pragma unroll
                for (int ai = 0; ai < 2; ++ai)
#pragma unroll
                    for (int m = 0; m < 4; ++m) acc[ai][bj][m][n] += bv; }
        bool bad = st1.run(acc, u, wr, wc, fr, fq, lds, wid, lane) || poison != 0u;
        const float qnan = __builtin_nanf("");
#pragma unroll
        for (int ai = 0; ai < 2; ++ai)
#pragma unroll
            for (int m = 0; m < 4; ++m) { const int r = ai * HALF + wr * 64 + m * 16 + fr; const f32x2v sr = S[r]; const size_t off = (size_t)(u.pm * BM + r) * ldc + col0;
#pragma unroll
                for (int bj = 0; bj < 2; ++bj)
#pragma unroll
                    for (int n = 0; n < 2; ++n) { const f32x4 bs = *(const f32x4*)(base + off + bj * HALF + n * 16); acc[ai][bj][m][n] = bs + (acc[ai][bj][m][n] - sr.x) * sr.y; }
                asm volatile("" : "+v"(acc[ai][0][m][0]), "+v"(acc[ai][0][m][1]), "+v"(acc[ai][1][m][0]), "+v"(acc[ai][1][m][1]));
                if (m & 1) asm volatile("" ::: "memory"); }
        const bool bad1 = bad;
        bad = st2.run(acc, u, wr, wc, fr, fq, lds, wid, lane) || bad;
#pragma unroll
        for (int ai = 0; ai < 2; ++ai)
#pragma unroll
            for (int m = 0; m < 4; ++m) { const int r = ai * HALF + wr * 64 + m * 16 + fr; const f32x2v sr = S[r]; const size_t off = (size_t)(u.pm * BM + r) * ldc + col0;
#pragma unroll
                for (int bj = 0; bj < 2; ++bj)
#pragma unroll
                    for (int n = 0; n < 2; ++n) { const f32x4 x1 = acc[ai][bj][m][n]; *(f32x4*)(out + off + bj * HALF + n * 16) = bad1 ? (f32x4){qnan, qnan, qnan, qnan} : x1;
                        const f32x4 o = (x1 - sr.x) * sr.y; u32x2v w; w.x = cvt_pk_bf16(o[0], o[1]); w.y = cvt_pk_bf16(o[2], o[3]);
                        if (bad) { w.x = 0x7fc07fc0u; w.y = 0x7fc07fc0u; } *(u32x2v*)(xn + off + bj * HALF + n * 16) = w; }
                asm volatile("" ::: "memory"); }
    }
};

template <class Epi, class Sched, bool STAMP = false>
__device__ __forceinline__ void gemm_phase(PG8_LAS unsigned char* lds, const Gemm g, const Sched& S, const Epi& E, unsigned long long* stamps, int wid_in) {
    const int wid = wid_in, lane = lane_id(), tid = wid * 64 + lane, wr = wid >> 2, wc = wid & 3, fr = lane & 15, fq = lane >> 4;
    const int K = g.K, nt = K / BK;
    int ts_lo = 0, ts_hi = 0, nts = 0; const unsigned long long rt_entry = STAMP ? (unsigned long long)wall_clock64() : 0ull;
#define PG8_STAMP() do { if (STAMP && wid == 0 && nts < 64) { const unsigned long long _c = (unsigned long long)clock64(); \
        ts_lo = (lane == nts) ? (int)(unsigned)_c : ts_lo; ts_hi = (lane == nts) ? (int)(unsigned)(_c >> 32) : ts_hi; ++nts; } } while (0)
    PG8_STAMP();
    unsigned voffA[2], voffB[2];
#pragma unroll
    for (int i = 0; i < 2; ++i) { int R, C; stage_rc(tid * 16 + i * 8192, R, C); const int Rb = Epi::PERM ? ((R & ~31) + perm32(R & 31)) : R;
        voffA[i] = (unsigned)(R * K + C) * 2u; voffB[i] = (unsigned)(Rb * K + C) * 2u; }
    const size_t kstep = (size_t)(BK * 2);
    const size_t hstep = (size_t)HALF * K * 2;
    const size_t tstep = 2 * hstep;
    const unsigned ldsw = (unsigned)wid * 1024u;
    const int aoff = lds_byte(wr * 64 + fr, fq * 8), boff = lds_byte(wc * 32 + fr, fq * 8);
#define PG8_SA(b, h) (((b) * 2 + (h)) * HTB)
#define PG8_SB(b, h) ((4 + (b) * 2 + (h)) * HTB)
#define PG8_STAGE(bufoff, gbase, voff) do { _Pragma("unroll") for (int _i = 0; _i < 2; ++_i) \
        __builtin_amdgcn_global_load_lds((const unsigned*)((const char*)(gbase) + (voff)[_i]), (PG8_LAS unsigned*)(lds + (bufoff) + ldsw + _i * 8192), 16, 0, 0); } while (0)
#define PG8_LDA(dst, b, h) do { _Pragma("unroll") for (int m = 0; m < 4; ++m) _Pragma("unroll") for (int k = 0; k < 2; ++k) dst[m][k] = *(const PG8_LAS bf16x8*)(lds + PG8_SA(b, h) + aoff + m * 2048 + k * 1024); } while (0)
#define PG8_LDB(dst, b, h) do { _Pragma("unroll") for (int n = 0; n < 2; ++n) _Pragma("unroll") for (int k = 0; k < 2; ++k) dst[n][k] = *(const PG8_LAS bf16x8*)(lds + PG8_SB(b, h) + boff + n * 2048 + k * 1024); } while (0)
#define PG8_MMA(ai, bj, At, Bt) do { __builtin_amdgcn_s_setprio(1); _Pragma("unroll") for (int m = 0; m < 4; ++m) _Pragma("unroll") for (int n = 0; n < 2; ++n) _Pragma("unroll") for (int k = 0; k < 2; ++k) \
        acc[ai][bj][m][n] = __builtin_amdgcn_mfma_f32_16x16x32_bf16(Bt[n][k], At[m][k], acc[ai][bj][m][n], 0, 0, 0); __builtin_amdgcn_s_setprio(0); } while (0)
#define PG8_WAIT_V(n) asm volatile("s_waitcnt vmcnt(" #n ")" ::: "memory")
#define PG8_WAIT_L(n) asm volatile("s_waitcnt lgkmcnt(" #n ")" ::: "memory")
#define PG8_BAR __builtin_amdgcn_s_barrier()
#define PG8_SCHED __builtin_amdgcn_sched_barrier(0)
    Unit cur, nxt; int ui = 0;
    if (!S.next(0, cur)) return;
    f32x4 acc[2][2][4][2];
#pragma unroll
    for (int a = 0; a < 2; ++a)
#pragma unroll
        for (int b = 0; b < 2; ++b)
#pragma unroll
            for (int m = 0; m < 4; ++m)
#pragma unroll
                for (int n = 0; n < 2; ++n) acc[a][b][m][n] = (f32x4){0.f, 0.f, 0.f, 0.f};
    bf16x8 At[4][2], B0[2][2], B1[2][2];
    const char* cA = (const char*)g.A + (size_t)cur.pm * tstep; const char* cB = (const char*)g.Bt + (size_t)cur.pn * tstep;
    S.a_ready(cur);
    PG8_STAGE(PG8_SB(0, 0), cB, voffB); PG8_STAGE(PG8_SA(0, 0), cA, voffA); PG8_STAGE(PG8_SB(0, 1), cB + hstep, voffB); PG8_STAGE(PG8_SA(0, 1), cA + hstep, voffA);
    if (wr == 1) PG8_BAR;
    PG8_WAIT_V(4); PG8_BAR;
    PG8_STAGE(PG8_SB(1, 0), cB + kstep, voffB); PG8_STAGE(PG8_SA(1, 0), cA + kstep, voffA); PG8_STAGE(PG8_SB(1, 1), cB + hstep + kstep, voffB);
    PG8_WAIT_V(6); PG8_BAR;
    PG8_STAMP();
    for (;;) {
        const bool has_next = S.next(ui + 1, nxt);
        const char* nA = has_next ? (const char*)g.A + (size_t)nxt.pm * tstep : cA; const char* nB = has_next ? (const char*)g.Bt + (size_t)nxt.pn * tstep : cB;
        for (int t = 0; t < nt; t += 2) {
            const bool last = (t == nt - 2);
            const char* a1 = cA + (size_t)(t + 1) * kstep;
            const char* a2 = last ? nA : cA + (size_t)(t + 2) * kstep; const char* b2 = last ? nB : cB + (size_t)(t + 2) * kstep;
            const char* a3 = a2 + kstep; const char* b3 = b2 + kstep;
            if (last && has_next) S.a_ready(nxt);
            PG8_LDB(B0, 0, 0); PG8_SCHED; PG8_LDA(At, 0, 0); PG8_STAGE(PG8_SA(1, 1), a1 + hstep, voffA);
            PG8_WAIT_L(8); PG8_BAR; PG8_WAIT_L(0); PG8_MMA(0, 0, At, B0); PG8_BAR; PG8_SCHED;
            PG8_LDB(B1, 0, 1); PG8_STAGE(PG8_SB(0, 0), b2, voffB);
            PG8_BAR; PG8_WAIT_L(0); PG8_MMA(0, 1, At, B1); PG8_BAR;
            PG8_LDA(At, 0, 1); PG8_STAGE(PG8_SA(0, 0), a2, voffA);
            PG8_BAR; PG8_WAIT_L(0); PG8_MMA(1, 0, At, B0); PG8_BAR; PG8_SCHED;
            PG8_STAGE(PG8_SB(0, 1), b2 + hstep, voffB);
            PG8_WAIT_V(6); PG8_BAR; PG8_MMA(1, 1, At, B1); PG8_BAR;
            PG8_LDB(B0, 1, 0); PG8_SCHED; PG8_LDA(At, 1, 0); PG8_STAGE(PG8_SA(0, 1), a2 + hstep, voffA);
            PG8_WAIT_L(8); PG8_BAR; PG8_WAIT_L(0); PG8_MMA(0, 0, At, B0); PG8_BAR; PG8_SCHED;
            PG8_LDB(B1, 1, 1); PG8_STAGE(PG8_SB(1, 0), b3, voffB);
            PG8_BAR; PG8_WAIT_L(0); PG8_MMA(0, 1, At, B1); PG8_BAR;
            PG8_LDA(At, 1, 1); PG8_STAGE(PG8_SA(1, 0), a3, voffA);
            PG8_BAR; PG8_WAIT_L(0); PG8_MMA(1, 0, At, B0); PG8_BAR; PG8_SCHED;
            PG8_STAGE(PG8_SB(1, 1), b3 + hstep, voffB);
            PG8_WAIT_V(6); PG8_BAR; PG8_MMA(1, 1, At, B1); PG8_BAR;
        }
        PG8_STAMP();
        if constexpr (!Epi::AFTER_DRAIN) { E(acc, cur, wr, wc, fr, fq); S.done(cur); }
        PG8_STAMP();
        if (!has_next) break;
#pragma unroll
        for (int a = 0; a < 2; ++a)
#pragma unroll
            for (int b = 0; b < 2; ++b)
#pragma unroll
                for (int m = 0; m < 4; ++m)
#pragma unroll
                    for (int n = 0; n < 2; ++n) acc[a][b][m][n] = (f32x4){0.f, 0.f, 0.f, 0.f};
        cur = nxt; cA = nA; cB = nB; ++ui;
    }
    PG8_WAIT_V(0);
    if (wr == 0) PG8_BAR;
    PG8_BAR;
    if constexpr (Epi::AFTER_DRAIN) { E.fused(acc, cur, wr, wc, fr, fq, lds, wid, lane); S.done(cur); }
    PG8_STAMP();
    if (STAMP && wid == 0) { stamps[lane] = lane < nts ? (((unsigned long long)(unsigned)ts_hi << 32) | (unsigned)ts_lo) : 0ull;
        if (lane == 62) stamps[62] = rt_entry; if (lane == 63) stamps[63] = (unsigned long long)wall_clock64(); }
#undef PG8_STAMP
#undef PG8_SA
#undef PG8_SB
#undef PG8_STAGE
#undef PG8_LDA
#undef PG8_LDB
#undef PG8_MMA
#undef PG8_WAIT_V
#undef PG8_WAIT_L
#undef PG8_BAR
#undef PG8_SCHED
}
}
constexpr int D = 1024, NB = 2, SEQ = 8192, CTXL = 256;
constexpr int TX = NB * SEQ;
constexpr int TC = NB * CTXL;
constexpr int TR = TX + TC;
constexpr float EPS = 1e-6f;
constexpr int NEXP = 16, CAPX = 1024, CAPC = 32, EROWS = 2304;
constexpr int FF = 2048;
constexpr int NKEY = CTXL + SEQ;
constexpr int RRS = 16640;
constexpr float QSCALE = 0.125f * 1.4426950408889634f;

enum { I_X = 0, I_C, I_CTX, I_CCTX, I_ADAW, I_ADAB, I_SGWIN, I_SGBIN, I_SGVG, I_SGWS, I_SGBS, I_SGWOUT, I_SGBOUT,
       I_HYWIN, I_HYBIN, I_HYCW, I_HYCB, I_HYFW1, I_HYFB1, I_HYFW2, I_HYFB2, I_HYFW3, I_HYFB3, I_HYFREQ, I_HYFWOUT, I_HYSKIP, I_HYWOUT, I_HYBOUT,
       I_DAWIN, I_DAQG, I_DAKG, I_DALQ1, I_DALK1, I_DALQ2, I_DALK2, I_DASUB, I_DAWOUT, I_ROUTER, I_WGATE, I_WUP, I_WDOWN, N_IN };

constexpr size_t MiB = 1u << 20;
constexpr size_t WS_CTL = 0, CTL_ZERO_BYTES = 1 * MiB;
constexpr size_t WS_MOD = 1 * MiB;
constexpr size_t WS_ROPE = 2 * MiB;
constexpr size_t WS_HID = 3 * MiB;
constexpr size_t WS_FSQP = 6 * MiB;
constexpr size_t WS_AFF = 9 * MiB;
constexpr size_t WS_TOKSLOT = 11 * MiB;
constexpr size_t WS_SELTOK = 13 * MiB;
constexpr size_t WS_SELG = 13 * MiB + 512 * 1024;
constexpr size_t WS_WSBD = 14 * MiB;
constexpr size_t WS_WSGIN = 16 * MiB, WS_WSGOUT = 32 * MiB, WS_WHYIN = 40 * MiB, WS_WHYOUT = 46 * MiB, WS_WDAIN = 48 * MiB, WS_WDAOUT = 54 * MiB;
constexpr size_t WS_WGU = 64 * MiB;
constexpr size_t WS_WDN = 576 * MiB;
constexpr size_t WS_X = 832 * MiB;
constexpr size_t WS_H = 898 * MiB;
constexpr size_t WS_BUF1 = 932 * MiB;
constexpr size_t WS_BUF2 = 1064 * MiB;
constexpr size_t WS_BUF3 = 1164 * MiB;
constexpr size_t WS_Y = 1232 * MiB;
constexpr size_t WS_RR = 1304 * MiB;
constexpr size_t WS_RRC = 1436 * MiB;
constexpr size_t WS_END = 1440 * MiB;
constexpr int CW_BAR = 4096;

constexpr int RING_BYTES = 131072;
constexpr int MISC_OFF = RING_BYTES + 320;
constexpr int LDS_BYTES = 147456;
constexpr int NWAVES = 8, NTHR = 512;

struct Args { const float* in[N_IN]; float* out; unsigned char* ws; int ph_lo, ph_hi; };
static_assert(sizeof(Args) == N_IN * 8 + 8 + 8 + 8, "Args has no padding");

DI int mod_index(int row) { return row < TX ? (row >> 13) : 2; }
DI const float* modp(const Args& a, int layer, int mi, int piece) { return (const float*)(a.ws + WS_MOD) + ((size_t)(layer * 3 + mi) * 6 + piece) * 1024; }

namespace pg8 {
struct MoeOrder {
    int MT, NT, G, c;
    __device__ bool next(int i, Unit& u) const {
        const int L = i * G + c; if (L >= 16 * MT * NT) return false;
        const int e = L / (MT * NT), r = L - e * (MT * NT), nt = r / MT, mt = r - nt * MT;
        u.pm = e * 9 + mt; u.pn = e * NT + nt; return true;
    }
    __device__ __forceinline__ void a_ready(const Unit&) const {}
    __device__ __forceinline__ void done(const Unit&) const {}
};
struct SpatOrder {
    int nunits, G, c;
    __device__ bool next(int i, Unit& u) const {
        const int L = i * G + c; if (L >= nunits) return false;
        u.pm = L & 3; u.pn = L; return true;
    }
    __device__ __forceinline__ void a_ready(const Unit&) const {}
    __device__ __forceinline__ void done(const Unit&) const {}
};
struct EpiRes {
    static constexpr bool PERM = false, AFTER_DRAIN = false;
    float* X; const float* bias; const float* gate0;
    __device__ __forceinline__ void operator()(const f32x4 (&acc)[2][2][4][2], const Unit& u, int wr, int wc, int fr, int fq) const {
        const int row0 = u.pm * BM + wr * 64 + fr, col0 = u.pn * BM + wc * 32 + 4 * fq;
        const int mi = (u.pm * BM) < TX ? ((u.pm * BM) >> 13) : 2;
        const float* gate = gate0 + (size_t)mi * 6 * 1024;
#pragma unroll
        for (int bj = 0; bj < 2; ++bj)
#pragma unroll
            for (int n = 0; n < 2; ++n) {
                const f32x4 bv = bias ? *(const f32x4*)(bias + col0 + bj * HALF + n * 16) : (f32x4){0.f, 0.f, 0.f, 0.f}; const f32x4 gv = *(const f32x4*)(gate + col0 + bj * HALF + n * 16);
#pragma unroll
                for (int ai = 0; ai < 2; ++ai)
#pragma unroll
                    for (int m = 0; m < 4; ++m) { f32x4* p = (f32x4*)(X + (size_t)(row0 + ai * HALF + m * 16) * 1024 + col0 + bj * HALF + n * 16); *p = *p + gv * (acc[ai][bj][m][n] + bv); }
                asm volatile("" ::: "memory"); }
    }
};
struct EpiSwiGLU {
    static constexpr bool PERM = true, AFTER_DRAIN = false;
    bf16_t* O;
    __device__ __forceinline__ void operator()(const f32x4 (&acc)[2][2][4][2], const Unit& u, int wr, int wc, int fr, int fq) const {
        const int row0 = u.pm * BM + wr * 64 + fr; const int e = u.pm / 9; const int pnl = u.pn - e * 16;
        const int col0 = pnl * 128 + wc * 16 + 4 * fq;
#pragma unroll
        for (int ai = 0; ai < 2; ++ai)
#pragma unroll
            for (int m = 0; m < 4; ++m) { bf16_t* rowp = O + (size_t)(row0 + ai * HALF + m * 16) * 2048 + col0;
#pragma unroll
                for (int bj = 0; bj < 2; ++bj) { const f32x4 g = acc[ai][bj][m][0], up = acc[ai][bj][m][1]; f32x4 h;
#pragma unroll
                    for (int j = 0; j < 4; ++j) h[j] = g[j] * __builtin_amdgcn_rcpf(1.0f + __expf(-g[j])) * up[j];
                    u32x2 w; w.x = cvt_pk_bf16(h[0], h[1]); w.y = cvt_pk_bf16(h[2], h[3]);
                    *(u32x2*)(rowp + bj * 64) = w; } }
    }
};
struct EpiDown {
    static constexpr bool PERM = true, AFTER_DRAIN = false;
    bf16_t* O; const float* g;
    __device__ __forceinline__ void operator()(const f32x4 (&acc)[2][2][4][2], const Unit& u, int wr, int wc, int fr, int fq) const {
        const int row0 = u.pm * BM + wr * 64 + fr; const int e = u.pm / 9; const int pnl = u.pn - e * 4;
        const int col0 = pnl * BM + wc * 32 + 8 * fq;
#pragma unroll
        for (int ai = 0; ai < 2; ++ai)
#pragma unroll
            for (int m = 0; m < 4; ++m) { const int row = row0 + ai * HALF + m * 16; const float gs = g[row]; bf16_t* rowp = O + (size_t)row * 1024 + col0;
#pragma unroll
                for (int bj = 0; bj < 2; ++bj) { const f32x4 v0 = acc[ai][bj][m][0] * gs, v1 = acc[ai][bj][m][1] * gs;
                    u32x4 w; w.x = cvt_pk_bf16(v0[0], v0[1]); w.y = cvt_pk_bf16(v0[2], v0[3]); w.z = cvt_pk_bf16(v1[0], v1[1]); w.w = cvt_pk_bf16(v1[2], v1[3]);
                    *(u32x4*)(rowp + bj * HALF) = w; } }
    }
};
struct EpiSpat {
    static constexpr bool PERM = true, AFTER_DRAIN = false;
    bf16_t* TT; const bf16_t* ZZ; const float* bs;
    __device__ __forceinline__ void operator()(const f32x4 (&acc)[2][2][4][2], const Unit& u, int wr, int wc, int fr, int fq) const {
        const int chunk = u.pn >> 2, gp = u.pn & 3;
        asm volatile("" : "+v"(fr), "+v"(fq));
        const unsigned lz = (unsigned)(fr * 4096 + 8 * fq) * 2u, lt = (unsigned)(fr * 2048 + 8 * fq) * 2u;
#pragma unroll
        for (int ai = 0; ai < 2; ++ai)
#pragma unroll
            for (int m = 0; m < 4; ++m) { const int pu = wr * 64 + m * 16; const int g = 2 * gp + ai; const float b = bs[g * 128 + pu + fr];
#pragma unroll
                for (int bj = 0; bj < 2; ++bj) { const int chu = g * 256 + bj * HALF + wc * 32;
                    const char* zu = (const char*)(ZZ + ((size_t)chunk * 128 + pu) * 4096 + chu); char* tu = (char*)(TT + ((size_t)chunk * 128 + pu) * 2048 + chu);
                    const u32x4 uu = *(const u32x4*)(zu + lz);
                    const f32x4 v0 = acc[ai][bj][m][0] + b, v1 = acc[ai][bj][m][1] + b;
                    u32x4 w;
                    w.x = cvt_pk_bf16(__uint_as_float(uu.x << 16) * v0[0], __uint_as_float(uu.x & 0xffff0000u) * v0[1]);
                    w.y = cvt_pk_bf16(__uint_as_float(uu.y << 16) * v0[2], __uint_as_float(uu.y & 0xffff0000u) * v0[3]);
                    w.z = cvt_pk_bf16(__uint_as_float(uu.z << 16) * v1[0], __uint_as_float(uu.z & 0xffff0000u) * v1[1]);
                    w.w = cvt_pk_bf16(__uint_as_float(uu.w << 16) * v1[2], __uint_as_float(uu.w & 0xffff0000u) * v1[3]);
                    *(u32x4*)(tu + lt) = w; }
                asm volatile("" ::: "memory"); }
    }
};
}
DI void cvt_item(const float* W, int K, int N, bf16_t* WT, int mode, LAS float* scr, int item, int lane) {
    const int nblk = N / 32, kb = item / nblk, nb = item % nblk, k0 = 64 * kb, n0 = 32 * nb;
#pragma unroll 8
    for (int i = 0; i < 32; ++i) { const int kk = 2 * i + (lane >> 5); scr[kk * 33 + (lane & 31)] = W[(size_t)(k0 + kk) * N + n0 + (lane & 31)]; }
    LDS_WAIT(); asm volatile("" ::: "memory");
    const int c = lane & 7;
#pragma unroll
    for (int j = 0; j < 4; ++j) { const int n = (lane >> 3) + 8 * j; const LAS float* s = scr + (8 * c) * 33 + n;
        u32x4 o; o.x = pkbf(s[0 * 33], s[1 * 33]); o.y = pkbf(s[2 * 33], s[3 * 33]); o.z = pkbf(s[4 * 33], s[5 * 33]); o.w = pkbf(s[6 * 33], s[7 * 33]);
        const int na = n0 + n; const int row = mode == 0 ? na : (((na >> 2) << 3) + (na & 3) + (mode == 2 ? 4 : 0));
        *(u32x4*)(WT + (size_t)row * K + k0 + 8 * c) = o; }
    LDS_WAIT(); asm volatile("" ::: "memory");
}
DI void pro0_convert(const Args& a, LAS unsigned char* lds, int lane, int wave, int gw, int NGW) {
    LAS float* scr = (LAS float*)(lds + wave * 16384);
    unsigned char* ws = a.ws;
    constexpr int NSMALL = 2 * 2048 + 2 * 1024 + 1536 + 512 + 1536 + 512;
    constexpr int NITEMS = NSMALL + 3 * 65536;
    for (int it = gw; it < NITEMS; it += NGW) {
        int r = it;
        if (r < 4096) { const int j = r >> 11; cvt_item(a.in[I_SGWIN] + (size_t)j * 1024 * 4096, 1024, 4096, (bf16_t*)(ws + WS_WSGIN) + (size_t)j * 4096 * 1024, 0, scr, r & 2047, lane); continue; } r -= 4096;
        if (r < 2048) { const int j = r >> 10; cvt_item(a.in[I_SGWOUT] + (size_t)j * 2048 * 1024, 2048, 1024, (bf16_t*)(ws + WS_WSGOUT) + (size_t)j * 1024 * 2048, 0, scr, r & 1023, lane); continue; } r -= 2048;
        if (r < 1536) { cvt_item(a.in[I_HYWIN], 1024, 3072, (bf16_t*)(ws + WS_WHYIN), 0, scr, r, lane); continue; } r -= 1536;
        if (r < 512) { cvt_item(a.in[I_HYWOUT], 1024, 1024, (bf16_t*)(ws + WS_WHYOUT), 0, scr, r, lane); continue; } r -= 512;
        if (r < 1536) { cvt_item(a.in[I_DAWIN], 1024, 3072, (bf16_t*)(ws + WS_WDAIN), 0, scr, r, lane); continue; } r -= 1536;
        if (r < 512) { cvt_item(a.in[I_DAWOUT], 1024, 1024, (bf16_t*)(ws + WS_WDAOUT), 0, scr, r, lane); continue; } r -= 512;
        const int which = r >> 16, mm = (r & 65535) >> 10, item = r & 1023;
        if (which == 0) cvt_item(a.in[I_WGATE] + (size_t)mm * 1024 * 2048, 1024, 2048, (bf16_t*)(ws + WS_WGU) + (size_t)mm * 4096 * 1024, 1, scr, item, lane);
        else if (which == 1) cvt_item(a.in[I_WUP] + (size_t)mm * 1024 * 2048, 1024, 2048, (bf16_t*)(ws + WS_WGU) + (size_t)mm * 4096 * 1024, 2, scr, item, lane);
        else cvt_item(a.in[I_WDOWN] + (size_t)mm * 2048 * 1024, 2048, 1024, (bf16_t*)(ws + WS_WDN) + (size_t)mm * 1024 * 2048, 0, scr, item, lane);
    }
}
DI void pro0_small(const Args& a, int gtid, int gthreads) {
    bf16_t* sbd = (bf16_t*)(a.ws + WS_WSBD);
    for (int i = gtid; i < 2 * 4 * 256 * 256; i += gthreads) {
        const int col = i & 255, row = (i >> 8) & 255, gp = (i >> 16) & 3, j = i >> 18;
        const int gsel = row >> 7, p = row & 127, gl = col >> 7, q = col & 127;
        const float v = (gsel == gl) ? a.in[I_SGWS][(((size_t)j * 8 + 2 * gp + gsel) * 128 + p) * 128 + q] : 0.f;
        sbd[i] = f2bf1(v);
    }
    float* rope = (float*)(a.ws + WS_ROPE);
    for (int i = gtid; i < 2048; i += gthreads) {
        const int pos = i >> 4, f = i & 15;
        const float inv = powf(10000.0f, -(float)f / 16.0f);
        const float ang = (float)pos * inv;
        rope[2 * i] = cosf(ang); rope[2 * i + 1] = sinf(ang);
    }
    bf16_t* rr = (bf16_t*)(a.ws + WS_RR);
    for (int i = gtid; i < 4096 * 258; i += gthreads) {
        const int row = i / 258, k = i % 258;
        const int idx = k == 257 ? 0 : 16383 + k;
        rr[(size_t)row * RRS + idx] = 0;
    }
}
DI void pro0_mod(const Args& a, LAS unsigned char* lds, int tid, int lane, int wave) {
    LAS float* sc = (LAS float*)lds;
    for (int i = tid; i < 3072; i += NTHR) { const int r = i >> 10, k = i & 1023; const float v = (r < 2) ? a.in[I_C][r * 1024 + k] : a.in[I_CCTX][k]; sc[i] = v / (1.0f + expf(-v)); }
    __syncthreads();
    LAS float* red = (LAS float*)(lds + 12288);
    float* MOD = (float*)(a.ws + WS_MOD);
    for (int it = blockIdx.x; it < 384; it += gridDim.x) {
        const int l = it / 96, cg = it % 96, col = cg * 64 + lane;
        const float* w = a.in[I_ADAW] + (size_t)l * 1024 * 6144 + col;
        float a0 = 0.f, a1 = 0.f, a2 = 0.f;
#pragma unroll 16
        for (int k = wave * 128; k < wave * 128 + 128; ++k) { const float wv = w[(size_t)k * 6144]; a0 += sc[k] * wv; a1 += sc[1024 + k] * wv; a2 += sc[2048 + k] * wv; }
        red[(wave * 3 + 0) * 64 + lane] = a0; red[(wave * 3 + 1) * 64 + lane] = a1; red[(wave * 3 + 2) * 64 + lane] = a2;
        __syncthreads();
        if (wave < 3) { float s = 0.f;
#pragma unroll
            for (int w8 = 0; w8 < 8; ++w8) s += red[(w8 * 3 + wave) * 64 + lane];
            MOD[(size_t)(l * 3 + wave) * 6144 + col] = s + a.in[I_ADAB][l * 6144 + col]; }
        __syncthreads();
    }
}
DI void pro0_filter1(const Args& a, int lane, int gw, int NGW) {
    float w1c[33], w2c[64], w3c[64];
#pragma unroll
    for (int i = 0; i < 33; ++i) w1c[i] = a.in[I_HYFW1][i * 64 + lane];
#pragma unroll
    for (int i = 0; i < 64; ++i) { w2c[i] = a.in[I_HYFW2][i * 64 + lane]; w3c[i] = a.in[I_HYFW3][i * 64 + lane]; }
    const float b1 = a.in[I_HYFB1][lane], b2 = a.in[I_HYFB2][lane], b3 = a.in[I_HYFB3][lane], fr = a.in[I_HYFREQ][lane];
    float* HID = (float*)(a.ws + WS_HID);
    for (int tt = gw; tt < 8448; tt += NGW) {
        const int n = tt < 8192 ? 8192 : 256, t = tt < 8192 ? tt : tt - 8192;
        const float tl = (float)t / (float)(n - 1);
        const float w = (6.283185307179586f / (float)n) * (float)t;
        float z = tl;
        if (lane >= 1 && lane <= 16) { const float f = 1e-4f + (float)(lane - 1) * ((15.0f - 1e-4f) / 15.0f); z = cosf(f * w); }
        else if (lane >= 17 && lane <= 32) { const float f = 1e-4f + (float)(lane - 17) * ((15.0f - 1e-4f) / 15.0f); z = -sinf(f * w); }
        float p = b1;
#pragma unroll
        for (int i = 0; i < 33; ++i) p += __uint_as_float(__builtin_amdgcn_readlane(__float_as_uint(z), i)) * w1c[i];
        float h = sinf(fr * p);
        p = b2;
#pragma unroll
        for (int i = 0; i < 64; ++i) p += __uint_as_float(__builtin_amdgcn_readlane(__float_as_uint(h), i)) * w2c[i];
        h = sinf(fr * p);
        p = b3;
#pragma unroll
        for (int i = 0; i < 64; ++i) p += __uint_as_float(__builtin_amdgcn_readlane(__float_as_uint(h), i)) * w3c[i];
        h = sinf(fr * p);
        HID[(size_t)tt * 64 + lane] = h;
    }
}
DI void pro1_filter2(const Args& a, LAS unsigned char* lds, int tid, int lane, int wave) {
    const float* HID = (const float*)(a.ws + WS_HID);
    const float* wout = a.in[I_HYFWOUT];
    float* FSQP = (float*)(a.ws + WS_FSQP);
    bf16_t* RR0 = (bf16_t*)(a.ws + WS_RR); bf16_t* RR1 = RR0 + (size_t)2048 * RRS;
    float* RRC = (float*)(a.ws + WS_RRC);
    LAS float* WT = (LAS float*)lds;
    const float dmin = logf(0.01f) / 1.5f, dmax = logf(0.01f) / 0.3f;
    for (int unit = blockIdx.x; unit < 17 * 64; unit += gridDim.x) {
        const int tg = unit >> 6, cg = unit & 63;
        __syncthreads();
        for (int i = tid; i < 1024; i += NTHR) { const int j = i >> 4, c4 = i & 15; const f32x4 w4 = *(const f32x4*)(wout + (size_t)j * 4096 + cg * 64 + c4 * 4);
            WT[(c4 * 4 + 0) * 68 + j] = w4[0]; WT[(c4 * 4 + 1) * 68 + j] = w4[1]; WT[(c4 * 4 + 2) * 68 + j] = w4[2]; WT[(c4 * 4 + 3) * 68 + j] = w4[3]; }
        __syncthreads();
        const int tbg = tg * 8 + wave;
        if (tbg < 132) {
            const int n = tbg < 128 ? 8192 : 256;
            const int t = (tbg < 128 ? tbg * 64 : (tbg - 128) * 64) + lane;
            const float tl = (float)t / (float)(n - 1);
            f32x4 hv[16];
            const f32x4* hp = (const f32x4*)(HID + (size_t)(tbg * 64 + lane) * 64);
#pragma unroll
            for (int j = 0; j < 16; ++j) hv[j] = hp[j];
#pragma unroll 1
            for (int cl = 0; cl < 64; ++cl) {
                f32x4 ap = (f32x4){0.f, 0.f, 0.f, 0.f};
#pragma unroll
                for (int j4 = 0; j4 < 16; ++j4) { const f32x4 w4 = *(const LAS f32x4*)(WT + cl * 68 + j4 * 4); ap += hv[j4] * w4; }
                const float accv = (ap[0] + ap[1]) + (ap[2] + ap[3]);
                const int ncol = cg * 64 + cl, o = ncol >> 11, side = (ncol >> 10) & 1, c = ncol & 1023;
                const float delta = fabsf(dmin + (float)c * ((dmax - dmin) / 1023.0f));
                const float val = accv * expf(-tl * delta);
                const bool skip = (side == 1 && t == 0);
                const float s = wave_sum(skip ? 0.f : val * val);
                if (lane == 0) FSQP[(size_t)tbg * 4096 + ncol] = s;
                if (!skip) {
                    const int idx = side == 0 ? n - t : n + t;
                    if (n == 8192) { const bf16_t bv = f2bf1(val); const size_t rb = (size_t)(o * 1024 + c) * RRS; RR0[rb + idx] = bv; RR1[rb + idx - 1] = bv; }
                    else RRC[(size_t)(o * 1024 + c) * 512 + idx] = val;
                }
            }
        }
    }
}

template <int LAYER> DI void phase_A(const Args& a, int lane, int gw, int NGW) {
    constexpr int nrows = (LAYER >= 3) ? TX : TR;
    float* X = (float*)(a.ws + WS_X); bf16_t* H = (bf16_t*)(a.ws + WS_H);
    const int* TS = (const int*)(a.ws + WS_TOKSLOT); const bf16_t* Y = (const bf16_t*)(a.ws + WS_Y);
    for (int r = gw; r < nrows; r += NGW) {
        const int mi = mod_index(r);
        f32x4 v[4];
        if (LAYER == 0) { const f32x4* src = (const f32x4*)(r < TX ? a.in[I_X] + (size_t)r * 1024 : a.in[I_CTX] + (size_t)(r - TX) * 1024) + lane;
#pragma unroll
            for (int j = 0; j < 4; ++j) v[j] = src[64 * j]; }
        else {
            const f32x4* src = (const f32x4*)(X + (size_t)r * 1024) + lane;
#pragma unroll
            for (int j = 0; j < 4; ++j) v[j] = src[64 * j];
            const bool has = (r < TX) || (LAYER - 1 <= 1);
            if (has) {
                f32x4 acc[4];
#pragma unroll
                for (int j = 0; j < 4; ++j) acc[j] = (f32x4){0.f, 0.f, 0.f, 0.f};
                for (int e = 0; e < 16; ++e) {
                    const int s = __builtin_amdgcn_readfirstlane(TS[(size_t)r * 16 + e]);
                    if (s >= 0) { const u32x2* yp = (const u32x2*)(Y + ((size_t)e * EROWS + s) * 1024) + lane;
#pragma unroll
                        for (int j = 0; j < 4; ++j) { const u32x2 w = yp[64 * j]; acc[j] += (f32x4){bflo(w.x), bfhi(w.x), bflo(w.y), bfhi(w.y)}; } }
                }
                const f32x4* g2 = (const f32x4*)modp(a, LAYER - 1, mi, 5) + lane;
#pragma unroll
                for (int j = 0; j < 4; ++j) v[j] += g2[64 * j] * acc[j];
            }
        }
        if (LAYER == 4) { f32x4* o = (f32x4*)(a.out + (size_t)r * 1024) + lane;
#pragma unroll
            for (int j = 0; j < 4; ++j) o[64 * j] = v[j];
            continue; }
        { f32x4* o = (f32x4*)(X + (size_t)r * 1024) + lane;
#pragma unroll
          for (int j = 0; j < 4; ++j) o[64 * j] = v[j]; }
        float ss = 0.f;
#pragma unroll
        for (int j = 0; j < 4; ++j) ss += (v[j][0] * v[j][0] + v[j][1] * v[j][1]) + (v[j][2] * v[j][2] + v[j][3] * v[j][3]);
        const float rs = 1.0f / sqrtf(wave_sum(ss) * (1.0f / 1024.0f) + EPS);
        constexpr int LY = LAYER < 4 ? LAYER : 0;
        const f32x4* sh = (const f32x4*)modp(a, LY, mi, 0) + lane; const f32x4* sc = (const f32x4*)modp(a, LY, mi, 1) + lane;
        u32x2* ho = (u32x2*)(H + (size_t)r * 1024) + lane;
#pragma unroll
        for (int j = 0; j < 4; ++j) { const f32x4 y = v[j] * rs * (sc[64 * j] + 1.0f) + sh[64 * j]; u32x2 w; w.x = pkbf(y[0], y[1]); w.y = pkbf(y[2], y[3]); ho[64 * j] = w; }
    }
}

template <int LAYER> DI void phase_moe_prep(const Args& a, LAS unsigned char* lds, int tid, int lane, int gw, int NGW) {
    constexpr int nrows = (LAYER >= 2) ? TX : TR;
    LAS float* wr = (LAS float*)lds;
    const float* rw = a.in[I_ROUTER] + (size_t)LAYER * 1024 * 16;
    for (int i = tid; i < 16384; i += NTHR) wr[(i & 15) * 1024 + (i >> 4)] = rw[i];
    __syncthreads();
    const float* X = (const float*)(a.ws + WS_X); bf16_t* H = (bf16_t*)(a.ws + WS_H); float* AFF = (float*)(a.ws + WS_AFF);
    for (int r = gw; r < nrows; r += NGW) {
        const int mi = mod_index(r);
        f32x4 v[4];
        const f32x4* src = (const f32x4*)(X + (size_t)r * 1024) + lane;
#pragma unroll
        for (int j = 0; j < 4; ++j) v[j] = src[64 * j];
        float ss = 0.f;
#pragma unroll
        for (int j = 0; j < 4; ++j) ss += (v[j][0] * v[j][0] + v[j][1] * v[j][1]) + (v[j][2] * v[j][2] + v[j][3] * v[j][3]);
        const float rs = 1.0f / sqrtf(wave_sum(ss) * (1.0f / 1024.0f) + EPS);
        const f32x4* sh = (const f32x4*)modp(a, LAYER, mi, 3) + lane; const f32x4* sc = (const f32x4*)modp(a, LAYER, mi, 4) + lane;
        u32x2* ho = (u32x2*)(H + (size_t)r * 1024) + lane;
#pragma unroll
        for (int j = 0; j < 4; ++j) { v[j] = v[j] * rs * (sc[64 * j] + 1.0f) + sh[64 * j]; u32x2 w; w.x = pkbf(v[j][0], v[j][1]); w.y = pkbf(v[j][2], v[j][3]); ho[64 * j] = w; }
        float lg[16];
#pragma unroll
        for (int e = 0; e < 16; ++e) { float s = 0.f;
#pragma unroll
            for (int j = 0; j < 4; ++j) { const f32x4 w4 = *(const LAS f32x4*)(wr + e * 1024 + j * 256 + lane * 4); s += (v[j][0] * w4[0] + v[j][1] * w4[1]) + (v[j][2] * w4[2] + v[j][3] * w4[3]); }
            lg[e] = wave_sum(s); }
        float mx = lg[0];
#pragma unroll
        for (int e = 1; e < 16; ++e) mx = fmaxf(mx, lg[e]);
        float sum = 0.f;
#pragma unroll
        for (int e = 0; e < 16; ++e) { lg[e] = expf(lg[e] - mx); sum += lg[e]; }
        float mine = 0.f;
#pragma unroll
        for (int e = 0; e < 16; ++e) mine = (lane == e) ? lg[e] : mine;
        if (lane < 16) AFF[(size_t)r * 16 + lane] = mine / sum;
    }
}

template <int LAYER> DI void phase_topk(const Args& a, LAS unsigned char* lds, int tid, int lane, int wave) {
    constexpr int nprob = (LAYER >= 2) ? 32 : 64;
    const float* AFF = (const float*)(a.ws + WS_AFF);
    int* TS = (int*)(a.ws + WS_TOKSLOT); int* SELTOK = (int*)(a.ws + WS_SELTOK); float* SELG = (float*)(a.ws + WS_SELG);
    LAS unsigned* red = (LAS unsigned*)lds;
    LAS unsigned* scan = (LAS unsigned*)(lds + 256);
    for (int p = blockIdx.x; p < nprob; p += gridDim.x) {
        const bool isx = p < 32; const int pb = isx ? p : p - 32; const int b = pb >> 4, e = pb & 15;
        const int N = isx ? 8192 : 256, cap = isx ? CAPX : CAPC, rowbase = isx ? b * 8192 : TX + b * 256, slotbase = isx ? b * 1024 : 2048 + b * 32;
        unsigned key[16];
        const bool active = tid * 16 < N;
#pragma unroll
        for (int i = 0; i < 16; ++i) key[i] = active ? __float_as_uint(AFF[(size_t)(rowbase + tid * 16 + i) * 16 + e]) : 0u;
        unsigned T = 0u;
        for (int bit = 30; bit >= 0; --bit) {
            const unsigned cand = T | (1u << bit);
            unsigned c = 0;
#pragma unroll
            for (int i = 0; i < 16; ++i) c += (active && key[i] >= cand) ? 1u : 0u;
#pragma unroll
            for (int o = 1; o < 64; o <<= 1) c += __shfl_xor(c, o);
            const int par = bit & 1;
            if (lane == 0) red[par * 8 + wave] = c;
            __syncthreads();
            unsigned tot = 0;
#pragma unroll
            for (int w8 = 0; w8 < 8; ++w8) tot += red[par * 8 + w8];
            if (tot >= (unsigned)cap) T = cand;
        }
        unsigned cg = 0, ce = 0;
#pragma unroll
        for (int i = 0; i < 16; ++i) { cg += (active && key[i] > T) ? 1u : 0u; ce += (active && key[i] == T) ? 1u : 0u; }
        unsigned ig = cg, ie = ce;
#pragma unroll
        for (int o = 1; o < 64; o <<= 1) { const unsigned tg = __shfl_up(ig, o), te = __shfl_up(ie, o); if (lane >= o) { ig += tg; ie += te; } }
        __syncthreads();
        if (lane == 63) { scan[wave * 2] = ig; scan[wave * 2 + 1] = ie; }
        __syncthreads();
        unsigned bg = 0, be = 0, totg = 0;
#pragma unroll
        for (int w8 = 0; w8 < 8; ++w8) { const unsigned g8 = scan[w8 * 2], e8 = scan[w8 * 2 + 1]; if (w8 < wave) { bg += g8; be += e8; } totg += g8; }
        unsigned pg = bg + ig - cg, pe = be + ie - ce;
        const unsigned need_eq = (unsigned)cap - totg;
        if (active) {
#pragma unroll
            for (int i = 0; i < 16; ++i) {
                const int row = rowbase + tid * 16 + i;
                const bool gt = key[i] > T, eq = key[i] == T;
                const bool sel = gt || (eq && pe < need_eq);
                int slot = -1;
                if (sel) { slot = slotbase + (int)(pg + (pe < need_eq ? pe : need_eq)); SELTOK[e * EROWS + slot] = row; SELG[e * EROWS + slot] = __uint_as_float(key[i]); }
                TS[(size_t)row * 16 + e] = slot;
                pg += gt ? 1u : 0u; pe += eq ? 1u : 0u;
            }
        }
        __syncthreads();
    }
}

template <int LAYER> DI void phase_gather(const Args& a, int lane, int gw, int NGW) {
    constexpr int ER = (LAYER >= 2) ? 2048 : 2304, VALID = (LAYER >= 2) ? 2048 : 2112;
    const int* SELTOK = (const int*)(a.ws + WS_SELTOK); const bf16_t* H = (const bf16_t*)(a.ws + WS_H); bf16_t* XS = (bf16_t*)(a.ws + WS_BUF1);
    for (int sr = gw; sr < 16 * ER; sr += NGW) {
        const int e = sr / ER, s = sr - e * ER;
        u32x4* dst = (u32x4*)(XS + ((size_t)e * EROWS + s) * 1024) + lane;
        if (s < VALID) { const int row = __builtin_amdgcn_readfirstlane(SELTOK[e * EROWS + s]); const u32x4* src = (const u32x4*)(H + (size_t)row * 1024) + lane; dst[0] = src[0]; dst[64] = src[64]; }
        else { dst[0] = (u32x4){0u, 0u, 0u, 0u}; dst[64] = (u32x4){0u, 0u, 0u, 0u}; }
    }
}

template <int J, int NCHUNK> DI void phase_sg_vnt(const Args& a, LAS unsigned char* lds, int tid, int lane, int wave) {
    const bf16_t* ZZ = (const bf16_t*)(a.ws + WS_BUF1); bf16_t* VNT = (bf16_t*)(a.ws + WS_BUF2);
    const float* gain = a.in[I_SGVG] + J * 2048;
    LAS float* rsq = (LAS float*)lds;
    LAS bf16_t* T = (LAS bf16_t*)(lds + 512);
    for (int chunk = blockIdx.x; chunk < NCHUNK; chunk += gridDim.x) {
        for (int qi = 0; qi < 16; ++qi) { const int q = wave * 16 + qi; const u32x4* vp = (const u32x4*)(ZZ + ((size_t)chunk * 128 + q) * 4096 + 2048) + lane; float ss = 0.f;
#pragma unroll
            for (int j = 0; j < 4; ++j) { const u32x4 w = vp[64 * j]; const float x0 = bflo(w.x), x1 = bfhi(w.x), x2 = bflo(w.y), x3 = bfhi(w.y), x4 = bflo(w.z), x5 = bfhi(w.z), x6 = bflo(w.w), x7 = bfhi(w.w);
                ss += (x0 * x0 + x1 * x1) + (x2 * x2 + x3 * x3) + (x4 * x4 + x5 * x5) + (x6 * x6 + x7 * x7); }
            ss = wave_sum(ss);
            if (lane == 0) rsq[q] = 1.0f / sqrtf(ss * (1.0f / 2048.0f) + EPS); }
        __syncthreads();
        for (int g = 0; g < 8; ++g) {
            for (int it = tid; it < 4096; it += NTHR) { const int q = it >> 5, c8 = (it & 31) * 8;
                const u32x4 w = *(const u32x4*)(ZZ + ((size_t)chunk * 128 + q) * 4096 + 2048 + g * 256 + c8);
                const f32x4 g0 = *(const f32x4*)(gain + g * 256 + c8), g1 = *(const f32x4*)(gain + g * 256 + c8 + 4); const float r = rsq[q];
                LAS unsigned* tp = (LAS unsigned*)(T + q * 258 + c8);
                tp[0] = pkbf(bflo(w.x) * r * g0[0], bfhi(w.x) * r * g0[1]); tp[1] = pkbf(bflo(w.y) * r * g0[2], bfhi(w.y) * r * g0[3]);
                tp[2] = pkbf(bflo(w.z) * r * g1[0], bfhi(w.z) * r * g1[1]); tp[3] = pkbf(bflo(w.w) * r * g1[2], bfhi(w.w) * r * g1[3]); }
            __syncthreads();
            for (int it = tid; it < 4096; it += NTHR) { const int c = it & 255, q8 = it >> 8;
                const LAS bf16_t* tp = T + (q8 * 8) * 258 + c;
                u32x4 o; o.x = (unsigned)tp[0] | ((unsigned)tp[258] << 16); o.y = (unsigned)tp[2 * 258] | ((unsigned)tp[3 * 258] << 16);
                o.z = (unsigned)tp[4 * 258] | ((unsigned)tp[5 * 258] << 16); o.w = (unsigned)tp[6 * 258] | ((unsigned)tp[7 * 258] << 16);
                *(u32x4*)(VNT + ((size_t)(chunk * 4 + (g >> 1)) * 256 + c) * 256 + (g & 1) * 128 + q8 * 8) = o; }
            __syncthreads();
        }
    }
}

DI void phase_hy_shortconv(const Args& a, LAS unsigned char* lds, int tid) {
    const bf16_t* UP = (const bf16_t*)(a.ws + WS_BUF1); bf16_t* UT = (bf16_t*)(a.ws + WS_BUF2); bf16_t* UTC = UT + (size_t)3 * 2 * 1024 * 8192;
    const float* cw = a.in[I_HYCW]; const float* cb = a.in[I_HYCB];
    LAS bf16_t* T = (LAS bf16_t*)lds;
    for (int unit = blockIdx.x; unit < 264 * 24; unit += gridDim.x) {
        const int tblk = unit / 24, chb = unit % 24;
        const bool isx = tblk < 256;
        const int b = isx ? tblk >> 7 : (tblk - 256) >> 2, tb0 = isx ? (tblk & 127) * 64 : ((tblk - 256) & 3) * 64, n = isx ? 8192 : 256;
        const size_t rowbase = isx ? (size_t)b * 8192 : (size_t)TX + b * 256;
        for (int it = tid; it < 66 * 16; it += NTHR) { const int rr = it >> 4, c8 = (it & 15) * 8; const int t = tb0 - 1 + rr;
            u32x4 w = (u32x4){0u, 0u, 0u, 0u};
            if (t >= 0 && t < n) w = *(const u32x4*)(UP + (rowbase + t) * 3072 + chb * 128 + c8);
            LAS unsigned* tp = (LAS unsigned*)(T + rr * 130 + c8); tp[0] = w.x; tp[1] = w.y; tp[2] = w.z; tp[3] = w.w; }
        __syncthreads();
        for (int it = tid; it < 1024; it += NTHR) { const int ch = it & 127, t8 = it >> 7; const int chg = chb * 128 + ch;
            const float w0 = cw[chg], w1 = cw[3072 + chg], w2 = cw[2 * 3072 + chg], bb = cb[chg];
            float in[10];
#pragma unroll
            for (int k = 0; k < 10; ++k) in[k] = bf1(T[(t8 * 8 + k) * 130 + ch]);
            float o[8];
#pragma unroll
            for (int j = 0; j < 8; ++j) o[j] = w0 * in[j] + w1 * in[j + 1] + w2 * in[j + 2] + bb;
            u32x4 ov; ov.x = pkbf(o[0], o[1]); ov.y = pkbf(o[2], o[3]); ov.z = pkbf(o[4], o[5]); ov.w = pkbf(o[6], o[7]);
            const int part = chg >> 10, c = chg & 1023;
            if (isx) *(u32x4*)(UT + ((size_t)(part * 2 + b) * 1024 + c) * 8192 + tb0 + t8 * 8) = ov;
            else *(u32x4*)(UTC + ((size_t)(part * 2 + b) * 1024 + c) * 256 + tb0 + t8 * 8) = ov; }
        __syncthreads();
    }
}
DI void phase_hy_transpose(const Args& a, LAS unsigned char* lds, int lane, int wave, int gw, int NGW) {
    const bf16_t* Z2 = (const bf16_t*)(a.ws + WS_BUF3); const bf16_t* Z2C = Z2 + (size_t)2 * 1024 * 8192; bf16_t* ZA = (bf16_t*)(a.ws + WS_H);
    LAS bf16_t* T = (LAS bf16_t*)(lds + wave * 8704);
    for (int unit = gw; unit < 4096 + 128; unit += NGW) {
        const bool isx = unit < 4096; const int u = isx ? unit : unit - 4096;
        const int ntb = isx ? 128 : 4; const int b = u / (16 * ntb), cb = (u / ntb) & 15, tb = u % ntb;
        const bf16_t* src = isx ? Z2 + ((size_t)b * 1024 + cb * 64 + lane) * 8192 + tb * 64 : Z2C + ((size_t)b * 1024 + cb * 64 + lane) * 256 + tb * 64;
#pragma unroll
        for (int k = 0; k < 8; ++k) { const u32x4 w = ((const u32x4*)src)[k]; LAS unsigned* tp = (LAS unsigned*)(T + lane * 66 + k * 8); tp[0] = w.x; tp[1] = w.y; tp[2] = w.z; tp[3] = w.w; }
        LDS_WAIT(); __builtin_amdgcn_wave_barrier();
        bf16_t* dst = ZA + ((isx ? (size_t)b * 8192 : (size_t)TX + b * 256) + tb * 64 + lane) * 1024 + cb * 64;
#pragma unroll
        for (int k = 0; k < 8; ++k) { u32x4 o;
            o.x = (unsigned)T[(k * 8 + 0) * 66 + lane] | ((unsigned)T[(k * 8 + 1) * 66 + lane] << 16); o.y = (unsigned)T[(k * 8 + 2) * 66 + lane] | ((unsigned)T[(k * 8 + 3) * 66 + lane] << 16);
            o.z = (unsigned)T[(k * 8 + 4) * 66 + lane] | ((unsigned)T[(k * 8 + 5) * 66 + lane] << 16); o.w = (unsigned)T[(k * 8 + 6) * 66 + lane] | ((unsigned)T[(k * 8 + 7) * 66 + lane] << 16);
            ((u32x4*)dst)[k] = o; }
        LDS_WAIT(); __builtin_amdgcn_wave_barrier();
    }
}

DI void phase_da_prep(const Args& a, LAS unsigned char* lds, int tid) {
    const bf16_t* QKV = (const bf16_t*)(a.ws + WS_BUF1);
    bf16_t* Qn = (bf16_t*)(a.ws + WS_BUF2); bf16_t* Kn = Qn + (size_t)2 * 8 * 2 * 8192 * 64; bf16_t* VT = Kn + (size_t)2 * 8 * 2 * NKEY * 64;
    const float* rope = (const float*)(a.ws + WS_ROPE);
    LAS bf16_t* T = (LAS bf16_t*)lds;
    for (int unit = blockIdx.x; unit < 264 * 8; unit += gridDim.x) {
        const int rb = unit >> 3, h = unit & 7; const int r0 = rb * 64;
        const bool isx = r0 < TX;
        const int b = isx ? r0 >> 13 : (r0 - TX) >> 8;
        const int key0 = isx ? 256 + (r0 & 8191) : (r0 - TX) & 255;
        for (int it = tid; it < 1024; it += NTHR) { const int rl = it >> 4, c8 = (it & 15) * 8;
            const u32x4 w = *(const u32x4*)(QKV + (size_t)(r0 + rl) * 3072 + 2048 + h * 128 + c8);
            LAS unsigned* tp = (LAS unsigned*)(T + rl * 130 + c8); tp[0] = w.x; tp[1] = w.y; tp[2] = w.z; tp[3] = w.w; }
        { const int vid = tid >> 1, half = tid & 1, rl = vid & 63, which = vid >> 6; const int isk = which >> 1, m = which & 1; const int r = r0 + rl;
          if (isk || isx) {
            const u32x4* sp = (const u32x4*)(QKV + (size_t)r * 3072 + isk * 1024 + h * 128 + m * 64 + half * 32);
            float x[32];
#pragma unroll
            for (int k = 0; k < 4; ++k) { const u32x4 w = sp[k]; x[8 * k] = bflo(w.x); x[8 * k + 1] = bfhi(w.x); x[8 * k + 2] = bflo(w.y); x[8 * k + 3] = bfhi(w.y); x[8 * k + 4] = bflo(w.z); x[8 * k + 5] = bfhi(w.z); x[8 * k + 6] = bflo(w.w); x[8 * k + 7] = bfhi(w.w); }
            float ss = 0.f;
#pragma unroll
            for (int k = 0; k < 32; ++k) ss += x[k] * x[k];
            ss += __shfl_xor(ss, 1);
            const float rinv = 1.0f / sqrtf(ss * (1.0f / 64.0f) + EPS);
            const float* gn = (isk ? a.in[I_DAKG] : a.in[I_DAQG]) + half * 32;
#pragma unroll
            for (int k = 0; k < 32; ++k) x[k] = x[k] * rinv * gn[k];
            if (isx) { const int t = r & 8191; const int pos = half == 0 ? (t >> 6) : (t & 63); const float* rp = rope + pos * 32;
#pragma unroll
                for (int f = 0; f < 16; ++f) { const float cs = rp[2 * f], sn = rp[2 * f + 1]; const float x1 = x[f], x2 = x[16 + f]; x[f] = x1 * cs - x2 * sn; x[16 + f] = x2 * cs + x1 * sn; } }
            if (!isk) {
#pragma unroll
                for (int k = 0; k < 32; ++k) x[k] *= QSCALE; }
            bf16_t* dp = isk ? Kn + ((size_t)((b * 8 + h) * 2 + m) * NKEY + key0 + rl) * 64 + half * 32 : Qn + ((size_t)((b * 8 + h) * 2 + m) * 8192 + (r & 8191)) * 64 + half * 32;
#pragma unroll
            for (int k = 0; k < 4; ++k) { u32x4 o; o.x = pkbf(x[8 * k], x[8 * k + 1]); o.y = pkbf(x[8 * k + 2], x[8 * k + 3]); o.z = pkbf(x[8 * k + 4], x[8 * k + 5]); o.w = pkbf(x[8 * k + 6], x[8 * k + 7]); ((u32x4*)dp)[k] = o; }
          } }
        __syncthreads();
        for (int it = tid; it < 1024; it += NTHR) { const int e = it & 127, j8 = it >> 7; const int kb = 16 * (j8 >> 1) + 4 * (j8 & 1);
            const LAS bf16_t* tp = T + e;
            u32x4 o; o.x = (unsigned)tp[(kb + 0) * 130] | ((unsigned)tp[(kb + 1) * 130] << 16); o.y = (unsigned)tp[(kb + 2) * 130] | ((unsigned)tp[(kb + 3) * 130] << 16);
            o.z = (unsigned)tp[(kb + 8) * 130] | ((unsigned)tp[(kb + 9) * 130] << 16); o.w = (unsigned)tp[(kb + 10) * 130] | ((unsigned)tp[(kb + 11) * 130] << 16);
            *(u32x4*)(VT + ((size_t)(b * 8 + h) * 128 + e) * NKEY + key0 + j8 * 8) = o; }
        __syncthreads();
    }
}
#define MFMA32(a, b, c) __builtin_amdgcn_mfma_f32_32x32x16_bf16((a), (b), (c), 0, 0, 0)
DI bf16x8 pack8(const f32x16& x, int s) {
    u32x4 p;
    if (s == 0) { p.x = pkbf(x[0], x[1]); p.y = pkbf(x[2], x[3]); p.z = pkbf(x[4], x[5]); p.w = pkbf(x[6], x[7]); }
    else { p.x = pkbf(x[8], x[9]); p.y = pkbf(x[10], x[11]); p.z = pkbf(x[12], x[13]); p.w = pkbf(x[14], x[15]); }
    return __builtin_bit_cast(bf16x8, p);
}
constexpr int AT_STAGE = 32768;
DI void attn_issue_tile(LAS unsigned char* lds, int stage, const bf16_t* K0t, const bf16_t* K1t, const bf16_t* VTt, unsigned koff, unsigned voff0, unsigned voff1, int wave) {
    LAS unsigned char* sb = lds + stage * AT_STAGE;
    __builtin_amdgcn_global_load_lds((const unsigned*)((const char*)K0t + koff), (LAS unsigned*)(sb + wave * 1024), 16, 0, 0);
    __builtin_amdgcn_global_load_lds((const unsigned*)((const char*)K1t + koff), (LAS unsigned*)(sb + 8192 + wave * 1024), 16, 0, 0);
    __builtin_amdgcn_global_load_lds((const unsigned*)((const char*)VTt + voff0), (LAS unsigned*)(sb + 16384 + wave * 1024), 16, 0, 0);
    __builtin_amdgcn_global_load_lds((const unsigned*)((const char*)(VTt + (size_t)64 * NKEY) + voff1), (LAS unsigned*)(sb + 16384 + 8192 + wave * 1024), 16, 0, 0);
}
DI void phase_attn(const Args& a, LAS unsigned char* lds, int tid, int lane, int wave) {
    const bf16_t* Qn = (const bf16_t*)(a.ws + WS_BUF2); const bf16_t* Kn = Qn + (size_t)2 * 8 * 2 * 8192 * 64; const bf16_t* VT = Kn + (size_t)2 * 8 * 2 * NKEY * 64;
    bf16_t* AO = (bf16_t*)(a.ws + WS_BUF3);
    float lam;
    { const float q1 = a.in[I_DALQ1][lane] * a.in[I_DALK1][lane], q2 = a.in[I_DALQ2][lane] * a.in[I_DALK2][lane];
      const float lam_init = 0.8f - 0.6f * expf(-0.3f * 2.0f);
      lam = expf(wave_sum(q1)) - expf(wave_sum(q2)) + lam_init; }
    const float lam_init = 0.8f - 0.6f * expf(-0.3f * 2.0f);
    const int G = gridDim.x, blk = blockIdx.x;
    const int ql = lane & 31, kg = lane >> 5;
    for (int i = 0;; ++i) {
        int bh, qb;
        if (G == 256) { if (i >= 2) break; bh = (blk & 7) + 8 * i; qb = blk >> 3; }
        else { const int L = i * G + blk; if (L >= 512) break; bh = L >> 5; qb = L & 31; }
        const int b = bh >> 3, h = bh & 7;
        const int t0 = qb * 256 + wave * 32;
        const bf16_t* K0g = Kn + (size_t)(bh * 2 + 0) * NKEY * 64; const bf16_t* K1g = Kn + (size_t)(bh * 2 + 1) * NKEY * 64; const bf16_t* VTg = VT + (size_t)bh * 128 * NKEY;
        unsigned koff, voff0, voff1;
        { const int key = tid >> 3, cl = (tid & 7) ^ ((key >> 1) & 7); koff = (unsigned)(key * 64 + cl * 8) * 2u;
          const int e0 = tid >> 3, c0 = (tid & 7) ^ ((e0 >> 1) & 7); voff0 = (unsigned)(e0 * NKEY + c0 * 8) * 2u;
          voff1 = voff0; }
        __syncthreads();
        attn_issue_tile(lds, 0, K0g, K1g, VTg, koff, voff0, voff1, wave);
        bf16x8 qf[2][4];
        { int qlv = ql, kgv = kg; asm volatile("" : "+v"(qlv), "+v"(kgv));
          const unsigned qoff = (unsigned)(qlv * 64 + kgv * 8);
#pragma unroll
        for (int m = 0; m < 2; ++m) { const bf16_t* qbase = Qn + ((size_t)(bh * 2 + m) * 8192 + t0) * 64;
#pragma unroll
            for (int ks = 0; ks < 4; ++ks) qf[m][ks] = *(const bf16x8*)(qbase + (qoff + ks * 16)); } }
        f32x16 O[2][4];
#pragma unroll
        for (int m = 0; m < 2; ++m)
#pragma unroll
            for (int et = 0; et < 4; ++et)
#pragma unroll
                for (int r = 0; r < 16; ++r) O[m][et][r] = 0.f;
        float lsum[2] = {0.f, 0.f};
        VM_WAIT(); __syncthreads();
        for (int kt = 0; kt < NKEY / 64; ++kt) {
            const int st = kt & 1;
            if (kt + 1 < NKEY / 64) attn_issue_tile(lds, st ^ 1, K0g + (size_t)(kt + 1) * 4096, K1g + (size_t)(kt + 1) * 4096, VTg + (size_t)(kt + 1) * 64, koff, voff0, voff1, wave);
            const LAS unsigned char* sb = lds + st * AT_STAGE;
#pragma unroll
            for (int k2 = 0; k2 < 2; ++k2) {
                bf16x8 pf[2][2];
#pragma unroll
                for (int m = 0; m < 2; ++m) {
                    f32x16 S;
#pragma unroll
                    for (int r = 0; r < 16; ++r) S[r] = 0.f;
                    const int key = k2 * 32 + ql;
#pragma unroll
                    for (int ks = 0; ks < 4; ++ks) { const bf16x8 kf = *(const LAS bf16x8*)(sb + m * 8192 + key * 128 + (((2 * ks + kg) ^ ((key >> 1) & 7)) << 4)); S = MFMA32(kf, qf[m][ks], S); }
                    float ps = 0.f;
#pragma unroll
                    for (int r = 0; r < 16; ++r) { S[r] = __builtin_amdgcn_exp2f(S[r]); ps += S[r]; }
                    lsum[m] += ps;
                    pf[m][0] = pack8(S, 0); pf[m][1] = pack8(S, 1);
                }
#pragma unroll
                for (int et = 0; et < 4; ++et) { const int e = et * 32 + ql;
#pragma unroll
                    for (int s2 = 0; s2 < 2; ++s2) { const bf16x8 vf = *(const LAS bf16x8*)(sb + 16384 + e * 128 + (((2 * (2 * k2 + s2) + kg) ^ ((e >> 1) & 7)) << 4));
                        O[0][et] = MFMA32(vf, pf[0][s2], O[0][et]); O[1][et] = MFMA32(vf, pf[1][s2], O[1][et]); } }
            }
            VM_WAIT(); __syncthreads();
        }
        const float l0 = lsum[0] + __shfl_xor(lsum[0], 32), l1 = lsum[1] + __shfl_xor(lsum[1], 32);
        const float i0 = 1.0f / l0, i1 = lam / l1;
        float ss = 0.f;
#pragma unroll
        for (int et = 0; et < 4; ++et)
#pragma unroll
            for (int r = 0; r < 16; ++r) { const float o = O[0][et][r] * i0 - O[1][et][r] * i1; O[0][et][r] = o; ss += o * o; }
        ss += __shfl_xor(ss, 32);
        const float rn = (1.0f / sqrtf(ss * (1.0f / 128.0f) + EPS)) * (1.0f - lam_init);
        int ql2 = ql, kg2 = kg; asm volatile("" : "+v"(ql2), "+v"(kg2));
        bf16_t* obase = AO + ((size_t)b * 8192 + t0) * 1024 + h * 128; const unsigned ooff = (unsigned)(ql2 * 1024 + 4 * kg2);
        const float* sg = a.in[I_DASUB];
#pragma unroll
        for (int et = 0; et < 4; ++et)
#pragma unroll
            for (int g4 = 0; g4 < 4; ++g4) { const int e0 = et * 32 + 8 * g4; const f32x4 gv = *(const f32x4*)(sg + (unsigned)(e0 + 4 * kg2));
                u32x2 w; w.x = pkbf(O[0][et][4 * g4] * rn * gv[0], O[0][et][4 * g4 + 1] * rn * gv[1]); w.y = pkbf(O[0][et][4 * g4 + 2] * rn * gv[2], O[0][et][4 * g4 + 3] * rn * gv[3]);
                *(u32x2*)(obase + (ooff + e0)) = w; }
    }
}
typedef unsigned u32x4a4 __attribute__((ext_vector_type(4), aligned(4)));
constexpr int CV_ZB = 25856;
DI int cv_pad(int y) { return y + ((y >> 7) << 3); }
DI void phase_hy_conv(const Args& a, LAS unsigned char* lds, int tid, int lane, int wave, int gw, int NGW) {
    const bf16_t* UT = (const bf16_t*)(a.ws + WS_BUF2); const bf16_t* UTC = UT + (size_t)3 * 2 * 1024 * 8192;
    bf16_t* Z2 = (bf16_t*)(a.ws + WS_BUF3); bf16_t* Z2C = Z2 + (size_t)2 * 1024 * 8192;
    const float* FSQP = (const float*)(a.ws + WS_FSQP);
    const bf16_t* RR = (const bf16_t*)(a.ws + WS_RR);
    const float* skip = a.in[I_HYSKIP];
    const int half = wave >> 2, w4 = wave & 3, htid = tid & 255;
    const int ql = lane & 31, kg = lane >> 5, bcol = ql >> 4, ii = ql & 15, i0 = 16 * w4;
    const int par = ql & 1;
    for (int u = blockIdx.x; u < 512; u += gridDim.x) {
        const int c = 2 * u + half;
        __syncthreads();
#pragma unroll
        for (int b = 0; b < 2; ++b) { LAS unsigned char* zb = lds + (half * 2 + b) * CV_ZB; const bf16_t* vsrc = UT + ((size_t)(0 * 2 + b) * 1024 + c) * 8192;
            for (int ch = htid; ch < 1520; ch += 256) { const int y = ch * 8; u32x4 w = (u32x4){0u, 0u, 0u, 0u};
                if (y >= 1920 && y < 1920 + 8192) w = *(const u32x4*)(vsrc + (y - 1920));
                *(LAS u32x4*)(zb + cv_pad(y) * 2) = w; } }
        float scl[2];
#pragma unroll
        for (int o = 0; o < 2; ++o) { float s = 0.f;
#pragma unroll
            for (int k = 0; k < 2; ++k) { const int tb = lane + 64 * k; s += FSQP[(size_t)tb * 4096 + o * 2048 + c] + FSQP[(size_t)tb * 4096 + o * 2048 + 1024 + c]; }
            scl[o] = 1.0f / sqrtf(wave_sum(s) + EPS); }
        __syncthreads();
        const LAS unsigned char* zrd = lds + (half * 2 + bcol) * CV_ZB;
        const int ybase = 128 * ii + 8 * kg;
#pragma unroll 1
        for (int o = 0; o < 2; ++o) {
            const bf16_t* rp = RR + ((size_t)par * 2048 + o * 1024 + c) * RRS + (6272 - 128 * i0 + 8 * kg - ql - par);
            f32x16 acc[4];
#pragma unroll
            for (int mt = 0; mt < 4; ++mt)
#pragma unroll
                for (int r = 0; r < 16; ++r) acc[mt][r] = 0.f;
            bf16x8 F[16];
#pragma unroll
            for (int ks = -6; ks < 8; ++ks) F[ks & 15] = __builtin_bit_cast(bf16x8, *(const u32x4a4*)(rp + 16 * ks));
#pragma unroll 1
            for (int it = 0; it < 40; ++it) {
#pragma unroll
                for (int j = 0; j < 16; ++j) {
                    const int ks = it * 16 + j;
                    F[(j + 8) & 15] = __builtin_bit_cast(bf16x8, *(const u32x4a4*)(rp + 16 * (ks + 8)));
                    const int y = ybase + 16 * ks;
                    const bf16x8 Bf = *(const LAS bf16x8*)(zrd + cv_pad(y) * 2);
                    acc[0] = MFMA32(F[j], Bf, acc[0]);
                    acc[1] = MFMA32(F[(j + 14) & 15], Bf, acc[1]);
                    acc[2] = MFMA32(F[(j + 12) & 15], Bf, acc[2]);
                    acc[3] = MFMA32(F[(j + 10) & 15], Bf, acc[3]);
                }
            }
            const float sk = skip[o * 1024 + c], sc = o == 0 ? scl[0] : scl[1];
            const bf16_t* gsrc = UT + ((size_t)((1 + o) * 2 + bcol) * 1024 + c) * 8192;
            LAS unsigned char* zw = lds + (half * 2 + bcol) * CV_ZB;
            if (o == 0) __syncthreads();
#pragma unroll
            for (int mt = 0; mt < 4; ++mt)
#pragma unroll
                for (int g4 = 0; g4 < 4; ++g4) {
                    const int t4 = 128 * (i0 + ii) + 32 * mt + 8 * g4 + 4 * kg;
                    const u32x2 gw2 = *(const u32x2*)(gsrc + t4);
                    LAS u32x2* zp = (LAS u32x2*)(zw + cv_pad(t4 + 1920) * 2);
                    const u32x2 zo = *zp;
                    const float r0 = bflo(gw2.x) * (acc[mt][4 * g4] * sc + sk * bflo(zo.x)), r1 = bfhi(gw2.x) * (acc[mt][4 * g4 + 1] * sc + sk * bfhi(zo.x));
                    const float r2 = bflo(gw2.y) * (acc[mt][4 * g4 + 2] * sc + sk * bflo(zo.y)), r3 = bfhi(gw2.y) * (acc[mt][4 * g4 + 3] * sc + sk * bfhi(zo.y));
                    u32x2 w; w.x = pkbf(r0, r1); w.y = pkbf(r2, r3);
                    if (o == 0) *zp = w;
                    else *(u32x2*)(Z2 + ((size_t)bcol * 1024 + c) * 8192 + t4) = w;
                }
            if (o == 0) __syncthreads();
        }
    }
    __syncthreads();
    {
        const float* RRC = (const float*)(a.ws + WS_RRC);
        LAS float* zc = (LAS float*)(lds + wave * 6144);
        LAS float* rc = zc + 512;
        for (int c = gw; c < 1024; c += NGW) {
            float scl[2];
#pragma unroll
            for (int o = 0; o < 2; ++o) { float s = 0.f; if (lane < 4) s = FSQP[(size_t)(128 + lane) * 4096 + o * 2048 + c] + FSQP[(size_t)(128 + lane) * 4096 + o * 2048 + 1024 + c]; scl[o] = 1.0f / sqrtf(wave_sum(s) + EPS); }
            for (int k = lane; k < 1024; k += 64) { const int o = k >> 9, idx = k & 511; rc[k] = idx == 0 ? 0.f : RRC[(size_t)(o * 1024 + c) * 512 + idx]; }
            for (int k = lane; k < 512; k += 64) { const int b = k >> 8, t = k & 255; zc[k] = bf1(UTC[((size_t)(0 * 2 + b) * 1024 + c) * 256 + t]); }
            LDS_WAIT(); __builtin_amdgcn_wave_barrier();
#pragma unroll 1
            for (int o = 0; o < 2; ++o) {
                float y[2][4];
#pragma unroll
                for (int b = 0; b < 2; ++b)
#pragma unroll
                    for (int j = 0; j < 4; ++j) y[b][j] = 0.f;
                for (int s = 0; s < 256; ++s) { const float z0 = zc[s], z1 = zc[256 + s];
#pragma unroll
                    for (int j = 0; j < 4; ++j) { const float rv = rc[o * 512 + s - (lane + 64 * j) + 256]; y[0][j] += rv * z0; y[1][j] += rv * z1; } }
                float zn[2][4];
                const float sk = skip[o * 1024 + c];
#pragma unroll
                for (int b = 0; b < 2; ++b)
#pragma unroll
                    for (int j = 0; j < 4; ++j) { const int t = lane + 64 * j; const float g = bf1(UTC[((size_t)((1 + o) * 2 + b) * 1024 + c) * 256 + t]); zn[b][j] = g * (y[b][j] * (o == 0 ? scl[0] : scl[1]) + sk * zc[b * 256 + t]); }
                LDS_WAIT(); __builtin_amdgcn_wave_barrier();
#pragma unroll
                for (int b = 0; b < 2; ++b)
#pragma unroll
                    for (int j = 0; j < 4; ++j) { const int t = lane + 64 * j; if (o == 0) zc[b * 256 + t] = zn[b][j]; else Z2C[((size_t)b * 1024 + c) * 256 + t] = f2bf1(zn[b][j]); }
                LDS_WAIT(); __builtin_amdgcn_wave_barrier();
            }
        }
    }
}
constexpr int NPHASE = 43;
template <int LAYER, int PH0, class BarT> DI void moe_block(const Args& a, LAS unsigned char* lds, const BarT& bar, int lo, int hi, int wave, int gw, int NGW) {
    constexpr int MT = (LAYER >= 2) ? 8 : 9;
    unsigned char* ws = a.ws;
#define PH_BEGIN(k) if (lo <= (k) && (k) < hi) { const int lane = lane_id(); const int tid = wave * 64 + lane; (void)tid; (void)lane;
#define PH_END(k) if ((k) + 1 < hi) xcd_barrier(bar); }
    PH_BEGIN(PH0 + 0) phase_moe_prep<LAYER>(a, lds, tid, lane, gw, NGW); __syncthreads(); PH_END(PH0 + 0)
    PH_BEGIN(PH0 + 1) phase_topk<LAYER>(a, lds, tid, lane, wave); PH_END(PH0 + 1)
    PH_BEGIN(PH0 + 2) phase_gather<LAYER>(a, lane, gw, NGW); PH_END(PH0 + 2)
    PH_BEGIN(PH0 + 3) {
        pg8::Gemm g{(const bf16_t*)(ws + WS_BUF1), (const bf16_t*)(ws + WS_WGU) + (size_t)LAYER * 16 * 4096 * 1024, 16 * EROWS, 16 * 4096, 1024};
        pg8::MoeOrder S{MT, 16, (int)gridDim.x, (int)blockIdx.x}; pg8::EpiSwiGLU E{(bf16_t*)(ws + WS_BUF2)};
        pg8::gemm_phase<pg8::EpiSwiGLU, pg8::MoeOrder, false>(lds, g, S, E, nullptr, wave); } PH_END(PH0 + 3)
    PH_BEGIN(PH0 + 4) {
        pg8::Gemm g{(const bf16_t*)(ws + WS_BUF2), (const bf16_t*)(ws + WS_WDN) + (size_t)LAYER * 16 * 1024 * 2048, 16 * EROWS, 16 * 1024, 2048};
        pg8::MoeOrder S{MT, 4, (int)gridDim.x, (int)blockIdx.x}; pg8::EpiDown E{(bf16_t*)(ws + WS_Y), (const float*)(ws + WS_SELG)};
        pg8::gemm_phase<pg8::EpiDown, pg8::MoeOrder, false>(lds, g, S, E, nullptr, wave); } PH_END(PH0 + 4)
}
template <int LAYER, int J, int PH0, class BarT> DI void sg_block(const Args& a, LAS unsigned char* lds, const BarT& bar, int lo, int hi, int wave) {
    constexpr int M = (LAYER == 3) ? TX : TR, NCHUNK = M / 128;
    unsigned char* ws = a.ws;
    PH_BEGIN(PH0 + 0) {
        pg8::Gemm g{(const bf16_t*)(ws + WS_H), (const bf16_t*)(ws + WS_WSGIN) + (size_t)J * 4096 * 1024, M, 4096, 1024};
        pg8::StaticOrder S; S.init(M, 4096, (int)gridDim.x, (int)blockIdx.x);
        pg8::EpiBf16<1> E{(bf16_t*)(ws + WS_BUF1), 4096, a.in[I_SGBIN] + J * 4096, 0, 0};
        pg8::gemm_phase<pg8::EpiBf16<1>, pg8::StaticOrder, false>(lds, g, S, E, nullptr, wave); } PH_END(PH0 + 0)
    PH_BEGIN(PH0 + 1) phase_sg_vnt<J, NCHUNK>(a, lds, tid, lane, wave); PH_END(PH0 + 1)
    PH_BEGIN(PH0 + 2) {
        pg8::Gemm g{(const bf16_t*)(ws + WS_WSBD) + (size_t)J * 4 * 256 * 256, (const bf16_t*)(ws + WS_BUF2), 1024, NCHUNK * 4 * 256, 256};
        pg8::SpatOrder S{NCHUNK * 4, (int)gridDim.x, (int)blockIdx.x};
        pg8::EpiSpat E{(bf16_t*)(ws + WS_BUF3), (const bf16_t*)(ws + WS_BUF1), a.in[I_SGBS] + J * 8 * 128};
        pg8::gemm_phase<pg8::EpiSpat, pg8::SpatOrder, false>(lds, g, S, E, nullptr, wave); } PH_END(PH0 + 2)
    PH_BEGIN(PH0 + 3) {
        pg8::Gemm g{(const bf16_t*)(ws + WS_BUF3), (const bf16_t*)(ws + WS_WSGOUT) + (size_t)J * 1024 * 2048, M, 1024, 2048};
        pg8::StaticOrder S; S.init(M, 1024, (int)gridDim.x, (int)blockIdx.x);
        pg8::EpiRes E{(float*)(ws + WS_X), a.in[I_SGBOUT] + J * 1024, modp(a, LAYER, 0, 2)};
        pg8::gemm_phase<pg8::EpiRes, pg8::StaticOrder, false>(lds, g, S, E, nullptr, wave); } PH_END(PH0 + 3)
}

__global__ void __launch_bounds__(NTHR, 2) mk_fwd(Args a) {
    extern __shared__ __attribute__((aligned(16))) unsigned char lds_raw[];
    LAS unsigned char* lds = (LAS unsigned char*)lds_raw;
    const int wave = __builtin_amdgcn_readfirstlane((int)threadIdx.x >> 6);
    const int G = gridDim.x, gw = blockIdx.x * NWAVES + wave, NGW = G * NWAVES;
    volatile LAS unsigned* MISC = (volatile LAS unsigned*)(lds + MISC_OFF);
    if (threadIdx.x < 32) MISC[threadIdx.x] = 0u;
    __syncthreads();
    unsigned char* ws = a.ws;
    XcdBarrier bar = xcd_barrier_post((unsigned*)(ws + WS_CTL) + CW_BAR, MISC + 8);
    const int lo = a.ph_lo, hi = a.ph_hi;

    PH_BEGIN(0)
        pro0_mod(a, lds, tid, lane, wave);
        pro0_small(a, blockIdx.x * NTHR + tid, G * NTHR);
        pro0_filter1(a, lane, gw, NGW);
        __syncthreads();
        pro0_convert(a, lds, lane, wave, gw, NGW);
        __syncthreads();
    PH_END(0)
    PH_BEGIN(1)
        phase_A<0>(a, lane, gw, NGW);
        pro1_filter2(a, lds, tid, lane, wave); __syncthreads();
    PH_END(1)
    sg_block<0, 0, 2>(a, lds, bar, lo, hi, wave);
    moe_block<0, 6>(a, lds, bar, lo, hi, wave, gw, NGW);
    PH_BEGIN(11) phase_A<1>(a, lane, gw, NGW); PH_END(11)
    PH_BEGIN(12) {
        pg8::Gemm g{(const bf16_t*)(ws + WS_H), (const bf16_t*)(ws + WS_WHYIN), TR, 3072, 1024};
        pg8::StaticOrder S; S.init(TR, 3072, G, (int)blockIdx.x);
        pg8::EpiBf16<0> E{(bf16_t*)(ws + WS_BUF1), 3072, a.in[I_HYBIN], 0, 0};
        pg8::gemm_phase<pg8::EpiBf16<0>, pg8::StaticOrder, false>(lds, g, S, E, nullptr, wave); } PH_END(12)
    PH_BEGIN(13) phase_hy_shortconv(a, lds, tid); PH_END(13)
    PH_BEGIN(14) phase_hy_conv(a, lds, tid, lane, wave, gw, NGW); __syncthreads(); PH_END(14)
    PH_BEGIN(15) phase_hy_transpose(a, lds, lane, wave, gw, NGW); __syncthreads(); PH_END(15)
    PH_BEGIN(16) {
        pg8::Gemm g{(const bf16_t*)(ws + WS_H), (const bf16_t*)(ws + WS_WHYOUT), TR, 1024, 1024};
        pg8::StaticOrder S; S.init(TR, 1024, G, (int)blockIdx.x);
        pg8::EpiRes E{(float*)(ws + WS_X), a.in[I_HYBOUT], modp(a, 1, 0, 2)};
        pg8::gemm_phase<pg8::EpiRes, pg8::StaticOrder, false>(lds, g, S, E, nullptr, wave); } PH_END(16)
    moe_block<1, 17>(a, lds, bar, lo, hi, wave, gw, NGW);
    PH_BEGIN(22) phase_A<2>(a, lane, gw, NGW); PH_END(22)
    PH_BEGIN(23) {
        pg8::Gemm g{(const bf16_t*)(ws + WS_H), (const bf16_t*)(ws + WS_WDAIN), TR, 3072, 1024};
        pg8::StaticOrder S; S.init(TR, 3072, G, (int)blockIdx.x);
        pg8::EpiBf16<0> E{(bf16_t*)(ws + WS_BUF1), 3072, nullptr, 0, 0};
        pg8::gemm_phase<pg8::EpiBf16<0>, pg8::StaticOrder, false>(lds, g, S, E, nullptr, wave); } PH_END(23)
    PH_BEGIN(24) phase_da_prep(a, lds, tid); PH_END(24)
    PH_BEGIN(25) phase_attn(a, lds, tid, lane, wave); __syncthreads(); PH_END(25)
    PH_BEGIN(26) {
        pg8::Gemm g{(const bf16_t*)(ws + WS_BUF3), (const bf16_t*)(ws + WS_WDAOUT), TX, 1024, 1024};
        pg8::StaticOrder S; S.init(TX, 1024, G, (int)blockIdx.x);
        pg8::EpiRes E{(float*)(ws + WS_X), nullptr, modp(a, 2, 0, 2)};
        pg8::gemm_phase<pg8::EpiRes, pg8::StaticOrder, false>(lds, g, S, E, nullptr, wave); } PH_END(26)
    moe_block<2, 27>(a, lds, bar, lo, hi, wave, gw, NGW);
    PH_BEGIN(32) phase_A<3>(a, lane, gw, NGW); PH_END(32)
    sg_block<3, 1, 33>(a, lds, bar, lo, hi, wave);
    moe_block<3, 37>(a, lds, bar, lo, hi, wave, gw, NGW);
    PH_BEGIN(42) phase_A<4>(a, lane, gw, NGW); PH_END(42)
}

extern "C" void kernel_launch(void* const* d_in, const int* in_sizes, int n_in, void* d_out, int out_size, void* d_ws, size_t ws_size, hipStream_t stream) {
    static int grid = 0;
    if (grid == 0) {
        if (n_in != N_IN || out_size != TX * D || ws_size < WS_END) { fprintf(stderr, "kernel_launch: unexpected problem (n_in %d, out %d, ws %zu < %zu)\n", n_in, out_size, ws_size, (size_t)WS_END); grid = -1; return; }
        int dev = 0, cus = 0, per_cu = 0;
        if (hipGetDevice(&dev) != hipSuccess || hipDeviceGetAttribute(&cus, hipDeviceAttributeMultiprocessorCount, dev) != hipSuccess) { grid = -1; return; }
        if (hipFuncSetAttribute((const void*)mk_fwd, hipFuncAttributeMaxDynamicSharedMemorySize, LDS_BYTES) != hipSuccess) { fprintf(stderr, "kernel_launch: hipFuncSetAttribute failed\n"); grid = -1; return; }
        if (hipOccupancyMaxActiveBlocksPerMultiprocessor(&per_cu, (const void*)mk_fwd, NTHR, LDS_BYTES) != hipSuccess || per_cu < 1)
            fprintf(stderr, "kernel_launch: occupancy query reports %d workgroups per CU\n", per_cu);
        (void)hipGetLastError();
        grid = cus;
    }
    if (grid < 0) return;
    if (hipMemsetAsync((char*)d_ws + WS_CTL, 0, CTL_ZERO_BYTES, stream) != hipSuccess) return;
    Args a{};
    for (int i = 0; i < N_IN; ++i) a.in[i] = (const float*)d_in[i];
    a.out = (float*)d_out; a.ws = (unsigned char*)d_ws;
#if MK_LAUNCHES == 1
    a.ph_lo = 0; a.ph_hi = NPHASE;
    hipLaunchKernelGGL(mk_fwd, dim3(grid), dim3(NTHR), LDS_BYTES, stream, a);
#else
    for (int p = 0; p < NPHASE; ++p) { a.ph_lo = p; a.ph_hi = p + 1; hipLaunchKernelGGL(mk_fwd, dim3(grid), dim3(NTHR), LDS_BYTES, stream, a); }
#endif
}
```

```cpp
#include <hip/hip_runtime.h>
#include <stdint.h>
#include <stdio.h>
#include <math.h>

#ifndef MK_LAUNCHES
#define MK_LAUNCHES 1
#endif

#define GAS __attribute__((address_space(1)))
#define LAS __attribute__((address_space(3)))
typedef unsigned short bf16_t;
typedef float f32x4 __attribute__((ext_vector_type(4)));
typedef float f32x2 __attribute__((ext_vector_type(2)));
typedef float f32x16 __attribute__((ext_vector_type(16)));
typedef unsigned u32x4 __attribute__((ext_vector_type(4)));
typedef unsigned u32x2 __attribute__((ext_vector_type(2)));
typedef short bf16x8 __attribute__((ext_vector_type(8)));
#define DI __device__ __forceinline__

DI unsigned pkbf(float lo, float hi) { unsigned r; asm volatile("v_cvt_pk_bf16_f32 %0, %1, %2" : "=v"(r) : "v"(lo), "v"(hi)); return r; }
DI float bflo(unsigned w) { return __uint_as_float(w << 16); }
DI float bfhi(unsigned w) { return __uint_as_float(w & 0xffff0000u); }
DI float bf1(bf16_t h) { return __uint_as_float(((unsigned)h) << 16); }
DI bf16_t f2bf1(float f) { return (bf16_t)(pkbf(f, 0.f) & 0xffffu); }
template <int CTRL> DI float dppf(float v) { return __builtin_bit_cast(float, __builtin_amdgcn_update_dpp(0, __builtin_bit_cast(int, v), CTRL, 0xf, 0xf, true)); }
#define DPP_XOR1 0xB1
#define DPP_XOR2 0x4E
#define DPP_ROR(n) (0x120 + (n))
DI float row_sum16(float v) { v += dppf<DPP_ROR(8)>(v); v += dppf<DPP_ROR(4)>(v); v += dppf<DPP_ROR(2)>(v); v += dppf<DPP_ROR(1)>(v); return v; }
DI float row_max16(float v) { v = fmaxf(v, dppf<DPP_ROR(8)>(v)); v = fmaxf(v, dppf<DPP_ROR(4)>(v)); v = fmaxf(v, dppf<DPP_ROR(2)>(v)); v = fmaxf(v, dppf<DPP_ROR(1)>(v)); return v; }
DI float rlane(float v, int l) { return __builtin_bit_cast(float, __builtin_amdgcn_readlane(__builtin_bit_cast(int, v), l)); }
DI float wave_sum(float v) { v = row_sum16(v); return (rlane(v, 0) + rlane(v, 16)) + (rlane(v, 32) + rlane(v, 48)); }
DI float wave_max(float v) { v = row_max16(v); return fmaxf(fmaxf(rlane(v, 0), rlane(v, 16)), fmaxf(rlane(v, 32), rlane(v, 48))); }
DI int lane_id() { int l; asm volatile("v_mbcnt_lo_u32_b32 %0, -1, 0\n\tv_mbcnt_hi_u32_b32 %0, -1, %0" : "=v"(l)); return l; }
#define MFMA32(a, b, c) __builtin_amdgcn_mfma_f32_32x32x16_bf16((a), (b), (c), 0, 0, 0)
#define LDS_WAIT() asm volatile("s_waitcnt lgkmcnt(0)" ::: "memory")
#define VM_WAIT() asm volatile("s_waitcnt vmcnt(0)" ::: "memory")

#define XB_TMO      128
#define XB_XCNT(j)  (256  + 64 * (j))
#define XB_XSUB(j)  (1280 + 64 * (j))
#define XB_XGEN(j)  (2304 + 64 * (j))
#define XB_TOP      3328
#define XB_TOPGEN   3392
#define XCD_BAR_WORDS 3456
#define XB_SPIN_CAP (1u << 18)
__device__ __forceinline__ unsigned xb_ld(unsigned* p)              { return __hip_atomic_load(p, __ATOMIC_RELAXED, __HIP_MEMORY_SCOPE_AGENT); }
__device__ __forceinline__ unsigned xb_add(unsigned* p, unsigned v) { return __hip_atomic_fetch_add(p, v, __ATOMIC_RELAXED, __HIP_MEMORY_SCOPE_AGENT); }
__device__ __forceinline__ unsigned xb_xcc_id() { return (unsigned)__builtin_amdgcn_s_getreg((3 << 11) | 20) & 0xFu; }
#define XB_SPIN(cond, bar) do { unsigned _sp = 0; while (cond) { __builtin_amdgcn_s_sleep(1); \
    if ((++_sp & 255u) == 0u) { if (xb_ld(&(bar)[XB_TMO])) break; if (_sp > XB_SPIN_CAP) { atomicAdd(&(bar)[XB_TMO], 1u); break; } } } } while (0)
struct XcdBarrier { unsigned* bar; unsigned x; volatile LAS unsigned* st; };
__device__ __forceinline__ XcdBarrier xcd_barrier_post(unsigned* bar, volatile LAS unsigned* st) {
    XcdBarrier b; b.bar = bar; b.x = xb_xcc_id(); b.st = st;
    if (threadIdx.x == 0) (void)xb_add(&bar[XB_XCNT(b.x)], 1u);
    return b;
}
__device__ __forceinline__ void xcd_barrier_complete(unsigned* bar, unsigned x, unsigned& nloc, unsigned& nx) {
    const unsigned G = gridDim.x * gridDim.y * gridDim.z;
    unsigned sum, cnt, mine, sp = 0u;
    for (;;) {
        sum = 0u; cnt = 0u; mine = 0u;
#pragma unroll
        for (unsigned j = 0; j < 16; ++j) { const unsigned c = xb_ld(&bar[XB_XCNT(j)]); sum += c; cnt += (c > 0u) ? 1u : 0u; mine = (j == x) ? c : mine; }
        if (sum == G) break;
        __builtin_amdgcn_s_sleep(1);
        if ((++sp & 255u) == 0u) { if (xb_ld(&bar[XB_TMO])) break; if (sp > XB_SPIN_CAP) { atomicAdd(&bar[XB_TMO], 1u); break; } }
    }
    nloc = mine > 0u ? mine : 1u; nx = cnt > 0u ? cnt : 1u;
}
__device__ __forceinline__ void xcd_barrier(const XcdBarrier& b) {
    asm volatile("s_waitcnt vmcnt(0)" ::: "memory");
    __syncthreads();
    if (threadIdx.x == 0) {
        unsigned* bar = b.bar;
        __builtin_amdgcn_s_waitcnt(0);
        unsigned nloc = b.st[0], nx = b.st[1];
        if (nloc == 0u) { xcd_barrier_complete(bar, b.x, nloc, nx); b.st[0] = nloc; b.st[1] = nx; }
        const unsigned old = xb_add(&bar[XB_XSUB(b.x)], 1u);
        const unsigned gen = old / nloc;
        if (old + 1u == (gen + 1u) * nloc) {
            __builtin_amdgcn_fence(__ATOMIC_RELEASE, "agent");
            asm volatile("s_waitcnt vmcnt(0)" ::: "memory");
            const unsigned og = xb_add(&bar[XB_TOP], 1u);
            const unsigned tg = og / nx;
            if (og + 1u == (tg + 1u) * nx) xb_add(&bar[XB_TOPGEN], 1u);
            else XB_SPIN(xb_ld(&bar[XB_TOPGEN]) == tg, bar);
            __builtin_amdgcn_fence(__ATOMIC_ACQUIRE, "agent");
            xb_add(&bar[XB_XGEN(b.x)], 1u);
            asm volatile("s_waitcnt vmcnt(0)" ::: "memory");
        } else {
            XB_SPIN(xb_ld(&bar[XB_XGEN(b.x)]) == gen, bar);
            __builtin_amdgcn_fence(__ATOMIC_ACQUIRE, "agent");
            asm volatile("s_waitcnt vmcnt(0)" ::: "memory");
        }
    }
    __syncthreads();
}
namespace pg8 {
#define PG8_LAS __attribute__((address_space(3)))
typedef unsigned short bf16_t;
typedef short bf16x8 __attribute__((ext_vector_type(8)));
typedef float f32x4 __attribute__((ext_vector_type(4)));
typedef unsigned u32x4 __attribute__((ext_vector_type(4)));
constexpr int BM = 256, BK = 64, HALF = 128, HTB = HALF * BK * 2  , STAGE_BYTES = 8 * HTB, NXCD = 8, WGM = 8;

__host__ __device__ __forceinline__ int lds_byte(int r, int c) { const int st = (r >> 4) * 2 + (c >> 5), rr = r & 15, cc = c & 31, ob = rr * 64 + cc * 2; return st * 1024 + (ob ^ (((ob >> 9) & 1) << 5)); }
__host__ __device__ __forceinline__ void stage_rc(int b, int& R, int& C) { const int st = b / 1024, sb = b % 1024, swz = sb ^ (((sb >> 9) & 1) << 5); R = (st >> 1) * 16 + swz / 64; C = (st & 1) * 32 + (swz % 64) / 2; }
__host__ __device__ __forceinline__ int perm32(int rho) { const int n = rho >> 4, i = rho & 15; return 8 * (i >> 2) + 4 * n + (i & 3); }

struct Unit { int pm, pn; };
struct Gemm { const bf16_t* A; const bf16_t* Bt; int M, N, K; const int* aidx; };

struct StaticOrder {
    int nM, nN, nwg, G, c;
    __host__ __device__ void init(int M, int N, int G_, int c_) { nM = M / BM; nN = N / BM; nwg = nM * nN; G = G_; c = c_; }
    __host__ __device__ bool next(int i, Unit& u) const {
        const long L = (long)i * G + c; if (L >= nwg) return false;
        int wgid = (int)L; { const int q = nwg / NXCD, r = nwg % NXCD, xcd = wgid % NXCD, off = wgid / NXCD; wgid = (xcd < r ? xcd * (q + 1) : r * (q + 1) + (xcd - r) * q) + off; }
        const int nig = WGM * nN, gid = wgid / nig, fm = gid * WGM, gsz = (nM - fm) < WGM ? (nM - fm) : WGM;
        u.pm = fm + ((wgid % nig) % gsz); u.pn = (wgid % nig) / gsz; return true;
    }
    __device__ __forceinline__ void a_ready(const Unit&) const {}
    __device__ __forceinline__ void done(const Unit&) const {}
};
struct CountedOrder : StaticOrder {
    const unsigned* ready; unsigned need; unsigned* tmo;
    __device__ __forceinline__ void a_ready(const Unit& u) const {
        if (threadIdx.x < 64) {
            const unsigned long long t0 = __builtin_amdgcn_s_memrealtime(); unsigned polls = 0;
            while ((unsigned)__builtin_amdgcn_readfirstlane(__hip_atomic_load(ready + 64 * u.pm, __ATOMIC_RELAXED, __HIP_MEMORY_SCOPE_AGENT)) < need) {
                if ((++polls & 255u) == 0u && __builtin_amdgcn_readfirstlane(__hip_atomic_load(tmo, __ATOMIC_RELAXED, __HIP_MEMORY_SCOPE_AGENT)) != 0u) break;
                if (__builtin_amdgcn_s_memrealtime() - t0 > 2000000ull) {
                    if (threadIdx.x == 0) { unsigned expect = 0u; __hip_atomic_compare_exchange_strong(tmo + 1, &expect, 0x600u | (unsigned)(u.pm & 0xff), __ATOMIC_RELAXED, __ATOMIC_RELAXED, __HIP_MEMORY_SCOPE_AGENT); __hip_atomic_store(tmo, 1u, __ATOMIC_RELAXED, __HIP_MEMORY_SCOPE_AGENT); }
                    break; }
                __builtin_amdgcn_s_sleep(2); }
            __builtin_amdgcn_fence(__ATOMIC_ACQUIRE, "agent");
            asm volatile("s_waitcnt vmcnt(0)" ::: "memory");
        }
#if !defined(BROKEN_HOOK_NO_BARRIER)
        asm volatile("" ::: "memory"); __builtin_amdgcn_s_barrier(); asm volatile("" ::: "memory");
#endif
    }
};

__device__ __forceinline__ unsigned cvt_pk_bf16(float lo, float hi) { unsigned r; asm volatile("v_cvt_pk_bf16_f32 %0, %1, %2" : "=v"(r) : "v"(lo), "v"(hi)); return r; }
typedef float f32x2 __attribute__((ext_vector_type(2)));
__device__ __forceinline__ f32x2 gelu_pk(f32x2 v) {
    const f32x2 av = __builtin_elementwise_abs(v), d = av * 0.2316418882f + 1.0f;
    f32x2 t; t.x = __builtin_amdgcn_rcpf(d.x); t.y = __builtin_amdgcn_rcpf(d.y);
    f32x2 q = t * 0.5307027145f + (-0.7265760135f); q = q * t + 0.7107068705f; q = q * t + (-0.142248368f); q = q * t + 0.127414796f; q = q * t;
    const f32x2 s = (v * v) * (-0.72134752044f);
    f32x2 e; e.x = __builtin_amdgcn_exp2f(s.x); e.y = __builtin_amdgcn_exp2f(s.y);
    const f32x2 m = v * (q * e), r = v - m;
    f32x2 o; o.x = v.x < 0.f ? m.x : r.x; o.y = v.y < 0.f ? m.y : r.y; return o;
}

struct EpiF32 {
    static constexpr bool PERM = false, AFTER_DRAIN = false;
    float* C; int ldc; const float* bias;
    __device__ __forceinline__ void operator()(const f32x4 (&acc)[2][2][4][2], const Unit& u, int wr, int wc, int fr, int fq) const {
        const int row0 = u.pm * BM + wr * 64 + fr, col0 = u.pn * BM + wc * 32 + 4 * fq;
        f32x4 bv[2][2];
#pragma unroll
        for (int bj = 0; bj < 2; ++bj)
#pragma unroll
            for (int n = 0; n < 2; ++n) bv[bj][n] = bias ? *(const f32x4*)(bias + col0 + bj * HALF + n * 16) : (f32x4){0.f, 0.f, 0.f, 0.f};
#pragma unroll
        for (int ai = 0; ai < 2; ++ai)
#pragma unroll
            for (int m = 0; m < 4; ++m) { float* rowp = C + (size_t)(row0 + ai * HALF + m * 16) * ldc + col0;
#pragma unroll
                for (int bj = 0; bj < 2; ++bj)
#pragma unroll
                    for (int n = 0; n < 2; ++n) *(f32x4*)(rowp + bj * HALF + n * 16) = acc[ai][bj][m][n] + bv[bj][n]; }
    }
};
template <int ACT  > struct EpiBf16 {
    static constexpr bool PERM = true, AFTER_DRAIN = false;
    bf16_t* O; int ldc; const float* bias; int split_cols; size_t split_stride;
    float* vsq; int vsq_col0;
    __device__ __forceinline__ void operator()(const f32x4 (&acc)[2][2][4][2], const Unit& u, int wr, int wc, int fr, int fq) const {
        const int row0 = u.pm * BM + wr * 64 + fr; int colt = u.pn * BM; bf16_t* base = O;
        if (split_cols) { const int t = colt / split_cols; base += (size_t)t * split_stride; colt -= t * split_cols; }
        const int col0 = colt + wc * 32 + 8 * fq, bcol0 = u.pn * BM + wc * 32 + 8 * fq;
        f32x4 bv[2][2];
#pragma unroll
        for (int bj = 0; bj < 2; ++bj)
#pragma unroll
            for (int n = 0; n < 2; ++n) bv[bj][n] = bias ? *(const f32x4*)(bias + bcol0 + bj * HALF + 4 * n) : (f32x4){0.f, 0.f, 0.f, 0.f};
        const bool dosq = vsq != nullptr && u.pn * BM >= vsq_col0;
#pragma unroll
        for (int ai = 0; ai < 2; ++ai)
#pragma unroll
            for (int m = 0; m < 4; ++m) { bf16_t* rowp = base + (size_t)(row0 + ai * HALF + m * 16) * ldc + col0; float ss = 0.f;
#pragma unroll
                for (int bj = 0; bj < 2; ++bj) { f32x4 v0 = acc[ai][bj][m][0] + bv[bj][0], v1 = acc[ai][bj][m][1] + bv[bj][1];
                    if (ACT == 1) { f32x2 a = gelu_pk((f32x2){v0[0], v0[1]}), b = gelu_pk((f32x2){v0[2], v0[3]}), c = gelu_pk((f32x2){v1[0], v1[1]}), d = gelu_pk((f32x2){v1[2], v1[3]});
                        v0 = (f32x4){a.x, a.y, b.x, b.y}; v1 = (f32x4){c.x, c.y, d.x, d.y}; }
                    if (ACT == 2) {
#pragma unroll
                        for (int j = 0; j < 4; ++j) { v0[j] = 0.5f * v0[j] * (1.0f + erff(v0[j] * 0.70710678f)); v1[j] = 0.5f * v1[j] * (1.0f + erff(v1[j] * 0.70710678f)); } }
                    ss += ((v0[0] * v0[0] + v0[1] * v0[1]) + (v0[2] * v0[2] + v0[3] * v0[3])) + ((v1[0] * v1[0] + v1[1] * v1[1]) + (v1[2] * v1[2] + v1[3] * v1[3]));
                    u32x4 w; w.x = cvt_pk_bf16(v0[0], v0[1]); w.y = cvt_pk_bf16(v0[2], v0[3]); w.z = cvt_pk_bf16(v1[0], v1[1]); w.w = cvt_pk_bf16(v1[2], v1[3]);
                    *(u32x4*)(rowp + bj * HALF) = w; }
                if (dosq) { ss += __shfl_xor(ss, 16); ss += __shfl_xor(ss, 32);
                    if (fq == 0) vsq[(size_t)(row0 + ai * HALF + m * 16) * 32 + ((u.pn * BM - vsq_col0) >> 8) * 4 + wc] = ss; } }
    }
};

struct PanelStats {
    unsigned* xbuf;
    unsigned* cnt;
    unsigned* tmo;
    int ntn; float eps;
    unsigned code;
    __device__ __forceinline__ bool run(const f32x4 (&v)[2][2][4][2], const Unit& u, int wr, int wc, int fr, int fq, PG8_LAS unsigned char* lds, int wid, int lane) const {
        typedef float f32x2v __attribute__((ext_vector_type(2)));
        PG8_LAS f32x2v* P = (PG8_LAS f32x2v*)lds;
        PG8_LAS f32x2v* S = (PG8_LAS f32x2v*)(lds + 8192);
        PG8_LAS unsigned* flag = (PG8_LAS unsigned*)(lds + 8192 + 2048);
#pragma unroll
        for (int ai = 0; ai < 2; ++ai)
#pragma unroll
            for (int m = 0; m < 4; ++m) {
                float s = 0.f;
#pragma unroll
                for (int bj = 0; bj < 2; ++bj)
#pragma unroll
                    for (int n = 0; n < 2; ++n) { const f32x4 x = v[ai][bj][m][n]; s += (x[0] + x[1]) + (x[2] + x[3]); }
                s += __shfl_xor(s, 16); s += __shfl_xor(s, 32);
                const float mw = s * (1.0f / 64.0f); float q = 0.f;
#pragma unroll
                for (int bj = 0; bj < 2; ++bj)
#pragma unroll
                    for (int n = 0; n < 2; ++n) { const f32x4 d = v[ai][bj][m][n] - mw; q += (d[0] * d[0] + d[1] * d[1]) + (d[2] * d[2] + d[3] * d[3]); }
                q += __shfl_xor(q, 16); q += __shfl_xor(q, 32);
                if (fq == 0) P[(ai * HALF + wr * 64 + m * 16 + fr) * 4 + wc] = (f32x2v){mw, q};
            }
        asm volatile("s_waitcnt lgkmcnt(0)" ::: "memory"); __builtin_amdgcn_s_barrier(); asm volatile("" ::: "memory");
#if defined(BROKEN_NO_WAIT)
        if (blockIdx.x >= 64) { const long long t0 = clock64(); while (clock64() - t0 < 60000) __builtin_amdgcn_s_sleep(8); }
#endif
        const int row = wid * 32 + (lane & 31);
        if (lane < 32) {
            const f32x2v a = P[row * 4 + 0], b = P[row * 4 + 1], c = P[row * 4 + 2], d = P[row * 4 + 3];
            const float mt = (a.x + b.x + c.x + d.x) * 0.25f;
            const float da = a.x - mt, db = b.x - mt, dc = c.x - mt, dd = d.x - mt;
            const float m2 = (a.y + b.y) + (c.y + d.y) + 64.0f * ((da * da + db * db) + (dc * dc + dd * dd));
            unsigned long long* slot = (unsigned long long*)xbuf + ((size_t)(u.pm * BM + row) * 4 + u.pn);
            __hip_atomic_store(slot, ((unsigned long long)__float_as_uint(m2) << 32) | __float_as_uint(mt), __ATOMIC_RELAXED, __HIP_MEMORY_SCOPE_AGENT);
        }
        asm volatile("s_waitcnt vmcnt(0)" ::: "memory");
        if (lane == 0) __hip_atomic_fetch_add(cnt + 64 * u.pm, 1u, __ATOMIC_RELAXED, __HIP_MEMORY_SCOPE_AGENT);
        if (wid == 0) {
            bool dead = false; const unsigned long long t0 = __builtin_amdgcn_s_memrealtime(); const unsigned want = 8u * (unsigned)ntn;
            for (;;) {
#if defined(BROKEN_NO_WAIT)
                break;
#endif
                if ((unsigned)__builtin_amdgcn_readfirstlane(__hip_atomic_load(cnt + 64 * u.pm, __ATOMIC_RELAXED, __HIP_MEMORY_SCOPE_AGENT)) >= want) break;
                if (__builtin_amdgcn_s_memrealtime() - t0 > 2000000ull) {
                    if (lane == 0) { unsigned expect = 0u; __hip_atomic_compare_exchange_strong(tmo + 1, &expect, code | (unsigned)(u.pm & 0xff), __ATOMIC_RELAXED, __ATOMIC_RELAXED, __HIP_MEMORY_SCOPE_AGENT);
                                     __hip_atomic_store(tmo, 1u, __ATOMIC_RELAXED, __HIP_MEMORY_SCOPE_AGENT); }
                    dead = true; break; }
                __builtin_amdgcn_s_sleep(2);
            }
            __builtin_amdgcn_fence(__ATOMIC_ACQUIRE, "agent");
            if (lane == 0) flag[0] = dead ? 1u : 0u;
        }
        asm volatile("s_waitcnt vmcnt(0) lgkmcnt(0)" ::: "memory"); __builtin_amdgcn_s_barrier(); asm volatile("" ::: "memory");
        const bool bad = flag[0] != 0u;
        if (lane < 32) {
            const unsigned long long* slot = (const unsigned long long*)xbuf + (size_t)(u.pm * BM + row) * 4; float mt[4], m2[4]; float ms = 0.f;
#pragma unroll
            for (int t = 0; t < 4; ++t) { if (t < ntn) { const unsigned long long w = __hip_atomic_load(slot + t, __ATOMIC_RELAXED, __HIP_MEMORY_SCOPE_AGENT); mt[t] = __uint_as_float((unsigned)w); m2[t] = __uint_as_float((unsigned)(w >> 32)); } else { mt[t] = 0.f; m2[t] = 0.f; } ms += mt[t]; }
            const float mean = ms / (float)ntn; float q = 0.f;
#pragma unroll
            for (int t = 0; t < 4; ++t) if (t < ntn) { const float dm = mt[t] - mean; q += m2[t] + 256.0f * dm * dm; }
            S[row] = (f32x2v){mean, 1.0f / sqrtf(q / (256.0f * (float)ntn) + eps)};
        }
        asm volatile("s_waitcnt lgkmcnt(0)" ::: "memory"); __builtin_amdgcn_s_barrier(); asm volatile("" ::: "memory");
        return bad;
    }
};
struct EpiLnRes {
    static constexpr bool PERM = false, AFTER_DRAIN = true;
    const float* base; float* out; int ldc; const float* bias; PanelStats st; unsigned poison;
    __device__ __forceinline__ void refuse(size_t i0, size_t stride, int M, int N) const { const float q = __builtin_nanf(""); for (size_t i = i0; i < (size_t)M * N; i += stride) out[(i / N) * ldc + i % N] = q;
        if (i0 == 0) { unsigned expect = 0u; __hip_atomic_compare_exchange_strong(st.tmo + 1, &expect, 0x7f0u, __ATOMIC_RELAXED, __ATOMIC_RELAXED, __HIP_MEMORY_SCOPE_AGENT); __hip_atomic_store(st.tmo, 1u, __ATOMIC_RELAXED, __HIP_MEMORY_SCOPE_AGENT); } }
    __device__ __forceinline__ void fused(f32x4 (&acc)[2][2][4][2], const Unit& u, int wr, int wc, int fr, int fq, PG8_LAS unsigned char* lds, int wid, int lane) const {
        typedef float f32x2v __attribute__((ext_vector_type(2)));
        const PG8_LAS f32x2v* S = (const PG8_LAS f32x2v*)(lds + 8192);
        const int col0 = u.pn * BM + wc * 32 + 4 * fq;
#pragma unroll
        for (int bj = 0; bj < 2; ++bj)
#pragma unroll
            for (int n = 0; n < 2; ++n) { const f32x4 bv = bias ? *(const f32x4*)(bias + col0 + bj * HALF + n * 16) : (f32x4){0.f, 0.f, 0.f, 0.f};
#pragma unroll
                for (int ai = 0; ai < 2; ++ai)
#pragma unroll
                    for (int m = 0; m < 4; ++m) acc[ai][bj][m][n] += bv; }
        const bool bad = st.run(acc, u, wr, wc, fr, fq, lds, wid, lane) || poison != 0u;
        const float qnan = __builtin_nanf("");
#pragma unroll
        for (int ai = 0; ai < 2; ++ai)
#pragma unroll
            for (int m = 0; m < 4; ++m) { const int r = ai * HALF + wr * 64 + m * 16 + fr; const f32x2v sr = S[r]; const size_t off = (size_t)(u.pm * BM + r) * ldc + col0;
#pragma unroll
                for (int bj = 0; bj < 2; ++bj)
#pragma unroll
                    for (int n = 0; n < 2; ++n) { const f32x4 bs = *(const f32x4*)(base + off + bj * HALF + n * 16); f32x4 o = bs + (acc[ai][bj][m][n] - sr.x) * sr.y;
                        if (bad) o = (f32x4){qnan, qnan, qnan, qnan}; *(f32x4*)(out + off + bj * HALF + n * 16) = o; }
                asm volatile("" ::: "memory"); }
    }
};
struct EpiLnResLn {
    static constexpr bool PERM = false, AFTER_DRAIN = true;
    const float* base; float* out; bf16_t* xn; int ldc; const float* bias; PanelStats st1, st2; unsigned poison;
    __device__ __forceinline__ void refuse(size_t i0, size_t stride, int M, int N) const { const float q = __builtin_nanf(""); for (size_t i = i0; i < (size_t)M * N; i += stride) { const size_t o = (i / N) * ldc + i % N; out[o] = q; xn[o] = (bf16_t)0x7fc0u; }
        if (i0 == 0) { unsigned expect = 0u; __hip_atomic_compare_exchange_strong(st1.tmo + 1, &expect, 0x7f0u, __ATOMIC_RELAXED, __ATOMIC_RELAXED, __HIP_MEMORY_SCOPE_AGENT); __hip_atomic_store(st1.tmo, 1u, __ATOMIC_RELAXED, __HIP_MEMORY_SCOPE_AGENT); } }
    __device__ __forceinline__ void fused(f32x4 (&acc)[2][2][4][2], const Unit& u, int wr, int wc, int fr, int fq, PG8_LAS unsigned char* lds, int wid, int lane) const {
        typedef float f32x2v __attribute__((ext_vector_type(2))); typedef unsigned u32x2v __attribute__((ext_vector_type(2)));
        const PG8_LAS f32x2v* S = (const PG8_LAS f32x2v*)(lds + 8192);
        const int col0 = u.pn * BM + wc * 32 + 4 * fq;
#pragma unroll
        for (int bj = 0; bj < 2; ++bj)
#pragma unroll
            for (int n = 0; n < 2; ++n) { const f32x4 bv = bias ? *(const f32x4*)(bias + col0 + bj * HALF + n * 16) : (f32x4){0.f, 0.f, 0.f, 0.f};
#pragma unroll
                for (int ai = 0; ai < 2; ++ai)
#pragma unroll
                    for (int m = 0; m < 4; ++m) acc[ai][bj][m][n] += bv; }
        bool bad = st1.run(acc, u, wr, wc, fr, fq, lds, wid, lane) || poison != 0u;
        const float qnan = __builtin_nanf("");
#pragma unroll
        for (int ai = 0; ai < 2; ++ai)
#pragma unroll
            for (int m = 0; m < 4; ++m) { const int r = ai * HALF + wr * 64 + m * 16 + fr; const f32x2v sr = S[r]; const size_t off = (size_t)(u.pm * BM + r) * ldc + col0;
#pragma unroll
                for (int bj = 0; bj < 2; ++bj)
#pragma unroll
                    for (int n = 0; n < 2; ++n) { const f32x4 bs = *(const f32x4*)(base + off + bj * HALF + n * 16); acc[ai][bj][m][n] = bs + (acc[ai][bj][m][n] - sr.x) * sr.y; }
                asm volatile("" : "+v"(acc[ai][0][m][0]), "+v"(acc[ai][0][m][1]), "+v"(acc[ai][1][m][0]), "+v"(acc[ai][1][m][1]));
                if (m & 1) asm volatile("" ::: "memory"); }
        const bool bad1 = bad;
        bad = st2.run(acc, u, wr, wc, fr, fq, lds, wid, lane) || bad;
#pragma unroll
        for (int ai = 0; ai < 2; ++ai)
#pragma unroll
            for (int m = 0; m < 4; ++m) { const int r = ai * HALF + wr * 64 + m * 16 + fr; const f32x2v sr = S[r]; const size_t off = (size_t)(u.pm * BM + r) * ldc + col0;
#pragma unroll
                for (int bj = 0; bj < 2; ++bj)
#pragma unroll
                    for (int n = 0; n < 2; ++n) { const f32x4 x1 = acc[ai][bj][m][n]; *(f32x4*)(out + off + bj * HALF + n * 16) = bad1 ? (f32x4){qnan, qnan, qnan, qnan} : x1;
                        const f32x4 o = (x1 - sr.x) * sr.y; u32x2v w; w.x = cvt_pk_bf16(o[0], o[1]); w.y = cvt_pk_bf16(o[2], o[3]);
                        if (bad) { w.x = 0x7fc07fc0u; w.y = 0x7fc07fc0u; } *(u32x2v*)(xn + off + bj * HALF + n * 16) = w; }
                asm volatile("" ::: "memory"); }
    }
};

template <class Epi, class Sched, bool STAMP = false, bool GATHER = false>
__device__ __forceinline__ void gemm_phase(PG8_LAS unsigned char* lds, const Gemm g, const Sched& S, const Epi& E, unsigned long long* stamps, int wid_in) {
    const int wid = wid_in, lane = lane_id(), tid = wid * 64 + lane, wr = wid >> 2, wc = wid & 3, fr = lane & 15, fq = lane >> 4;
    const int K = g.K, nt = K / BK;
    int ts_lo = 0, ts_hi = 0, nts = 0; const unsigned long long rt_entry = STAMP ? (unsigned long long)wall_clock64() : 0ull;
#define PG8_STAMP() do { if (STAMP && wid == 0 && nts < 64) { const unsigned long long _c = (unsigned long long)clock64(); \
        ts_lo = (lane == nts) ? (int)(unsigned)_c : ts_lo; ts_hi = (lane == nts) ? (int)(unsigned)(_c >> 32) : ts_hi; ++nts; } } while (0)
    PG8_STAMP();
    unsigned voffA[2], voffB[2]; int RA[2], CA[2];
#pragma unroll
    for (int i = 0; i < 2; ++i) { int R, C; stage_rc(tid * 16 + i * 8192, R, C); const int Rb = Epi::PERM ? ((R & ~31) + perm32(R & 31)) : R; RA[i] = R; CA[i] = C;
        voffA[i] = (unsigned)(R * K + C) * 2u; voffB[i] = (unsigned)(Rb * K + C) * 2u; }
    unsigned vga[2][2], vgn[2][2];
#define PG8_GIDX(dst, u_) do { _Pragma("unroll") for (int _h = 0; _h < 2; ++_h) _Pragma("unroll") for (int _i = 0; _i < 2; ++_i) { int _r = g.aidx[(u_).pm * BM + _h * HALF + RA[_i]]; _r = ((unsigned)_r < (unsigned)g.M) ? _r : 0; \
        dst[_h][_i] = (unsigned)(_r * K + CA[_i]) * 2u; } } while (0)
    const size_t kstep = (size_t)(BK * 2);
    const size_t hstep = (size_t)HALF * K * 2;
    const size_t tstep = 2 * hstep;
    const unsigned ldsw = (unsigned)wid * 1024u;
    const int aoff = lds_byte(wr * 64 + fr, fq * 8), boff = lds_byte(wc * 32 + fr, fq * 8);
#define PG8_SA(b, h) (((b) * 2 + (h)) * HTB)
#define PG8_SB(b, h) ((4 + (b) * 2 + (h)) * HTB)
#define PG8_STAGE(bufoff, gbase, voff) do { _Pragma("unroll") for (int _i = 0; _i < 2; ++_i) \
        __builtin_amdgcn_global_load_lds((const unsigned*)((const char*)(gbase) + (voff)[_i]), (PG8_LAS unsigned*)(lds + (bufoff) + ldsw + _i * 8192), 16, 0, 0); } while (0)
#define PG8_STA(bufoff, isnext, h, kt) do { if constexpr (GATHER) { const char* _gb = (const char*)g.A + (size_t)(kt) * kstep; \
        _Pragma("unroll") for (int _i = 0; _i < 2; ++_i) __builtin_amdgcn_global_load_lds((const unsigned*)(_gb + ((isnext) ? vgn[h][_i] : vga[h][_i])), (PG8_LAS unsigned*)(lds + (bufoff) + ldsw + _i * 8192), 16, 0, 0); } \
    else { const char* _gb = ((isnext) ? nA : cA) + (size_t)(h) * hstep + (size_t)(kt) * kstep; PG8_STAGE(bufoff, _gb, voffA); } } while (0)
#define PG8_LDA(dst, b, h) do { _Pragma("unroll") for (int m = 0; m < 4; ++m) _Pragma("unroll") for (int k = 0; k < 2; ++k) dst[m][k] = *(const PG8_LAS bf16x8*)(lds + PG8_SA(b, h) + aoff + m * 2048 + k * 1024); } while (0)
#define PG8_LDB(dst, b, h) do { _Pragma("unroll") for (int n = 0; n < 2; ++n) _Pragma("unroll") for (int k = 0; k < 2; ++k) dst[n][k] = *(const PG8_LAS bf16x8*)(lds + PG8_SB(b, h) + boff + n * 2048 + k * 1024); } while (0)
#define PG8_MMA(ai, bj, At, Bt) do { __builtin_amdgcn_s_setprio(1); _Pragma("unroll") for (int m = 0; m < 4; ++m) _Pragma("unroll") for (int n = 0; n < 2; ++n) _Pragma("unroll") for (int k = 0; k < 2; ++k) \
        acc[ai][bj][m][n] = __builtin_amdgcn_mfma_f32_16x16x32_bf16(Bt[n][k], At[m][k], acc[ai][bj][m][n], 0, 0, 0); __builtin_amdgcn_s_setprio(0); } while (0)
#define PG8_WAIT_V(n) asm volatile("s_waitcnt vmcnt(" #n ")" ::: "memory")
#define PG8_WAIT_L(n) asm volatile("s_waitcnt lgkmcnt(" #n ")" ::: "memory")
#define PG8_BAR __builtin_amdgcn_s_barrier()
#define PG8_SCHED __builtin_amdgcn_sched_barrier(0)
    Unit cur, nxt; int ui = 0;
    if (!S.next(0, cur)) return;
    f32x4 acc[2][2][4][2];
#pragma unroll
    for (int a = 0; a < 2; ++a)
#pragma unroll
        for (int b = 0; b < 2; ++b)
#pragma unroll
            for (int m = 0; m < 4; ++m)
#pragma unroll
                for (int n = 0; n < 2; ++n) acc[a][b][m][n] = (f32x4){0.f, 0.f, 0.f, 0.f};
    bf16x8 At[4][2], B0[2][2], B1[2][2];
    const char* cA = (const char*)g.A + (size_t)cur.pm * tstep; const char* cB = (const char*)g.Bt + (size_t)cur.pn * tstep;
    S.a_ready(cur);
    const char* nA = cA;
    if constexpr (GATHER) { PG8_GIDX(vga, cur); }
    PG8_STAGE(PG8_SB(0, 0), cB, voffB); PG8_STA(PG8_SA(0, 0), false, 0, 0); PG8_STAGE(PG8_SB(0, 1), cB + hstep, voffB); PG8_STA(PG8_SA(0, 1), false, 1, 0);
    if (wr == 1) PG8_BAR;
    PG8_WAIT_V(4); PG8_BAR;
    PG8_STAGE(PG8_SB(1, 0), cB + kstep, voffB); PG8_STA(PG8_SA(1, 0), false, 0, 1); PG8_STAGE(PG8_SB(1, 1), cB + hstep + kstep, voffB);
    PG8_WAIT_V(6); PG8_BAR;
    PG8_STAMP();
    for (;;) {
        const bool has_next = S.next(ui + 1, nxt);
        nA = has_next ? (const char*)g.A + (size_t)nxt.pm * tstep : cA; const char* nB = has_next ? (const char*)g.Bt + (size_t)nxt.pn * tstep : cB;
        if constexpr (GATHER) { if (has_next) { PG8_GIDX(vgn, nxt); } else { _Pragma("unroll") for (int _h = 0; _h < 2; ++_h) _Pragma("unroll") for (int _i = 0; _i < 2; ++_i) vgn[_h][_i] = vga[_h][_i]; } }
        for (int t = 0; t < nt; t += 2) {
            const bool last = (t == nt - 2);
            const char* b2 = last ? nB : cB + (size_t)(t + 2) * kstep;
            const char* b3 = b2 + kstep;
            const int kt2 = last ? 0 : t + 2;
            if (last && has_next) S.a_ready(nxt);
            PG8_LDB(B0, 0, 0); PG8_SCHED; PG8_LDA(At, 0, 0); PG8_STA(PG8_SA(1, 1), false, 1, t + 1);
            PG8_WAIT_L(8); PG8_BAR; PG8_WAIT_L(0); PG8_MMA(0, 0, At, B0); PG8_BAR; PG8_SCHED;
            PG8_LDB(B1, 0, 1); PG8_STAGE(PG8_SB(0, 0), b2, voffB);
            PG8_BAR; PG8_WAIT_L(0); PG8_MMA(0, 1, At, B1); PG8_BAR;
            PG8_LDA(At, 0, 1); PG8_STA(PG8_SA(0, 0), last, 0, kt2);
            PG8_BAR; PG8_WAIT_L(0); PG8_MMA(1, 0, At, B0); PG8_BAR; PG8_SCHED;
            PG8_STAGE(PG8_SB(0, 1), b2 + hstep, voffB);
            PG8_WAIT_V(6); PG8_BAR; PG8_MMA(1, 1, At, B1); PG8_BAR;
            PG8_LDB(B0, 1, 0); PG8_SCHED; PG8_LDA(At, 1, 0); PG8_STA(PG8_SA(0, 1), last, 1, kt2);
            PG8_WAIT_L(8); PG8_BAR; PG8_WAIT_L(0); PG8_MMA(0, 0, At, B0); PG8_BAR; PG8_SCHED;
            PG8_LDB(B1, 1, 1); PG8_STAGE(PG8_SB(1, 0), b3, voffB);
            PG8_BAR; PG8_WAIT_L(0); PG8_MMA(0, 1, At, B1); PG8_BAR;
            PG8_LDA(At, 1, 1); PG8_STA(PG8_SA(1, 0), last, 0, kt2 + 1);
            PG8_BAR; PG8_WAIT_L(0); PG8_MMA(1, 0, At, B0); PG8_BAR; PG8_SCHED;
            PG8_STAGE(PG8_SB(1, 1), b3 + hstep, voffB);
            PG8_WAIT_V(6); PG8_BAR; PG8_MMA(1, 1, At, B1); PG8_BAR;
        }
        PG8_STAMP();
        if constexpr (!Epi::AFTER_DRAIN) { E(acc, cur, wr, wc, fr, fq); S.done(cur); }
        PG8_STAMP();
        if (!has_next) break;
#pragma unroll
        for (int a = 0; a < 2; ++a)
#pragma unroll
            for (int b = 0; b < 2; ++b)
#pragma unroll
                for (int m = 0; m < 4; ++m)
#pragma unroll
                    for (int n = 0; n < 2; ++n) acc[a][b][m][n] = (f32x4){0.f, 0.f, 0.f, 0.f};
        cur = nxt; cA = nA; cB = nB; ++ui;
        if constexpr (GATHER) { _Pragma("unroll") for (int _h = 0; _h < 2; ++_h) _Pragma("unroll") for (int _i = 0; _i < 2; ++_i) vga[_h][_i] = vgn[_h][_i]; }
    }
    PG8_WAIT_V(0);
    if (wr == 0) PG8_BAR;
    PG8_BAR;
    if constexpr (Epi::AFTER_DRAIN) { E.fused(acc, cur, wr, wc, fr, fq, lds, wid, lane); S.done(cur); }
    PG8_STAMP();
    if (STAMP && wid == 0) { stamps[lane] = lane < nts ? (((unsigned long long)(unsigned)ts_hi << 32) | (unsigned)ts_lo) : 0ull;
        if (lane == 62) stamps[62] = rt_entry; if (lane == 63) stamps[63] = (unsigned long long)wall_clock64(); }
#undef PG8_STAMP
#undef PG8_SA
#undef PG8_SB
#undef PG8_STAGE
#undef PG8_STA
#undef PG8_GIDX
#undef PG8_LDA
#undef PG8_LDB
#undef PG8_MMA
#undef PG8_WAIT_V
#undef PG8_WAIT_L
#undef PG8_BAR
#undef PG8_SCHED
}
}
constexpr int D = 1024, NB = 2, SEQ = 8192, CTXL = 256;
constexpr int TX = NB * SEQ;
constexpr int TC = NB * CTXL;
constexpr int TR = TX + TC;
constexpr float EPS = 1e-6f;
constexpr int NEXP = 16, CAPX = 1024, CAPC = 32, EROWS = 2304;
constexpr int FF = 2048;
constexpr int NKEY = CTXL + SEQ;
constexpr int RRS = 16896;
constexpr float QSCALE = 0.125f * 1.4426950408889634f;

enum { I_X = 0, I_C, I_CTX, I_CCTX, I_ADAW, I_ADAB, I_SGWIN, I_SGBIN, I_SGVG, I_SGWS, I_SGBS, I_SGWOUT, I_SGBOUT,
       I_HYWIN, I_HYBIN, I_HYCW, I_HYCB, I_HYFW1, I_HYFB1, I_HYFW2, I_HYFB2, I_HYFW3, I_HYFB3, I_HYFREQ, I_HYFWOUT, I_HYSKIP, I_HYWOUT, I_HYBOUT,
       I_DAWIN, I_DAQG, I_DAKG, I_DALQ1, I_DALK1, I_DALQ2, I_DALK2, I_DASUB, I_DAWOUT, I_ROUTER, I_WGATE, I_WUP, I_WDOWN, N_IN };

constexpr size_t MiB = 1u << 20;
constexpr size_t WS_CTL = 0, CTL_ZERO_BYTES = 1 * MiB;
constexpr size_t WS_MOD = 1 * MiB;
constexpr size_t WS_ROPE = 2 * MiB;
constexpr size_t WS_WRT = 2 * MiB + 512 * 1024;
constexpr size_t WS_HID = 3 * MiB;
constexpr int UTS = 8192;
constexpr int FQ_LSEG = 16, FQ_CSEG = 4;
constexpr size_t WS_FSQP = 6 * MiB;
constexpr size_t WS_AFF = 9 * MiB;
constexpr int AFFC_OFF = 2 * 16 * 8192;
constexpr size_t WS_TOKSLOT = 11 * MiB;
constexpr size_t WS_SELTOK = 13 * MiB;
constexpr size_t WS_SELG = 13 * MiB + 512 * 1024;
constexpr size_t WS_WSBD = 14 * MiB;
constexpr size_t WS_WSGIN = 16 * MiB, WS_WSGOUT = 32 * MiB, WS_WHYIN = 40 * MiB, WS_WHYOUT = 46 * MiB, WS_WDAIN = 48 * MiB, WS_WDAOUT = 54 * MiB;
constexpr size_t WS_VSQ = 56 * MiB;
constexpr size_t WS_WGU = 64 * MiB;
constexpr size_t WS_WDN = 576 * MiB;
constexpr size_t WS_X = 832 * MiB;
constexpr size_t WS_H = 898 * MiB;
constexpr size_t WS_BUF1 = 932 * MiB;
constexpr size_t WS_BUF2 = 1064 * MiB;
constexpr size_t WS_BUF3 = 1164 * MiB;
constexpr size_t WS_Y = 1232 * MiB;
constexpr size_t WS_RR = 1304 * MiB;
constexpr size_t WS_RRC = 1436 * MiB;
constexpr size_t WS_END = 1440 * MiB;
constexpr int CW_BAR = 4096;

constexpr int RING_BYTES = 131072;
constexpr int LDS_BYTES = 163840;
constexpr int MISC_OFF = LDS_BYTES - 256;
constexpr int NWAVES = 8, NTHR = 512;

struct Args { const float* in[N_IN]; float* out; unsigned char* ws; int ph_lo, ph_hi; };
static_assert(sizeof(Args) == N_IN * 8 + 8 + 8 + 8, "Args has no padding");

DI int mod_index(int row) { return row < TX ? (row >> 13) : 2; }
DI const float* modp(const Args& a, int layer, int mi, int piece) { return (const float*)(a.ws + WS_MOD) + ((size_t)(layer * 3 + mi) * 6 + piece) * 1024; }

namespace pg8 {
struct MoeOrder {
    int MT, NT, G, c;
    __device__ bool next(int i, Unit& u) const {
        int e, r;
        if ((G & 7) == 0) { const int per = 2 * MT * NT; const int uu = i * (G >> 3) + (c >> 3); if (uu >= per) return false; e = (c & 7) * 2 + uu / (MT * NT); r = uu % (MT * NT); }
        else { const int L = i * G + c; if (L >= 16 * MT * NT) return false; e = L / (MT * NT); r = L - e * (MT * NT); }
        const int nt = r / MT, mt = r - nt * MT;
        u.pm = e * 9 + mt; u.pn = e * NT + nt; return true;
    }
    __device__ __forceinline__ void a_ready(const Unit&) const {}
    __device__ __forceinline__ void done(const Unit&) const {}
};
struct SpatOrder {
    int nunits, G, c;
    __device__ bool next(int i, Unit& u) const {
        const int L = i * G + c; if (L >= nunits) return false;
        u.pm = L & 3; u.pn = L; return true;
    }
    __device__ __forceinline__ void a_ready(const Unit&) const {}
    __device__ __forceinline__ void done(const Unit&) const {}
};
struct EpiRes {
    static constexpr bool PERM = false, AFTER_DRAIN = false;
    float* X; const float* bias; const float* gate0;
    __device__ __forceinline__ void operator()(const f32x4 (&acc)[2][2][4][2], const Unit& u, int wr, int wc, int fr, int fq) const {
        const int row0 = u.pm * BM + wr * 64 + fr, col0 = u.pn * BM + wc * 32 + 4 * fq;
        const int mi = (u.pm * BM) < TX ? ((u.pm * BM) >> 13) : 2;
        const float* gate = gate0 + (size_t)mi * 6 * 1024;
#pragma unroll
        for (int bj = 0; bj < 2; ++bj)
#pragma unroll
            for (int n = 0; n < 2; ++n) {
                const f32x4 bv = bias ? *(const f32x4*)(bias + col0 + bj * HALF + n * 16) : (f32x4){0.f, 0.f, 0.f, 0.f}; const f32x4 gv = *(const f32x4*)(gate + col0 + bj * HALF + n * 16);
#pragma unroll
                for (int ai = 0; ai < 2; ++ai)
#pragma unroll
                    for (int m = 0; m < 4; ++m) { f32x4* p = (f32x4*)(X + (size_t)(row0 + ai * HALF + m * 16) * 1024 + col0 + bj * HALF + n * 16); *p = *p + gv * (acc[ai][bj][m][n] + bv); }
                asm volatile("" ::: "memory"); }
    }
};
struct EpiSwiGLU {
    static constexpr bool PERM = true, AFTER_DRAIN = false;
    bf16_t* O;
    __device__ __forceinline__ void operator()(const f32x4 (&acc)[2][2][4][2], const Unit& u, int wr, int wc, int fr, int fq) const {
        const int row0 = u.pm * BM + wr * 64 + fr; const int e = u.pm / 9; const int pnl = u.pn - e * 16;
        const int col0 = pnl * 128 + wc * 16 + 4 * fq;
#pragma unroll
        for (int ai = 0; ai < 2; ++ai)
#pragma unroll
            for (int m = 0; m < 4; ++m) { bf16_t* rowp = O + (size_t)(row0 + ai * HALF + m * 16) * 2048 + col0;
#pragma unroll
                for (int bj = 0; bj < 2; ++bj) { const f32x4 g = acc[ai][bj][m][0], up = acc[ai][bj][m][1]; f32x4 h;
#pragma unroll
                    for (int j = 0; j < 4; ++j) h[j] = g[j] * __builtin_amdgcn_rcpf(1.0f + __expf(-g[j])) * up[j];
                    u32x2 w; w.x = cvt_pk_bf16(h[0], h[1]); w.y = cvt_pk_bf16(h[2], h[3]);
                    *(u32x2*)(rowp + bj * 64) = w; } }
    }
};
struct EpiDown {
    static constexpr bool PERM = true, AFTER_DRAIN = false;
    bf16_t* O; const float* g;
    __device__ __forceinline__ void operator()(const f32x4 (&acc)[2][2][4][2], const Unit& u, int wr, int wc, int fr, int fq) const {
        const int row0 = u.pm * BM + wr * 64 + fr; const int e = u.pm / 9; const int pnl = u.pn - e * 4;
        const int col0 = pnl * BM + wc * 32 + 8 * fq;
        float gsv[2][4];
#pragma unroll
        for (int ai = 0; ai < 2; ++ai)
#pragma unroll
            for (int m = 0; m < 4; ++m) gsv[ai][m] = g[row0 + ai * HALF + m * 16];
#pragma unroll
        for (int ai = 0; ai < 2; ++ai)
#pragma unroll
            for (int m = 0; m < 4; ++m) { const int row = row0 + ai * HALF + m * 16; const float gs = gsv[ai][m]; bf16_t* rowp = O + (size_t)row * 1024 + col0;
#pragma unroll
                for (int bj = 0; bj < 2; ++bj) { const f32x4 v0 = acc[ai][bj][m][0] * gs, v1 = acc[ai][bj][m][1] * gs;
                    u32x4 w; w.x = cvt_pk_bf16(v0[0], v0[1]); w.y = cvt_pk_bf16(v0[2], v0[3]); w.z = cvt_pk_bf16(v1[0], v1[1]); w.w = cvt_pk_bf16(v1[2], v1[3]);
                    *(u32x4*)(rowp + bj * HALF) = w; } }
    }
};
struct EpiSpat {
    static constexpr bool PERM = true, AFTER_DRAIN = false;
    bf16_t* TT; const bf16_t* ZZ; const float* bs;
    __device__ __forceinline__ void operator()(const f32x4 (&acc)[2][2][4][2], const Unit& u, int wr, int wc, int fr, int fq) const {
        const int chunk = u.pn >> 2, gp = u.pn & 3;
        asm volatile("" : "+v"(fr), "+v"(fq));
        const unsigned lz = (unsigned)(fr * 4096 + 8 * fq) * 2u, lt = (unsigned)(fr * 2048 + 8 * fq) * 2u;
#pragma unroll
        for (int ai = 0; ai < 2; ++ai)
#pragma unroll
            for (int mp = 0; mp < 2; ++mp) {
                const int g = 2 * gp + ai;
                u32x4 uu[2][2]; float bb[2];
#pragma unroll
                for (int mm = 0; mm < 2; ++mm) { const int pu = wr * 64 + (2 * mp + mm) * 16; bb[mm] = bs[g * 128 + pu + fr];
#pragma unroll
                    for (int bj = 0; bj < 2; ++bj) { const int chu = g * 256 + bj * HALF + wc * 32; uu[mm][bj] = *(const u32x4*)((const char*)(ZZ + ((size_t)chunk * 128 + pu) * 4096 + chu) + lz); } }
#pragma unroll
                for (int mm = 0; mm < 2; ++mm) { const int m = 2 * mp + mm; const int pu = wr * 64 + m * 16; const float b = bb[mm];
#pragma unroll
                    for (int bj = 0; bj < 2; ++bj) { const int chu = g * 256 + bj * HALF + wc * 32; const u32x4 u4 = uu[mm][bj];
                        const f32x4 v0 = acc[ai][bj][m][0] + b, v1 = acc[ai][bj][m][1] + b;
                        u32x4 w;
                        w.x = cvt_pk_bf16(__uint_as_float(u4.x << 16) * v0[0], __uint_as_float(u4.x & 0xffff0000u) * v0[1]);
                        w.y = cvt_pk_bf16(__uint_as_float(u4.y << 16) * v0[2], __uint_as_float(u4.y & 0xffff0000u) * v0[3]);
                        w.z = cvt_pk_bf16(__uint_as_float(u4.z << 16) * v1[0], __uint_as_float(u4.z & 0xffff0000u) * v1[1]);
                        w.w = cvt_pk_bf16(__uint_as_float(u4.w << 16) * v1[2], __uint_as_float(u4.w & 0xffff0000u) * v1[3]);
                        *(u32x4*)((char*)(TT + ((size_t)chunk * 128 + pu) * 2048 + chu) + lt) = w; } }
                asm volatile("" ::: "memory"); }
    }
};
}
struct CvtTile { const float* src; bf16_t* dst; int K, N, mode; };
constexpr int CVT_SG = 384, CVT_MOE = 6144, CVT_PROJ = 256;
constexpr int CVT_T_MOE0 = CVT_SG, CVT_T_HY = CVT_T_MOE0 + CVT_MOE, CVT_T_MOE1 = CVT_T_HY + CVT_PROJ, CVT_T_DA = CVT_T_MOE1 + CVT_MOE, CVT_T_MOE2 = CVT_T_DA + CVT_PROJ,
              CVT_T_SG3 = CVT_T_MOE2 + CVT_MOE, CVT_T_MOE3 = CVT_T_SG3 + CVT_SG, CVT_NTILES = CVT_T_MOE3 + CVT_MOE;
DI void cvt_sg(const Args& a, int j, int& r, CvtTile& d) {
    unsigned char* ws = a.ws;
    if (r < 256) { d.K = 1024; d.N = 4096; d.mode = 0; d.src = a.in[I_SGWIN] + (size_t)j * 1024 * 4096; d.dst = (bf16_t*)(ws + WS_WSGIN) + (size_t)j * 4096 * 1024; }
    else { r -= 256; d.K = 2048; d.N = 1024; d.mode = 0; d.src = a.in[I_SGWOUT] + (size_t)j * 2048 * 1024; d.dst = (bf16_t*)(ws + WS_WSGOUT) + (size_t)j * 1024 * 2048; }
}
DI void cvt_moe(const Args& a, int layer, int& r, CvtTile& d) {
    unsigned char* ws = a.ws; const int which = r >> 11, mm = layer * 16 + ((r >> 7) & 15); r &= 127;
    if (which == 0) { d.K = 1024; d.N = 2048; d.mode = 1; d.src = a.in[I_WGATE] + (size_t)mm * 1024 * 2048; d.dst = (bf16_t*)(ws + WS_WGU) + (size_t)mm * 4096 * 1024; }
    else if (which == 1) { d.K = 1024; d.N = 2048; d.mode = 2; d.src = a.in[I_WUP] + (size_t)mm * 1024 * 2048; d.dst = (bf16_t*)(ws + WS_WGU) + (size_t)mm * 4096 * 1024; }
    else { d.K = 2048; d.N = 1024; d.mode = 0; d.src = a.in[I_WDOWN] + (size_t)mm * 2048 * 1024; d.dst = (bf16_t*)(ws + WS_WDN) + (size_t)mm * 1024 * 2048; }
}
DI void cvt_decode(const Args& a, int t, CvtTile& d) {
    unsigned char* ws = a.ws; int r = t;
    if (r < CVT_T_MOE0) cvt_sg(a, 0, r, d);
    else if (r < CVT_T_HY) { r -= CVT_T_MOE0; cvt_moe(a, 0, r, d); }
    else if (r < CVT_T_MOE1) { r -= CVT_T_HY; if (r < 192) { d.K = 1024; d.N = 3072; d.mode = 0; d.src = a.in[I_HYWIN]; d.dst = (bf16_t*)(ws + WS_WHYIN); } else { r -= 192; d.K = 1024; d.N = 1024; d.mode = 0; d.src = a.in[I_HYWOUT]; d.dst = (bf16_t*)(ws + WS_WHYOUT); } }
    else if (r < CVT_T_DA) { r -= CVT_T_MOE1; cvt_moe(a, 1, r, d); }
    else if (r < CVT_T_MOE2) { r -= CVT_T_DA; if (r < 192) { d.K = 1024; d.N = 3072; d.mode = 0; d.src = a.in[I_DAWIN]; d.dst = (bf16_t*)(ws + WS_WDAIN); } else { r -= 192; d.K = 1024; d.N = 1024; d.mode = 0; d.src = a.in[I_DAWOUT]; d.dst = (bf16_t*)(ws + WS_WDAOUT); } }
    else if (r < CVT_T_SG3) { r -= CVT_T_MOE2; cvt_moe(a, 2, r, d); }
    else if (r < CVT_T_MOE3) { r -= CVT_T_SG3; cvt_sg(a, 1, r, d); }
    else { r -= CVT_T_MOE3; cvt_moe(a, 3, r, d); }
    const int ntn = d.N >> 7; const int kt = r / ntn, nt = r - kt * ntn;
    d.src += (size_t)(kt * 128) * d.N + nt * 128; d.dst += kt * 128;
    d.mode |= (nt << 8);
}
DI void cvt_load(const CvtTile& d, float (&v)[32], int tid) {
    const int nl = tid & 127, kq = tid >> 7; const float* p = d.src + (size_t)(kq * 32) * d.N + nl;
#pragma unroll
    for (int i = 0; i < 32; ++i) v[i] = p[(size_t)i * d.N];
}
DI void cvt_pack(LAS unsigned* L, const float (&v)[32], int tid) {
    const int nl = tid & 127, kq = tid >> 7;
#pragma unroll
    for (int i = 0; i < 16; ++i) L[nl * 65 + kq * 16 + i] = pkbf(v[2 * i], v[2 * i + 1]);
}
DI void cvt_store(const LAS unsigned* L, const CvtTile& cur, int tid) {
    const int kq2 = tid & 15, nb = cur.mode >> 8, mode = cur.mode & 255;
#pragma unroll
    for (int j = 0; j < 4; ++j) { const int n = (tid >> 4) + 32 * j; const LAS unsigned* lp = L + n * 65 + 4 * kq2;
        u32x4 o; o.x = lp[0]; o.y = lp[1]; o.z = lp[2]; o.w = lp[3];
        const int na = nb * 128 + n; const int row = mode == 0 ? na : (((na >> 2) << 3) + (na & 3) + (mode == 2 ? 4 : 0));
        *(u32x4*)(cur.dst + (size_t)row * cur.K + 8 * kq2) = o; }
}
DI void cvt_range(const Args& a, LAS unsigned char* lds, int tid, int lo, int hi) {
    LAS unsigned* L = (LAS unsigned*)lds;
    int t = lo + blockIdx.x;
    if (t >= hi) return;
    CvtTile cur; cvt_decode(a, t, cur);
    float v[32]; cvt_load(cur, v, tid);
    for (;;) {
        const int tn = t + gridDim.x; const bool more = tn < hi;
        CvtTile nxt = cur; float vn[32];
        if (more) { cvt_decode(a, tn, nxt); cvt_load(nxt, vn, tid); }
        cvt_pack(L, v, tid);
        __syncthreads();
        cvt_store(L, cur, tid);
        __syncthreads();
        if (!more) break;
        t = tn; cur = nxt;
#pragma unroll
        for (int i = 0; i < 32; ++i) v[i] = vn[i];
    }
}
DI void pro0_small(const Args& a, int gtid, int gthreads) {
    bf16_t* sbd = (bf16_t*)(a.ws + WS_WSBD);
    for (int i = gtid; i < 2 * 4 * 256 * 256; i += gthreads) {
        const int col = i & 255, row = (i >> 8) & 255, gp = (i >> 16) & 3, j = i >> 18;
        const int gsel = row >> 7, p = row & 127, gl = col >> 7, q = col & 127;
        const float v = (gsel == gl) ? a.in[I_SGWS][(((size_t)j * 8 + 2 * gp + gsel) * 128 + p) * 128 + q] : 0.f;
        sbd[i] = f2bf1(v);
    }
    float* rope = (float*)(a.ws + WS_ROPE);
    for (int i = gtid; i < 2048; i += gthreads) {
        const int pos = i >> 4, f = i & 15;
        const float inv = powf(10000.0f, -(float)f / 16.0f);
        const float ang = (float)pos * inv;
        rope[2 * i] = cosf(ang); rope[2 * i + 1] = sinf(ang);
    }
    float* wrt = (float*)(a.ws + WS_WRT);
    for (int i = gtid; i < 4 * 16384; i += gthreads) wrt[i] = a.in[I_ROUTER][(size_t)(i >> 14) * 16384 + (i & 1023) * 16 + ((i >> 10) & 15)];
    bf16_t* rr = (bf16_t*)(a.ws + WS_RR);
    for (int i = gtid; i < 2048 * 513; i += gthreads) {
        const int row = i / 513, k = i % 513;
        const int idx = k == 512 ? 0 : 16384 + k;
        rr[(size_t)row * RRS + idx] = 0;
    }
}
DI void pro0_mod(const Args& a, LAS unsigned char* lds, int tid, int lane, int wave) {
    LAS float* sc = (LAS float*)lds;
    for (int i = tid; i < 3072; i += NTHR) { const int r = i >> 10, k = i & 1023; const float v = (r < 2) ? a.in[I_C][r * 1024 + k] : a.in[I_CCTX][k]; sc[i] = v / (1.0f + expf(-v)); }
    __syncthreads();
    LAS float* red = (LAS float*)(lds + 12288);
    float* MOD = (float*)(a.ws + WS_MOD);
    for (int it = blockIdx.x; it < 384; it += gridDim.x) {
        const int l = it / 96, cg = it % 96, col = cg * 64 + lane;
        const float* w = a.in[I_ADAW] + (size_t)l * 1024 * 6144 + col;
        float a0 = 0.f, a1 = 0.f, a2 = 0.f;
#pragma unroll 16
        for (int k = wave * 128; k < wave * 128 + 128; ++k) { const float wv = w[(size_t)k * 6144]; a0 += sc[k] * wv; a1 += sc[1024 + k] * wv; a2 += sc[2048 + k] * wv; }
        red[(wave * 3 + 0) * 64 + lane] = a0; red[(wave * 3 + 1) * 64 + lane] = a1; red[(wave * 3 + 2) * 64 + lane] = a2;
        __syncthreads();
        if (wave < 3) { float s = 0.f;
#pragma unroll
            for (int w8 = 0; w8 < 8; ++w8) s += red[(w8 * 3 + wave) * 64 + lane];
            MOD[(size_t)(l * 3 + wave) * 6144 + col] = s + a.in[I_ADAB][l * 6144 + col]; }
        __syncthreads();
    }
}
DI void pro0_filter1(const Args& a, int lane, int gw, int NGW) {
    float w1c[33], w2c[64], w3c[64];
#pragma unroll
    for (int i = 0; i < 33; ++i) w1c[i] = a.in[I_HYFW1][i * 64 + lane];
#pragma unroll
    for (int i = 0; i < 64; ++i) { w2c[i] = a.in[I_HYFW2][i * 64 + lane]; w3c[i] = a.in[I_HYFW3][i * 64 + lane]; }
    const float b1 = a.in[I_HYFB1][lane], b2 = a.in[I_HYFB2][lane], b3 = a.in[I_HYFB3][lane], fr = a.in[I_HYFREQ][lane];
    float* HID = (float*)(a.ws + WS_HID);
    for (int tt = gw; tt < 8448; tt += NGW) {
        const int n = tt < 8192 ? 8192 : 256, t = tt < 8192 ? tt : tt - 8192;
        const float tl = (float)t / (float)(n - 1);
        const float w = (6.283185307179586f / (float)n) * (float)t;
        float z = tl;
        if (lane >= 1 && lane <= 16) { const float f = 1e-4f + (float)(lane - 1) * ((15.0f - 1e-4f) / 15.0f); z = cosf(f * w); }
        else if (lane >= 17 && lane <= 32) { const float f = 1e-4f + (float)(lane - 17) * ((15.0f - 1e-4f) / 15.0f); z = -sinf(f * w); }
        float p = b1;
#pragma unroll
        for (int i = 0; i < 33; ++i) p += __uint_as_float(__builtin_amdgcn_readlane(__float_as_uint(z), i)) * w1c[i];
        float h = sinf(fr * p);
        p = b2;
#pragma unroll
        for (int i = 0; i < 64; ++i) p += __uint_as_float(__builtin_amdgcn_readlane(__float_as_uint(h), i)) * w2c[i];
        h = sinf(fr * p);
        p = b3;
#pragma unroll
        for (int i = 0; i < 64; ++i) p += __uint_as_float(__builtin_amdgcn_readlane(__float_as_uint(h), i)) * w3c[i];
        h = sinf(fr * p);
        HID[(size_t)tt * 64 + lane] = h;
    }
}
DI void split_bf16(const float (&x)[8], bf16x8& hi, bf16x8& lo) {
    u32x4 h, l;
    unsigned hw[4], lw[4];
#pragma unroll
    for (int i = 0; i < 4; ++i) { const unsigned p = pkbf(x[2 * i], x[2 * i + 1]); hw[i] = p; lw[i] = pkbf(x[2 * i] - bflo(p), x[2 * i + 1] - bfhi(p)); }
    h.x = hw[0]; h.y = hw[1]; h.z = hw[2]; h.w = hw[3]; l.x = lw[0]; l.y = lw[1]; l.z = lw[2]; l.w = lw[3];
    hi = __builtin_bit_cast(bf16x8, h); lo = __builtin_bit_cast(bf16x8, l);
}
DI void pro1_filter2(const Args& a, LAS unsigned char* lds, int lane, int gw, int NGW) {
    LAS unsigned char* SG = lds + 34816 + (gw & 7) * 4608;
    const float* HID = (const float*)(a.ws + WS_HID);
    const float* wout = a.in[I_HYFWOUT];
    float* FSQP = (float*)(a.ws + WS_FSQP);
    bf16_t* RR0 = (bf16_t*)(a.ws + WS_RR);
    float* RRC = (float*)(a.ws + WS_RRC);
    const float dmin = logf(0.01f) / 1.5f, dmax = logf(0.01f) / 0.3f;
    const int l32 = lane & 31, kg = lane >> 5;
    const int G_ = NGW >> 3, uw = (gw & 7) * G_ + (gw >> 3);
    for (int unit = uw; unit < 128 * (FQ_LSEG + FQ_CSEG); unit += NGW) {
        const int ct = unit & 127, seg = unit >> 7;
        const int col0 = ct * 32, o = col0 >> 11, side = (col0 >> 10) & 1;
        bf16x8 whi[4], wlo[4];
#pragma unroll
        for (int ks = 0; ks < 4; ++ks) { float w[8];
#pragma unroll
            for (int j = 0; j < 8; ++j) w[j] = wout[(size_t)(16 * ks + 8 * kg + j) * 4096 + col0 + l32];
            split_bf16(w, whi[ks], wlo[ks]); }
        const unsigned cc = (unsigned)((col0 + l32) & 1023), row = (unsigned)(o * 1024) + cc;
        const float dl2 = -fabsf(dmin + (float)cc * ((dmax - dmin) / 1023.0f)) * 1.4426950408889634f;
        const bool lat = seg < FQ_LSEG;
        const int n = lat ? 8192 : 256, ntile = lat ? 8192 / FQ_LSEG / 32 : 256 / FQ_CSEG / 32, tbase = lat ? seg * (8192 / FQ_LSEG) : (seg - FQ_LSEG) * (256 / FQ_CSEG), ttoff = lat ? 0 : 8192;
        const float rn1 = 1.0f / (float)(n - 1);
        const int toff = side == 0 ? 1 : 0;
        const bool extra = (side == 0) && tbase == 0;
        const int ntl = ntile + (extra ? 1 : 0);
        float sq = 0.f;
        f32x4 hq[8];
#define FQ_TB(tile) ((tile) == ntile ? 0 : tbase + toff + (tile) * 32)
#define FQ_LOAD(tile) do { int tl_ = FQ_TB(tile) + l32; tl_ = tl_ < n ? tl_ : n - 1;   \
            const f32x4* hp = (const f32x4*)(HID + (size_t)(ttoff + tl_) * 64 + 8 * kg); _Pragma("unroll") for (int ks = 0; ks < 4; ++ks) { hq[2 * ks] = hp[4 * ks]; hq[2 * ks + 1] = hp[4 * ks + 1]; } } while (0)
        FQ_LOAD(0);
        for (int tile = 0; tile < ntl; ++tile) {
            const bool ex = tile == ntile;
            const int tb = FQ_TB(tile);
            f32x16 acc;
#pragma unroll
            for (int r = 0; r < 16; ++r) acc[r] = 0.f;
#pragma unroll
            for (int ks = 0; ks < 4; ++ks) { const f32x4 h0 = hq[2 * ks], h1 = hq[2 * ks + 1]; const float hv[8] = {h0[0], h0[1], h0[2], h0[3], h1[0], h1[1], h1[2], h1[3]};
                bf16x8 hhi, hlo; split_bf16(hv, hhi, hlo);
                acc = MFMA32(hhi, whi[ks], acc); acc = MFMA32(hlo, whi[ks], acc); acc = MFMA32(hhi, wlo[ks], acc); }
            if (tile + 1 < ntl) FQ_LOAD(tile + 1);
#pragma unroll
            for (int g = 0; g < 4; ++g) {
                const int t0g = tb + 8 * g + 4 * kg;
                float v[4];
#pragma unroll
                for (int q = 0; q < 4; ++q) { const int t = t0g + q; const bool ok = ex ? (t == 0) : ((t < n) && !(side == 1 && t == 0));
                    const float x = acc[4 * g + q] * __builtin_amdgcn_exp2f((float)t * rn1 * dl2); v[q] = ok ? x : 0.f; sq += v[q] * v[q]; }
                if (ex) { if (g == 0 && kg == 0) { if (lat) RR0[row * (unsigned)RRS + (unsigned)n] = f2bf1(v[0]); else RRC[row * 512u + (unsigned)n] = v[0]; } }
                else if (lat) { const int tl = (tile & 1) * 32 + 8 * g + 4 * kg;
                    u32x2 w; if (side == 0) { w.x = pkbf(v[3], v[2]); w.y = pkbf(v[1], v[0]); } else { w.x = pkbf(v[0], v[1]); w.y = pkbf(v[2], v[3]); }
                    *(LAS u32x2*)(SG + l32 * 144 + (side == 0 ? 60 - tl : tl) * 2) = w; }
                else if (side == 0) { const unsigned idx = (unsigned)(n - t0g - 3);
                    if (lat) { u32x2 w; w.x = pkbf(v[3], v[2]); w.y = pkbf(v[1], v[0]); *(u32x2*)(RR0 + (row * (unsigned)RRS + idx)) = w; }
                    else *(f32x4*)(RRC + (row * 512u + idx)) = (f32x4){v[3], v[2], v[1], v[0]}; }
                else { const unsigned idx = (unsigned)(n + t0g);
                    if (t0g == 0) {
#pragma unroll
                        for (int q = 1; q < 4; ++q) { if (lat) RR0[row * (unsigned)RRS + idx + q] = f2bf1(v[q]); else RRC[row * 512u + idx + q] = v[q]; } }
                    else if (lat) { u32x2 w; w.x = pkbf(v[0], v[1]); w.y = pkbf(v[2], v[3]); *(u32x2*)(RR0 + (row * (unsigned)RRS + idx)) = w; }
                    else *(f32x4*)(RRC + (row * 512u + idx)) = (f32x4){v[0], v[1], v[2], v[3]}; }
            }
            if (lat && !ex && (tile & 1)) {
                LDS_WAIT(); __builtin_amdgcn_wave_barrier();
                const int tp0 = tb - 32;
                const unsigned idx0 = side == 0 ? (unsigned)(n - tp0 - 63) : (unsigned)(n + tp0);
                const int piece = lane & 7;
#pragma unroll
                for (int j = 0; j < 4; ++j) { const int col = (lane >> 3) + 8 * j;
                    const u32x4 ov = *(const LAS u32x4*)(SG + col * 144 + piece * 16);
                    bf16_t* dp = RR0 + (((unsigned)(o * 1024) + (unsigned)((col0 + col) & 1023)) * (unsigned)RRS + idx0 + (unsigned)piece * 8u);
                    if (side == 1 && tp0 == 0 && piece == 0) {
                        dp[1] = (bf16_t)(ov.x >> 16); *(unsigned*)(dp + 2) = ov.y; *(u32x2*)(dp + 4) = (u32x2){ov.z, ov.w}; }
                    else *(u32x4*)dp = ov; }
                __builtin_amdgcn_wave_barrier();
            }
        }
#undef FQ_TB
#undef FQ_LOAD
        sq += __shfl_xor(sq, 32);
        if (kg == 0) FSQP[(size_t)seg * 4096 + col0 + l32] = sq;
    }
}

template <int LAYER> DI void phase_A(const Args& a, int lane, int gw, int NGW) {
    constexpr int nrows = (LAYER >= 3) ? TX : TR;
    float* X = (float*)(a.ws + WS_X); bf16_t* H = (bf16_t*)(a.ws + WS_H);
    const int* TS = (const int*)(a.ws + WS_TOKSLOT); const bf16_t* Y = (const bf16_t*)(a.ws + WS_Y);
    for (int r = gw; r < nrows; r += NGW) {
        const int mi = mod_index(r);
        f32x4 v[4];
        if (LAYER == 0) { const f32x4* src = (const f32x4*)(r < TX ? a.in[I_X] + (size_t)r * 1024 : a.in[I_CTX] + (size_t)(r - TX) * 1024) + lane;
#pragma unroll
            for (int j = 0; j < 4; ++j) v[j] = src[64 * j]; }
        else {
            const f32x4* src = (const f32x4*)(X + (size_t)r * 1024) + lane;
#pragma unroll
            for (int j = 0; j < 4; ++j) v[j] = src[64 * j];
            const bool has = (r < TX) || (LAYER - 1 <= 1);
            if (has) {
                f32x4 acc[4];
#pragma unroll
                for (int j = 0; j < 4; ++j) acc[j] = (f32x4){0.f, 0.f, 0.f, 0.f};
                const int tsv = lane < 16 ? (r < TX ? TS[(size_t)((r >> 13) * 16 + lane) * 8192 + (r & 8191)] : TS[AFFC_OFF + (((r - TX) >> 8) * 16 + lane) * 256 + ((r - TX) & 255)]) : -1;
                unsigned long long msk = __ballot(tsv >= 0);
                while (msk) {
                    int sl[4], ex[4];
#pragma unroll
                    for (int q = 0; q < 4; ++q) { if (msk) { const int e = __builtin_ctzll(msk); msk &= msk - 1; ex[q] = e; sl[q] = __builtin_amdgcn_readlane(tsv, e); } else { ex[q] = 0; sl[q] = -1; } }
                    u32x2 w[4][4];
#pragma unroll
                    for (int q = 0; q < 4; ++q) { if (sl[q] >= 0) { const u32x2* yp = (const u32x2*)(Y + ((size_t)ex[q] * EROWS + sl[q]) * 1024) + lane;
#pragma unroll
                            for (int j = 0; j < 4; ++j) w[q][j] = yp[64 * j]; }
                        else {
#pragma unroll
                            for (int j = 0; j < 4; ++j) w[q][j] = (u32x2){0u, 0u}; } }
#pragma unroll
                    for (int q = 0; q < 4; ++q)
#pragma unroll
                        for (int j = 0; j < 4; ++j) acc[j] += (f32x4){bflo(w[q][j].x), bfhi(w[q][j].x), bflo(w[q][j].y), bfhi(w[q][j].y)};
                }
                const f32x4* g2 = (const f32x4*)modp(a, LAYER - 1, mi, 5) + lane;
#pragma unroll
                for (int j = 0; j < 4; ++j) v[j] += g2[64 * j] * acc[j];
            }
        }
        if (LAYER == 4) { f32x4* o = (f32x4*)(a.out + (size_t)r * 1024) + lane;
#pragma unroll
            for (int j = 0; j < 4; ++j) o[64 * j] = v[j];
            continue; }
        { f32x4* o = (f32x4*)(X + (size_t)r * 1024) + lane;
#pragma unroll
          for (int j = 0; j < 4; ++j) o[64 * j] = v[j]; }
        float ss = 0.f;
#pragma unroll
        for (int j = 0; j < 4; ++j) ss += (v[j][0] * v[j][0] + v[j][1] * v[j][1]) + (v[j][2] * v[j][2] + v[j][3] * v[j][3]);
        const float rs = 1.0f / sqrtf(wave_sum(ss) * (1.0f / 1024.0f) + EPS);
        constexpr int LY = LAYER < 4 ? LAYER : 0;
        const f32x4* sh = (const f32x4*)modp(a, LY, mi, 0) + lane; const f32x4* sc = (const f32x4*)modp(a, LY, mi, 1) + lane;
        u32x2* ho = (u32x2*)(H + (size_t)r * 1024) + lane;
#pragma unroll
        for (int j = 0; j < 4; ++j) { const f32x4 y = v[j] * rs * (sc[64 * j] + 1.0f) + sh[64 * j]; u32x2 w; w.x = pkbf(y[0], y[1]); w.y = pkbf(y[2], y[3]); ho[64 * j] = w; }
    }
}

template <int LAYER> DI void phase_moe_prep(const Args& a, LAS unsigned char* lds, int tid, int lane, int gw, int NGW) {
    constexpr int nrows = (LAYER >= 2) ? TX : TR;
    LAS float* wr = (LAS float*)lds;
    { const u32x4* src = (const u32x4*)(a.ws + WS_WRT) + (size_t)LAYER * 4096;
#pragma unroll
      for (int n = 0; n < 8; ++n) ((LAS u32x4*)lds)[tid + NTHR * n] = src[tid + NTHR * n]; }
    __syncthreads();
    const float* X = (const float*)(a.ws + WS_X); bf16_t* H = (bf16_t*)(a.ws + WS_H); float* AFF = (float*)(a.ws + WS_AFF);
    const bool b0 = lane & 1, b1 = lane & 2, b2 = lane & 4, b3 = lane & 8, b4 = lane & 16;
    constexpr int NR = 2, NG = nrows / NR, NGX = TX / NR;
    const int nlat = (NGX - gw + NGW - 1) / NGW, tstride = NGW >> 3, ntail = ((gw & 7) == 5 && (gw >> 3) < NG - NGX) ? (NG - NGX - (gw >> 3) + tstride - 1) / tstride : 0;
    const int ntrip = nlat + ntail;
#define MP_GROUP(it) ((it) < nlat ? gw + (it) * NGW : NGX + (gw >> 3) + ((it) - nlat) * tstride)
    f32x4 v[NR][4], nx[NR][4];
    if (ntrip > 0) { const int r0 = NR * MP_GROUP(0);
#pragma unroll
        for (int q = 0; q < NR; ++q) { const f32x4* src = (const f32x4*)(X + (size_t)(r0 + q) * 1024) + lane;
#pragma unroll
            for (int j = 0; j < 4; ++j) v[q][j] = src[64 * j]; } }
    for (int it = 0; it < ntrip; ++it) {
        const int r0 = NR * MP_GROUP(it), mi = mod_index(r0);
        const f32x4* sh = (const f32x4*)modp(a, LAYER, mi, 3) + lane; const f32x4* sc = (const f32x4*)modp(a, LAYER, mi, 4) + lane;
        f32x4 shv[4], scv[4];
#pragma unroll
        for (int j = 0; j < 4; ++j) { shv[j] = sh[64 * j]; scv[j] = sc[64 * j] + 1.0f; }
        if (it + 1 < ntrip) { const int r1 = NR * MP_GROUP(it + 1);
#pragma unroll
            for (int q = 0; q < NR; ++q) { const f32x4* src = (const f32x4*)(X + (size_t)(r1 + q) * 1024) + lane;
#pragma unroll
                for (int j = 0; j < 4; ++j) nx[q][j] = src[64 * j]; } }
#pragma unroll
        for (int q = 0; q < NR; ++q) {
            float ss = 0.f;
#pragma unroll
            for (int j = 0; j < 4; ++j) ss += (v[q][j][0] * v[q][j][0] + v[q][j][1] * v[q][j][1]) + (v[q][j][2] * v[q][j][2] + v[q][j][3] * v[q][j][3]);
            const float rs = 1.0f / sqrtf(wave_sum(ss) * (1.0f / 1024.0f) + EPS);
            u32x2* ho = (u32x2*)(H + (size_t)(r0 + q) * 1024) + lane;
#pragma unroll
            for (int j = 0; j < 4; ++j) { v[q][j] = v[q][j] * rs * scv[j] + shv[j]; u32x2 w; w.x = pkbf(v[q][j][0], v[q][j][1]); w.y = pkbf(v[q][j][2], v[q][j][3]); ho[64 * j] = w; }
        }
        float u[NR];
#pragma unroll
        for (int h = 0; h < 2; ++h) {
            float s[NR][8];
#pragma unroll
            for (int e = 0; e < 8; ++e) {
                f32x4 w4[4];
#pragma unroll
                for (int j = 0; j < 4; ++j) w4[j] = *(const LAS f32x4*)(wr + (8 * h + e) * 1024 + j * 256 + lane * 4);
#pragma unroll
                for (int q = 0; q < NR; ++q) { f32x2 t = (f32x2){0.f, 0.f};
#pragma unroll
                    for (int j = 0; j < 4; ++j) { t += (f32x2){v[q][j][0], v[q][j][1]} * (f32x2){w4[j][0], w4[j][1]}; t += (f32x2){v[q][j][2], v[q][j][3]} * (f32x2){w4[j][2], w4[j][3]}; }
                    s[q][e] = t.x + t.y; }
            }
#pragma unroll
            for (int q = 0; q < NR; ++q) {
                float t4[4], t2[2];
#pragma unroll
                for (int i = 0; i < 4; ++i) t4[i] = (b0 ? s[q][2 * i + 1] : s[q][2 * i]) + dppf<DPP_XOR1>(b0 ? s[q][2 * i] : s[q][2 * i + 1]);
#pragma unroll
                for (int i = 0; i < 2; ++i) t2[i] = (b1 ? t4[2 * i + 1] : t4[2 * i]) + dppf<DPP_XOR2>(b1 ? t4[2 * i] : t4[2 * i + 1]);
                float t1 = (b2 ? t2[1] : t2[0]) + dppf<DPP_ROR(4)>(b2 ? t2[0] : t2[1]);
                t1 += dppf<DPP_ROR(8)>(t1);
                u[q] = (h == 0) ? t1 : (b3 ? t1 : u[q]);
            }
        }
        float lg = (b4 ? u[1] : u[0]) + __shfl_xor(b4 ? u[0] : u[1], 16);
        lg += __shfl_xor(lg, 32);
        const float ex = expf(lg - row_max16(lg)), pr = ex / row_sum16(ex);
        if (lane < 32) { const int r = r0 + (lane >> 4), e = lane & 15;
            if (r < TX) AFF[(size_t)((r >> 13) * 16 + e) * 8192 + (r & 8191)] = pr; else AFF[AFFC_OFF + (((r - TX) >> 8) * 16 + e) * 256 + ((r - TX) & 255)] = pr; }
#pragma unroll
        for (int q = 0; q < NR; ++q)
#pragma unroll
            for (int j = 0; j < 4; ++j) v[q][j] = nx[q][j];
    }
#undef MP_GROUP
}

template <int LAYER> DI void phase_topk(const Args& a, LAS unsigned char* lds, int tid, int lane, int wave) {
    constexpr int nprob = (LAYER >= 2) ? 32 : 64;
    const float* AFF = (const float*)(a.ws + WS_AFF);
    int* TS = (int*)(a.ws + WS_TOKSLOT); int* SELTOK = (int*)(a.ws + WS_SELTOK); float* SELG = (float*)(a.ws + WS_SELG);
    LAS unsigned* red = (LAS unsigned*)lds;
    LAS unsigned* scan = (LAS unsigned*)(lds + 256);
    LAS unsigned* hist = (LAS unsigned*)(lds + 512);
    for (int p = blockIdx.x; p < nprob; p += gridDim.x) {
        const bool isx = p < 32; const int pb = isx ? p : p - 32; const int b = pb >> 4, e = pb & 15;
        const int N = isx ? 8192 : 256, cap = isx ? CAPX : CAPC, rowbase = isx ? b * 8192 : TX + b * 256, slotbase = isx ? b * 1024 : 2048 + b * 32;
        const size_t pbase = isx ? (size_t)pb * 8192 : (size_t)AFFC_OFF + pb * 256;
        unsigned key[16];
        const bool active = tid * 16 < N;
#pragma unroll
        for (int i4 = 0; i4 < 4; ++i4) { u32x4 k4 = (u32x4){0u, 0u, 0u, 0u}; if (active) k4 = *(const u32x4*)(AFF + pbase + tid * 16 + i4 * 4);
            key[4 * i4] = k4.x; key[4 * i4 + 1] = k4.y; key[4 * i4 + 2] = k4.z; key[4 * i4 + 3] = k4.w; }
        unsigned T = 0u; unsigned kneed = (unsigned)cap;
#pragma unroll 1
        for (int pass = 0; pass < 4; ++pass) {
            const int shift = pass == 0 ? 23 : pass == 1 ? 15 : pass == 2 ? 7 : 0;
            const int nbits = pass == 3 ? 7 : 8;
            if (tid < 256) hist[tid] = 0u;
            __syncthreads();
            if (active) {
#pragma unroll
                for (int i = 0; i < 16; ++i) { const unsigned kk = key[i]; if ((kk >> (shift + nbits)) == (T >> (shift + nbits))) __hip_atomic_fetch_add(&hist[(kk >> shift) & ((1u << nbits) - 1u)], 1u, __ATOMIC_RELAXED, __HIP_MEMORY_SCOPE_WORKGROUP); }
            }
            __syncthreads();
            if (wave == 0) {
                const unsigned h0 = hist[4 * lane], h1 = hist[4 * lane + 1], h2 = hist[4 * lane + 2], h3 = hist[4 * lane + 3];
                unsigned suf = h0 + h1 + h2 + h3;
#pragma unroll
                for (int o = 1; o < 64; o <<= 1) { const unsigned t2 = __shfl_down(suf, o); if (lane + o < 64) suf += t2; }
                const unsigned above = suf - (h0 + h1 + h2 + h3);
                unsigned a3 = above, a2 = a3 + h3, a1 = a2 + h2, a0 = a1 + h1;
                int dsel = -1; unsigned asel = 0;
                if (a3 < kneed && kneed <= a3 + h3) { dsel = 4 * lane + 3; asel = a3; }
                else if (a2 < kneed && kneed <= a2 + h2) { dsel = 4 * lane + 2; asel = a2; }
                else if (a1 < kneed && kneed <= a1 + h1) { dsel = 4 * lane + 1; asel = a1; }
                else if (a0 < kneed && kneed <= a0 + h0) { dsel = 4 * lane; asel = a0; }
                if (dsel >= 0) { red[0] = (unsigned)dsel; red[1] = kneed - asel; }
            }
            __syncthreads();
            T |= red[0] << shift; kneed = red[1];
        }
        unsigned cg = 0, ce = 0;
#pragma unroll
        for (int i = 0; i < 16; ++i) { cg += (active && key[i] > T) ? 1u : 0u; ce += (active && key[i] == T) ? 1u : 0u; }
        unsigned ig = cg, ie = ce;
#pragma unroll
        for (int o = 1; o < 64; o <<= 1) { const unsigned tg = __shfl_up(ig, o), te = __shfl_up(ie, o); if (lane >= o) { ig += tg; ie += te; } }
        __syncthreads();
        if (lane == 63) { scan[wave * 2] = ig; scan[wave * 2 + 1] = ie; }
        __syncthreads();
        unsigned bg = 0, be = 0, totg = 0;
#pragma unroll
        for (int w8 = 0; w8 < 8; ++w8) { const unsigned g8 = scan[w8 * 2], e8 = scan[w8 * 2 + 1]; if (w8 < wave) { bg += g8; be += e8; } totg += g8; }
        unsigned pg = bg + ig - cg, pe = be + ie - ce;
        const unsigned need_eq = (unsigned)cap - totg;
        if (active) {
            int slots[16];
#pragma unroll
            for (int i = 0; i < 16; ++i) {
                const int row = rowbase + tid * 16 + i;
                const bool gt = key[i] > T, eq = key[i] == T;
                const bool sel = gt || (eq && pe < need_eq);
                int slot = -1;
                if (sel) { slot = slotbase + (int)(pg + (pe < need_eq ? pe : need_eq)); SELTOK[e * EROWS + slot] = row; SELG[e * EROWS + slot] = __uint_as_float(key[i]); }
                slots[i] = slot;
                pg += gt ? 1u : 0u; pe += eq ? 1u : 0u;
            }
#pragma unroll
            for (int i4 = 0; i4 < 4; ++i4) *(u32x4*)(TS + pbase + tid * 16 + i4 * 4) = (u32x4){(unsigned)slots[4 * i4], (unsigned)slots[4 * i4 + 1], (unsigned)slots[4 * i4 + 2], (unsigned)slots[4 * i4 + 3]};
        }
        __syncthreads();
    }
}

template <int LAYER> DI void phase_gather(const Args& a, int lane, int gw, int NGW) {
    constexpr int ER = (LAYER >= 2) ? 2048 : 2304, VALID = (LAYER >= 2) ? 2048 : 2112;
    const int* SELTOK = (const int*)(a.ws + WS_SELTOK); const bf16_t* H = (const bf16_t*)(a.ws + WS_H); bf16_t* XS = (bf16_t*)(a.ws + WS_BUF1);
    for (int sr = gw; sr < 16 * ER; sr += NGW) {
        const int e = sr / ER, s = sr - e * ER;
        u32x4* dst = (u32x4*)(XS + ((size_t)e * EROWS + s) * 1024) + lane;
        if (s < VALID) { const int row = __builtin_amdgcn_readfirstlane(SELTOK[e * EROWS + s]); const u32x4* src = (const u32x4*)(H + (size_t)row * 1024) + lane; dst[0] = src[0]; dst[64] = src[64]; }
        else { dst[0] = (u32x4){0u, 0u, 0u, 0u}; dst[64] = (u32x4){0u, 0u, 0u, 0u}; }
    }
}

template <int J, int NCHUNK> DI void phase_sg_vnt(const Args& a, LAS unsigned char* lds, int tid, int lane, int wave) {
    const bf16_t* ZZ = (const bf16_t*)(a.ws + WS_BUF1); bf16_t* VNT = (bf16_t*)(a.ws + WS_BUF2);
    const float* VSQ = (const float*)(a.ws + WS_VSQ);
    const float* gain = a.in[I_SGVG] + J * 2048;
    LAS float* rsq = (LAS float*)lds;
    LAS bf16_t* T = (LAS bf16_t*)(lds + 512);
    constexpr int NLAT = TX / 64, NCTXU = (NCHUNK * 2 - NLAT) * 8;
    for (int unit = blockIdx.x; unit < NLAT + NCTXU; unit += gridDim.x) {
        const bool lat = unit < NLAT;
        const int hc = lat ? unit : NLAT + ((unit - NLAT) >> 3);
        const int chunk = hc >> 1, q0 = (hc & 1) * 64;
        const int g0 = lat ? 0 : ((unit - NLAT) & 7), g1 = lat ? 8 : g0 + 1;
        if (lat) {
            const f32x4 p = *(const f32x4*)(VSQ + ((size_t)chunk * 128 + q0 + (tid >> 3)) * 32 + (tid & 7) * 4);
            float ss = (p[0] + p[1]) + (p[2] + p[3]);
            ss += dppf<DPP_XOR1>(ss); ss += dppf<DPP_XOR2>(ss); ss += dppf<0x141>(ss);
            if ((tid & 7) == 0) rsq[tid >> 3] = 1.0f / sqrtf(ss * (1.0f / 2048.0f) + EPS);
        } else {
#pragma unroll
            for (int qb = 0; qb < 2; ++qb) {
                u32x4 w[4][4];
#pragma unroll
                for (int qi = 0; qi < 4; ++qi) { const u32x4* vp = (const u32x4*)(ZZ + ((size_t)chunk * 128 + q0 + wave * 8 + qb * 4 + qi) * 4096 + 2048) + lane;
#pragma unroll
                    for (int j = 0; j < 4; ++j) w[qi][j] = vp[64 * j]; }
#pragma unroll
                for (int qi = 0; qi < 4; ++qi) { float ss = 0.f;
#pragma unroll
                    for (int j = 0; j < 4; ++j) { const u32x4 x = w[qi][j]; const float x0 = bflo(x.x), x1 = bfhi(x.x), x2 = bflo(x.y), x3 = bfhi(x.y), x4 = bflo(x.z), x5 = bfhi(x.z), x6 = bflo(x.w), x7 = bfhi(x.w);
                        ss += (x0 * x0 + x1 * x1) + (x2 * x2 + x3 * x3) + (x4 * x4 + x5 * x5) + (x6 * x6 + x7 * x7); }
                    ss = wave_sum(ss);
                    if (lane == 0) rsq[wave * 8 + qb * 4 + qi] = 1.0f / sqrtf(ss * (1.0f / 2048.0f) + EPS); }
            }
        }
        const int qa = tid >> 5, c8 = (tid & 31) * 8, ng = lat ? 8 : 1;
        u32x4 buf[8][4];
#pragma unroll
        for (int gi = 0; gi < 8; ++gi) if (gi < ng) {
#pragma unroll
            for (int k = 0; k < 4; ++k) buf[gi][k] = *(const u32x4*)(ZZ + ((size_t)chunk * 128 + q0 + qa + 16 * k) * 4096 + 2048 + (g0 + gi) * 256 + c8); }
        __syncthreads();
#pragma unroll
        for (int gi = 0; gi < 8; ++gi) if (gi < ng) {
            const int g = g0 + gi;
            const f32x4 g0v = *(const f32x4*)(gain + g * 256 + c8), g1v = *(const f32x4*)(gain + g * 256 + c8 + 4);
#pragma unroll
            for (int k = 0; k < 4; ++k) { const int q = qa + 16 * k; const u32x4 w = buf[gi][k]; const float r = rsq[q];
                LAS unsigned* tp = (LAS unsigned*)(T + q * 258 + c8);
                tp[0] = pkbf(bflo(w.x) * r * g0v[0], bfhi(w.x) * r * g0v[1]); tp[1] = pkbf(bflo(w.y) * r * g0v[2], bfhi(w.y) * r * g0v[3]);
                tp[2] = pkbf(bflo(w.z) * r * g1v[0], bfhi(w.z) * r * g1v[1]); tp[3] = pkbf(bflo(w.w) * r * g1v[2], bfhi(w.w) * r * g1v[3]); }
            __syncthreads();
#pragma unroll
            for (int i4 = 0; i4 < 4; ++i4) { const int it = tid + NTHR * i4, q8 = it & 7, c = it >> 3;
                const LAS bf16_t* tp = T + (q8 * 8) * 258 + c;
                u32x4 o; o.x = (unsigned)tp[0] | ((unsigned)tp[258] << 16); o.y = (unsigned)tp[2 * 258] | ((unsigned)tp[3 * 258] << 16);
                o.z = (unsigned)tp[4 * 258] | ((unsigned)tp[5 * 258] << 16); o.w = (unsigned)tp[6 * 258] | ((unsigned)tp[7 * 258] << 16);
                *(u32x4*)(VNT + ((size_t)(chunk * 4 + (g >> 1)) * 256 + c) * 256 + (g & 1) * 128 + q0 + q8 * 8) = o; }
            __syncthreads();
        }
    }
}

DI void phase_hy_shortconv(const Args& a, LAS unsigned char* lds, int tid) {
    const bf16_t* UP = (const bf16_t*)(a.ws + WS_BUF1); bf16_t* UT = (bf16_t*)(a.ws + WS_BUF2); bf16_t* UTC = UT + (size_t)3 * 2 * 1024 * UTS;
    const float* cw = a.in[I_HYCW]; const float* cb = a.in[I_HYCB];
    LAS bf16_t* T = (LAS bf16_t*)lds;
    u32x4 w[3], nw[3]; f32x4 fw[2], nfw[2];
#define SC_LOAD(unit_, dw, dfw) do { const int tblk_ = (unit_) / 24, chb_ = (unit_) % 24; const bool isx_ = tblk_ < 256; \
        _Pragma("unroll") for (int i = 0; i < 2; ++i) { const int chg_ = chb_ * 128 + (tid >> 3) + 64 * i; dfw[i] = (f32x4){cw[chg_], cw[3072 + chg_], cw[2 * 3072 + chg_], cb[chg_]}; } \
        const int b_ = isx_ ? tblk_ >> 7 : (tblk_ - 256) >> 2, tb0_ = isx_ ? (tblk_ & 127) * 64 : ((tblk_ - 256) & 3) * 64, n_ = isx_ ? 8192 : 256; \
        const size_t rowbase_ = isx_ ? (size_t)b_ * 8192 : (size_t)TX + b_ * 256; \
        _Pragma("unroll") for (int k = 0; k < 3; ++k) { const int it = tid + NTHR * k; const int rr = it >> 4, c8 = (it & 15) * 8; const int t = tb0_ - 1 + rr; dw[k] = (u32x4){0u, 0u, 0u, 0u}; \
            if (it < 66 * 16 && t >= 0 && t < n_) dw[k] = *(const u32x4*)(UP + (rowbase_ + t) * 3072 + chb_ * 128 + c8); } } while (0)
    if ((int)blockIdx.x < 264 * 24) SC_LOAD((int)blockIdx.x, w, fw);
    for (int unit = blockIdx.x; unit < 264 * 24; unit += gridDim.x) {
        const int tblk = unit / 24, chb = unit % 24;
        const bool isx = tblk < 256;
        const int b = isx ? tblk >> 7 : (tblk - 256) >> 2, tb0 = isx ? (tblk & 127) * 64 : ((tblk - 256) & 3) * 64;
        if (unit + (int)gridDim.x < 264 * 24) SC_LOAD(unit + (int)gridDim.x, nw, nfw);
#pragma unroll
        for (int k = 0; k < 3; ++k) { const int it = tid + NTHR * k; const int rr = it >> 4, c8 = (it & 15) * 8;
            if (it < 66 * 16) { LAS unsigned* tp = (LAS unsigned*)(T + rr * 130 + c8); tp[0] = w[k].x; tp[1] = w[k].y; tp[2] = w[k].z; tp[3] = w[k].w; } }
        __syncthreads();
#pragma unroll
        for (int i2 = 0; i2 < 2; ++i2) { const int t8 = tid & 7, ch = (tid >> 3) + 64 * i2; const int chg = chb * 128 + ch;
            const float w0 = fw[i2][0], w1 = fw[i2][1], w2 = fw[i2][2], bb = fw[i2][3];
            float in[10];
#pragma unroll
            for (int k = 0; k < 10; ++k) in[k] = bf1(T[(t8 * 8 + k) * 130 + ch]);
            float o[8];
#pragma unroll
            for (int j = 0; j < 8; ++j) o[j] = w0 * in[j] + w1 * in[j + 1] + w2 * in[j + 2] + bb;
            u32x4 ov; ov.x = pkbf(o[0], o[1]); ov.y = pkbf(o[2], o[3]); ov.z = pkbf(o[4], o[5]); ov.w = pkbf(o[6], o[7]);
            const int part = chg >> 10, c = chg & 1023;
            if (isx) *(u32x4*)(UT + ((size_t)(part * 2 + b) * 1024 + c) * UTS + tb0 + t8 * 8) = ov;
            else *(u32x4*)(UTC + ((size_t)(part * 2 + b) * 1024 + c) * 256 + tb0 + t8 * 8) = ov; }
        __syncthreads();
#pragma unroll
        for (int k = 0; k < 3; ++k) w[k] = nw[k];
        fw[0] = nfw[0]; fw[1] = nfw[1];
    }
#undef SC_LOAD
}
DI void phase_hy_transpose(const Args& a, LAS unsigned char* lds, int lane, int wave, int gw, int NGW) {
    const bf16_t* Z2 = (const bf16_t*)(a.ws + WS_BUF3); const bf16_t* Z2C = Z2 + (size_t)2 * 1024 * UTS; bf16_t* ZA = (bf16_t*)(a.ws + WS_H);
    LAS bf16_t* T = (LAS bf16_t*)(lds + wave * 8704);
    const int l8 = lane >> 3, p8 = lane & 7;
    u32x4 w[8], nw[8];
#define TR_LOAD(unit_, dw) do { const bool isx_ = (unit_) < 4096; const int u_ = isx_ ? (unit_) : (unit_) - 4096; const int ntb_ = isx_ ? 128 : 4; const int b_ = u_ / (16 * ntb_), cb_ = (u_ / ntb_) & 15, tb_ = u_ % ntb_; \
        const size_t rs_ = isx_ ? (size_t)UTS : (size_t)256; const bf16_t* base_ = (isx_ ? Z2 : Z2C) + ((size_t)b_ * 1024 + cb_ * 64 + l8) * rs_ + tb_ * 64 + p8 * 8; \
        _Pragma("unroll") for (int k = 0; k < 8; ++k) dw[k] = *(const u32x4*)(base_ + (size_t)(8 * k) * rs_); } while (0)
    if (gw < 4096 + 128) TR_LOAD(gw, w);
    for (int unit = gw; unit < 4096 + 128; unit += NGW) {
        const bool isx = unit < 4096; const int u = isx ? unit : unit - 4096;
        const int ntb = isx ? 128 : 4; const int b = u / (16 * ntb), cb = (u / ntb) & 15, tb = u % ntb;
        if (unit + NGW < 4096 + 128) TR_LOAD(unit + NGW, nw);
#pragma unroll
        for (int k = 0; k < 8; ++k) { LAS unsigned* tp = (LAS unsigned*)(T + (8 * k + l8) * 66 + p8 * 8); tp[0] = w[k].x; tp[1] = w[k].y; tp[2] = w[k].z; tp[3] = w[k].w; }
        LDS_WAIT(); __builtin_amdgcn_wave_barrier();
        bf16_t* dst = ZA + ((isx ? (size_t)b * 8192 : (size_t)TX + b * 256) + tb * 64 + l8) * 1024 + cb * 64 + p8 * 8;
#pragma unroll
        for (int k = 0; k < 8; ++k) { const LAS bf16_t* tp = T + (p8 * 8) * 66 + 8 * k + l8; u32x4 o;
            o.x = (unsigned)tp[0] | ((unsigned)tp[66] << 16); o.y = (unsigned)tp[2 * 66] | ((unsigned)tp[3 * 66] << 16);
            o.z = (unsigned)tp[4 * 66] | ((unsigned)tp[5 * 66] << 16); o.w = (unsigned)tp[6 * 66] | ((unsigned)tp[7 * 66] << 16);
            *(u32x4*)(dst + (size_t)(8 * k) * 1024) = o; }
        LDS_WAIT(); __builtin_amdgcn_wave_barrier();
#pragma unroll
        for (int k = 0; k < 8; ++k) w[k] = nw[k];
    }
#undef TR_LOAD
}

DI void phase_da_prep(const Args& a, LAS unsigned char* lds, int tid) {
    const bf16_t* QKV = (const bf16_t*)(a.ws + WS_BUF1);
    bf16_t* Qn = (bf16_t*)(a.ws + WS_BUF2); bf16_t* Kn = Qn + (size_t)2 * 8 * 2 * 8192 * 64; bf16_t* VT = Kn + (size_t)2 * 8 * 2 * NKEY * 64;
    const float* rope = (const float*)(a.ws + WS_ROPE);
    LAS bf16_t* T = (LAS bf16_t*)lds;
    const int vid = tid >> 1, half = tid & 1, rl = vid & 63, which = vid >> 6; const int isk = which >> 1, m = which & 1;
    u32x4 wv[2], wq[4], nv[2], nq[4]; f32x4 rp4[8], nrp4[8];
    f32x4 gn4[8];
    { const f32x4* gp = (const f32x4*)((isk ? a.in[I_DAKG] : a.in[I_DAQG]) + half * 32);
#pragma unroll
      for (int k = 0; k < 8; ++k) gn4[k] = gp[k]; }
#define DP_LOAD(unit_, dv, dq, drp) do { const int rb_ = (unit_) >> 3, h_ = (unit_) & 7, r0_ = rb_ * 64; \
        if (r0_ < TX) { const int t_ = (r0_ + rl) & 8191; const f32x4* rq_ = (const f32x4*)(rope + (half == 0 ? (t_ >> 6) : (t_ & 63)) * 32); _Pragma("unroll") for (int k = 0; k < 8; ++k) drp[k] = rq_[k]; } \
        _Pragma("unroll") for (int k = 0; k < 2; ++k) { const int it = tid + NTHR * k; const int rl_ = it >> 4, c8 = (it & 15) * 8; dv[k] = *(const u32x4*)(QKV + (size_t)(r0_ + rl_) * 3072 + 2048 + h_ * 128 + c8); } \
        if (isk || r0_ < TX) { const u32x4* sp = (const u32x4*)(QKV + (size_t)(r0_ + rl) * 3072 + isk * 1024 + h_ * 128 + m * 64 + half * 32); _Pragma("unroll") for (int k = 0; k < 4; ++k) dq[k] = sp[k]; } } while (0)
    if ((int)blockIdx.x < 264 * 8) DP_LOAD((int)blockIdx.x, wv, wq, rp4);
    for (int unit = blockIdx.x; unit < 264 * 8; unit += gridDim.x) {
        const int rb = unit >> 3, h = unit & 7; const int r0 = rb * 64;
        const bool isx = r0 < TX;
        const int b = isx ? r0 >> 13 : (r0 - TX) >> 8;
        const int key0 = isx ? 256 + (r0 & 8191) : (r0 - TX) & 255;
        if (unit + (int)gridDim.x < 264 * 8) DP_LOAD(unit + (int)gridDim.x, nv, nq, nrp4);
#pragma unroll
        for (int k = 0; k < 2; ++k) { const int it = tid + NTHR * k; const int rl_ = it >> 4, c8 = (it & 15) * 8; LAS unsigned* tp = (LAS unsigned*)(T + rl_ * 130 + c8); tp[0] = wv[k].x; tp[1] = wv[k].y; tp[2] = wv[k].z; tp[3] = wv[k].w; }
        { const int r = r0 + rl;
          if (isk || isx) {
            float x[32];
#pragma unroll
            for (int k = 0; k < 4; ++k) { const u32x4 w = wq[k]; x[8 * k] = bflo(w.x); x[8 * k + 1] = bfhi(w.x); x[8 * k + 2] = bflo(w.y); x[8 * k + 3] = bfhi(w.y); x[8 * k + 4] = bflo(w.z); x[8 * k + 5] = bfhi(w.z); x[8 * k + 6] = bflo(w.w); x[8 * k + 7] = bfhi(w.w); }
            float ss = 0.f;
#pragma unroll
            for (int k = 0; k < 32; ++k) ss += x[k] * x[k];
            ss += dppf<DPP_XOR1>(ss);
            const float rinv = 1.0f / sqrtf(ss * (1.0f / 64.0f) + EPS);
#pragma unroll
            for (int k = 0; k < 32; ++k) x[k] = x[k] * rinv * gn4[k >> 2][k & 3];
            if (isx) {
#pragma unroll
                for (int f = 0; f < 16; ++f) { const float cs = rp4[f >> 1][2 * (f & 1)], sn = rp4[f >> 1][2 * (f & 1) + 1]; const float x1 = x[f], x2 = x[16 + f]; x[f] = x1 * cs - x2 * sn; x[16 + f] = x2 * cs + x1 * sn; } }
            if (!isk) {
#pragma unroll
                for (int k = 0; k < 32; ++k) x[k] *= QSCALE; }
            LAS u32x4* sp = (LAS u32x4*)(lds + 16640 + which * 8192 + rl * 128 + half * 64);
#pragma unroll
            for (int k = 0; k < 4; ++k) { u32x4 o; o.x = pkbf(x[8 * k], x[8 * k + 1]); o.y = pkbf(x[8 * k + 2], x[8 * k + 3]); o.z = pkbf(x[8 * k + 4], x[8 * k + 5]); o.w = pkbf(x[8 * k + 6], x[8 * k + 7]); sp[k ^ (rl & 3)] = o; }
          } }
        __syncthreads();
#pragma unroll
        for (int j = 0; j < 4; ++j) { const int xx = tid + NTHR * j, wh = xx >> 9, xr = xx & 511, rr = xr >> 3, pp = xr & 7;
            if (wh >= 2 || isx) {
                const u32x4 o = *(const LAS u32x4*)(lds + 16640 + wh * 8192 + rr * 128 + (pp >> 2) * 64 + ((pp & 3) ^ (rr & 3)) * 16);
                bf16_t* dp = (wh >> 1) ? Kn + ((size_t)((b * 8 + h) * 2 + (wh & 1)) * NKEY + key0) * 64 : Qn + ((size_t)((b * 8 + h) * 2 + (wh & 1)) * 8192 + (r0 & 8191)) * 64;
                ((u32x4*)dp)[xr] = o; } }
        for (int it = tid; it < 1024; it += NTHR) { const int e = it >> 3, j8 = it & 7; const int kb = 16 * (j8 >> 1) + 4 * (j8 & 1);
            const LAS bf16_t* tp = T + e;
            u32x4 o; o.x = (unsigned)tp[(kb + 0) * 130] | ((unsigned)tp[(kb + 1) * 130] << 16); o.y = (unsigned)tp[(kb + 2) * 130] | ((unsigned)tp[(kb + 3) * 130] << 16);
            o.z = (unsigned)tp[(kb + 8) * 130] | ((unsigned)tp[(kb + 9) * 130] << 16); o.w = (unsigned)tp[(kb + 10) * 130] | ((unsigned)tp[(kb + 11) * 130] << 16);
            *(u32x4*)(VT + ((size_t)(b * 8 + h) * 128 + e) * NKEY + key0 + j8 * 8) = o; }
        __syncthreads();
#pragma unroll
        for (int k = 0; k < 2; ++k) wv[k] = nv[k];
#pragma unroll
        for (int k = 0; k < 4; ++k) wq[k] = nq[k];
#pragma unroll
        for (int k = 0; k < 8; ++k) rp4[k] = nrp4[k];
    }
#undef DP_LOAD
}
DI bf16x8 pack8(const f32x16& x, int s) {
    u32x4 p;
    if (s == 0) { p.x = pkbf(x[0], x[1]); p.y = pkbf(x[2], x[3]); p.z = pkbf(x[4], x[5]); p.w = pkbf(x[6], x[7]); }
    else { p.x = pkbf(x[8], x[9]); p.y = pkbf(x[10], x[11]); p.z = pkbf(x[12], x[13]); p.w = pkbf(x[14], x[15]); }
    return __builtin_bit_cast(bf16x8, p);
}
constexpr int AT_STAGE = 32768;
DI void attn_issue_tile(LAS unsigned char* lds, int stage, const bf16_t* K0t, const bf16_t* K1t, const bf16_t* VTt, unsigned koff, unsigned voff0, unsigned voff1, int wave) {
    LAS unsigned char* sb = lds + stage * AT_STAGE;
    __builtin_amdgcn_global_load_lds((const unsigned*)((const char*)K0t + koff), (LAS unsigned*)(sb + wave * 1024), 16, 0, 0);
    __builtin_amdgcn_global_load_lds((const unsigned*)((const char*)K1t + koff), (LAS unsigned*)(sb + 8192 + wave * 1024), 16, 0, 0);
    __builtin_amdgcn_global_load_lds((const unsigned*)((const char*)VTt + voff0), (LAS unsigned*)(sb + 16384 + wave * 1024), 16, 0, 0);
    __builtin_amdgcn_global_load_lds((const unsigned*)((const char*)(VTt + (size_t)64 * NKEY) + voff1), (LAS unsigned*)(sb + 16384 + 8192 + wave * 1024), 16, 0, 0);
}
DI void phase_attn(const Args& a, LAS unsigned char* lds, int tid, int lane, int wave) {
    const bf16_t* Qn = (const bf16_t*)(a.ws + WS_BUF2); const bf16_t* Kn = Qn + (size_t)2 * 8 * 2 * 8192 * 64; const bf16_t* VT = Kn + (size_t)2 * 8 * 2 * NKEY * 64;
    bf16_t* AO = (bf16_t*)(a.ws + WS_BUF3);
    const float lam_init = 0.8f - 0.6f * expf(-0.3f * 2.0f);
    const int G = gridDim.x, blk = blockIdx.x;
    const int ql = lane & 31, kg = lane >> 5;
    const int pr = wave >> 1, m = wave & 1;
    for (int i = 0;; ++i) {
        int bh, qb;
        if (G == 256) { if (i >= 2) break; bh = (blk & 7) + 8 * i; qb = blk >> 3; }
        else { const int L = i * G + blk; if (L >= 512) break; bh = L >> 5; qb = L & 31; }
        const int b = bh >> 3, h = bh & 7;
        const int t0 = qb * 256 + pr * 64;
        const bf16_t* K0g = Kn + (size_t)(bh * 2 + 0) * NKEY * 64; const bf16_t* K1g = Kn + (size_t)(bh * 2 + 1) * NKEY * 64; const bf16_t* VTg = VT + (size_t)bh * 128 * NKEY;
        unsigned koff, voff0, voff1;
        { const int tid_ = wave * 64 + lane_id();
          const int key = tid_ >> 3, cl = (tid_ & 7) ^ ((key >> 1) & 7); koff = (unsigned)(key * 64 + cl * 8) * 2u;
          const int e0 = tid_ >> 3, c0 = (tid_ & 7) ^ ((e0 >> 1) & 7); voff0 = (unsigned)(e0 * NKEY + c0 * 8) * 2u;
          voff1 = voff0; }
        __syncthreads();
        attn_issue_tile(lds, 0, K0g, K1g, VTg, koff, voff0, voff1, wave);
        attn_issue_tile(lds, 1, K0g + 4096, K1g + 4096, VTg + 64, koff, voff0, voff1, wave);
        bf16x8 qf[4];
        LAS unsigned char* qlds = lds + 3 * AT_STAGE + wave * 4096;
        { int qlv = ql, kgv = kg; asm volatile("" : "+v"(qlv), "+v"(kgv));
          const unsigned qoff = (unsigned)(qlv * 64 + kgv * 8);
          const bf16_t* qbase = Qn + ((size_t)(bh * 2 + m) * 8192 + t0) * 64;
#pragma unroll
          for (int ks = 0; ks < 4; ++ks) qf[ks] = *(const bf16x8*)(qbase + (qoff + ks * 16));
#pragma unroll
          for (int ks = 0; ks < 4; ++ks) { const bf16x8 qb_ = *(const bf16x8*)(qbase + (qoff + 2048 + ks * 16)); *(LAS bf16x8*)(qlds + ks * 1024 + (qlv + 32 * kgv) * 16) = qb_; } }
        f32x16 O[2][4];
#pragma unroll
        for (int g2 = 0; g2 < 2; ++g2)
#pragma unroll
            for (int et = 0; et < 4; ++et)
#pragma unroll
                for (int r = 0; r < 16; ++r) O[g2][et][r] = 0.f;
        float lsum[2] = {0.f, 0.f};
        asm volatile("s_waitcnt vmcnt(0)" ::: "memory"); __builtin_amdgcn_s_barrier(); asm volatile("" ::: "memory");
        int st = 0, st2 = 2;
        for (int kt = 0; kt < NKEY / 64; ++kt) {
            int lanev = lane; asm volatile("" : "+v"(lanev));
            const int tidv = wave * 64 + lanev, qlv = lanev & 31, kgv = lanev >> 5;
            unsigned koff, voff0, voff1;
            { const int key = tidv >> 3, cl = (tidv & 7) ^ ((key >> 1) & 7); koff = (unsigned)(key * 64 + cl * 8) * 2u; voff0 = (unsigned)(key * NKEY + cl * 8) * 2u; voff1 = voff0; }
#define AT_KRO(ks_) ({ const int l_ = lane_id(); (unsigned)((l_ & 31) * 128 + ((((2 * (ks_)) + (l_ >> 5)) ^ (((l_ & 31) >> 1) & 7)) << 4)); })
            if (kt + 2 < NKEY / 64) attn_issue_tile(lds, st2, K0g + (size_t)(kt + 2) * 4096, K1g + (size_t)(kt + 2) * 4096, VTg + (size_t)(kt + 2) * 64, koff, voff0, voff1, wave);
            const LAS unsigned char* sb = lds + st * AT_STAGE + m * 8192;
            const LAS unsigned char* sv = lds + st * AT_STAGE + 16384;
#pragma unroll
            for (int k2 = 0; k2 < 2; ++k2) {
                bf16x8 kf[4];
#pragma unroll
                for (int ks = 0; ks < 4; ++ks) kf[ks] = *(const LAS bf16x8*)(sb + AT_KRO(ks) + k2 * 4096);
                f32x16 SA, SB;
#pragma unroll
                for (int r = 0; r < 16; ++r) { SA[r] = 0.f; SB[r] = 0.f; }
#pragma unroll
                for (int ks = 0; ks < 4; ++ks) SA = MFMA32(kf[ks], qf[ks], SA);
#pragma unroll
                for (int ks = 0; ks < 4; ++ks) { const bf16x8 qb_ = *(const LAS bf16x8*)(qlds + ks * 1024 + lane_id() * 16); SB = MFMA32(kf[ks], qb_, SB); }
#pragma unroll
                for (int r = 0; r < 8; ++r) SA[r] = __builtin_amdgcn_exp2f(SA[r]);
                float psA = 0.f, psB = 0.f;
                __builtin_amdgcn_sched_group_barrier(0x008, 4, 0);
#pragma unroll
                for (int i = 0; i < 4; ++i) { __builtin_amdgcn_sched_group_barrier(0x008, 1, 0); __builtin_amdgcn_sched_group_barrier(0x400, 2, 0); }
                __builtin_amdgcn_sched_barrier(0);
#pragma unroll
                for (int r = 0; r < 8; ++r) { SB[r] = __builtin_amdgcn_exp2f(SB[r]); psA += SA[r]; psB += SB[r]; }
                const bf16x8 pA0 = pack8(SA, 0), pB0 = pack8(SB, 0);
                bf16x8 vf[4];
                { const unsigned vro = AT_KRO(2 * k2);
#pragma unroll
                  for (int j = 0; j < 4; ++j) vf[j] = *(const LAS bf16x8*)(sv + vro + j * 4096); }
                __builtin_amdgcn_sched_barrier(0);
                O[0][0] = MFMA32(vf[0], pA0, O[0][0]); O[0][1] = MFMA32(vf[1], pA0, O[0][1]); O[1][0] = MFMA32(vf[0], pB0, O[1][0]); O[1][1] = MFMA32(vf[1], pB0, O[1][1]);
                O[0][2] = MFMA32(vf[2], pA0, O[0][2]); O[0][3] = MFMA32(vf[3], pA0, O[0][3]); O[1][2] = MFMA32(vf[2], pB0, O[1][2]); O[1][3] = MFMA32(vf[3], pB0, O[1][3]);
#pragma unroll
                for (int r = 8; r < 16; ++r) { SA[r] = __builtin_amdgcn_exp2f(SA[r]); SB[r] = __builtin_amdgcn_exp2f(SB[r]); }
#pragma unroll
                for (int i = 0; i < 8; ++i) { __builtin_amdgcn_sched_group_barrier(0x008, 1, 0); __builtin_amdgcn_sched_group_barrier(0x400, 2, 0); }
                __builtin_amdgcn_sched_barrier(0);
#pragma unroll
                for (int r = 8; r < 16; ++r) { psA += SA[r]; psB += SB[r]; }
                lsum[0] += psA; lsum[1] += psB;
                const bf16x8 pA1 = pack8(SA, 1), pB1 = pack8(SB, 1);
                { const unsigned vro = AT_KRO(2 * k2 + 1);
#pragma unroll
                  for (int j = 0; j < 4; ++j) vf[j] = *(const LAS bf16x8*)(sv + vro + j * 4096); }
                __builtin_amdgcn_sched_barrier(0);
                O[0][0] = MFMA32(vf[0], pA1, O[0][0]); O[0][1] = MFMA32(vf[1], pA1, O[0][1]); O[1][0] = MFMA32(vf[0], pB1, O[1][0]); O[1][1] = MFMA32(vf[1], pB1, O[1][1]);
                O[0][2] = MFMA32(vf[2], pA1, O[0][2]); O[0][3] = MFMA32(vf[3], pA1, O[0][3]); O[1][2] = MFMA32(vf[2], pB1, O[1][2]); O[1][3] = MFMA32(vf[3], pB1, O[1][3]);
                __builtin_amdgcn_sched_barrier(0);
            }
            if (kt + 2 < NKEY / 64) asm volatile("s_waitcnt vmcnt(4) lgkmcnt(0)" ::: "memory"); else asm volatile("s_waitcnt vmcnt(0) lgkmcnt(0)" ::: "memory");
            __builtin_amdgcn_s_barrier(); asm volatile("" ::: "memory");
            st = (st == 2) ? 0 : st + 1; st2 = (st2 == 2) ? 0 : st2 + 1;
        }
        float lam;
        { int lv = lane; asm volatile("" : "+v"(lv)); const float q1 = a.in[I_DALQ1][lv] * a.in[I_DALK1][lv], q2 = a.in[I_DALQ2][lv] * a.in[I_DALK2][lv];
          lam = expf(wave_sum(q1)) - expf(wave_sum(q2)) + lam_init; }
        LAS float* xb = (LAS float*)lds + pr * 8192 + lane;
#pragma unroll
        for (int g2 = 0; g2 < 2; ++g2) {
            const float ltot = lsum[g2] + __shfl_xor(lsum[g2], 32);
            if (m == 1) { const float i1 = lam / ltot;
#pragma unroll
                for (int et = 0; et < 4; ++et)
#pragma unroll
                    for (int r = 0; r < 16; ++r) xb[(g2 * 64 + et * 16 + r) * 64] = O[g2][et][r] * i1; }
            else lsum[g2] = 1.0f / ltot;
        }
        __syncthreads();
        if (m == 0) {
            int ql2 = ql, kg2 = kg; asm volatile("" : "+v"(ql2), "+v"(kg2));
            const float* sg = a.in[I_DASUB];
#pragma unroll
            for (int g2 = 0; g2 < 2; ++g2) {
                const float i0 = lsum[g2];
                float ss = 0.f;
#pragma unroll
                for (int et = 0; et < 4; ++et)
#pragma unroll
                    for (int r = 0; r < 16; ++r) { const float o = O[g2][et][r] * i0 - xb[(g2 * 64 + et * 16 + r) * 64]; O[g2][et][r] = o; ss += o * o; }
                ss += __shfl_xor(ss, 32);
                const float rn = (1.0f / sqrtf(ss * (1.0f / 128.0f) + EPS)) * (1.0f - lam_init);
                bf16_t* obase = AO + ((size_t)b * 8192 + t0 + g2 * 32) * 1024 + h * 128; const unsigned ooff = (unsigned)(ql2 * 1024 + 4 * kg2);
#pragma unroll
                for (int et = 0; et < 4; ++et)
#pragma unroll
                    for (int g4 = 0; g4 < 4; ++g4) { const int e0 = et * 32 + 8 * g4; const f32x4 gv = *(const f32x4*)(sg + (unsigned)(e0 + 4 * kg2));
                        u32x2 w; w.x = pkbf(O[g2][et][4 * g4] * rn * gv[0], O[g2][et][4 * g4 + 1] * rn * gv[1]); w.y = pkbf(O[g2][et][4 * g4 + 2] * rn * gv[2], O[g2][et][4 * g4 + 3] * rn * gv[3]);
                        *(u32x2*)(obase + (ooff + e0)) = w; }
            }
        }
    }
}
constexpr int CV_ZB = 25856;
constexpr int CV_FB = RRS * 2;
constexpr int CV_FO = 2 * CV_ZB;
DI int cv_pad(int y) { return y + ((y >> 7) << 3); }
DI void cv_filter_dma(LAS unsigned char* dst, const bf16_t* src, int lane, int wave) {
#pragma unroll
    for (int j = 0; j < 5; ++j) { const int i = wave + 8 * j; if (i < 33) __builtin_amdgcn_global_load_lds((const unsigned*)((const char*)src + i * 1024 + lane * 16), (LAS unsigned*)(dst + i * 1024), 16, 0, 0); }
}
DI void phase_hy_conv(const Args& a, LAS unsigned char* lds, int tid, int lane, int wave, int gw, int NGW) {
    const bf16_t* UT = (const bf16_t*)(a.ws + WS_BUF2); const bf16_t* UTC = UT + (size_t)3 * 2 * 1024 * UTS;
    bf16_t* Z2 = (bf16_t*)(a.ws + WS_BUF3); bf16_t* Z2C = Z2 + (size_t)2 * 1024 * UTS;
    const float* FSQP = (const float*)(a.ws + WS_FSQP);
    const bf16_t* RR = (const bf16_t*)(a.ws + WS_RR);
    const float* skip = a.in[I_HYSKIP];
    const int nt = wave & 3, kh = wave >> 2;
    const int ql = lane & 31, kg = lane >> 5, bcol = ql >> 4, ii = ql & 15, i0 = 16 * nt;
    const int par = ql & 1;
    LAS unsigned char* const fA = lds + CV_FO; LAS unsigned char* const fB = lds + CV_FO + CV_FB + 64;
    LAS unsigned* const CVL = (LAS unsigned*)(lds + 119808);
    float cv[32]; CvtTile ctile; ctile.src = nullptr; ctile.dst = nullptr; ctile.K = 0; ctile.N = 0; ctile.mode = 0;
    int gi = 0, cstage = 0, cslot = 0;
    __syncthreads();
    if ((int)blockIdx.x < 1024) cv_filter_dma(fA, RR + (size_t)blockIdx.x * RRS, lane, wave);
    for (int c = blockIdx.x; c < 1024; c += gridDim.x) {
        { u32x4 w[2][3];
#pragma unroll
          for (int b = 0; b < 2; ++b) { const bf16_t* vsrc = UT + ((size_t)(0 * 2 + b) * 1024 + c) * UTS;
#pragma unroll
              for (int k = 0; k < 3; ++k) { const int y = (tid + NTHR * k) * 8; w[b][k] = (u32x4){0u, 0u, 0u, 0u}; if (y >= 1920 && y < 1920 + 8192) w[b][k] = *(const u32x4*)(vsrc + (y - 1920)); } }
#pragma unroll
          for (int b = 0; b < 2; ++b)
#pragma unroll
              for (int k = 0; k < 3; ++k) { const int y = (tid + NTHR * k) * 8; if (y < 12160) *(LAS u32x4*)(lds + b * CV_ZB + cv_pad(y) * 2) = w[b][k]; } }
        float scl0, scl1;
        { float s0 = 0.f, s1 = 0.f;
          if (lane < FQ_LSEG) { s0 = FSQP[(size_t)lane * 4096 + c] + FSQP[(size_t)lane * 4096 + 1024 + c]; s1 = FSQP[(size_t)lane * 4096 + 2048 + c] + FSQP[(size_t)lane * 4096 + 3072 + c]; }
          scl0 = 1.0f / sqrtf(wave_sum(s0) + EPS); scl1 = 1.0f / sqrtf(wave_sum(s1) + EPS); }
        const LAS unsigned char* zrd = lds + bcol * CV_ZB;
        const int ybase = 128 * ii + 8 * kg;
#pragma unroll 1
        for (int o = 0; o < 2; ++o) {
            VM_WAIT(); __syncthreads();
            for (int d = tid; d < RRS / 2 - 1; d += NTHR) { const LAS unsigned* sa = (const LAS unsigned*)fA + d; ((LAS unsigned*)fB)[d] = __builtin_amdgcn_alignbit(sa[1], sa[0], 16); }
            __syncthreads();
            const LAS unsigned char* rp = (par ? fB : fA) + 2 * (6272 - 128 * i0 + 8 * kg - ql - par);
            f32x16 acc[4];
#pragma unroll
            for (int mt = 0; mt < 4; ++mt)
#pragma unroll
                for (int r = 0; r < 16; ++r) acc[mt][r] = 0.f;
            bf16x8 F[8];
            const int ks0 = kh * 320;
#define CV_RAW(d_, ks_) do { const LAS unsigned* q_ = (const LAS unsigned*)(rp + 32 * (ks_)); d_[0] = q_[0]; d_[1] = q_[1]; d_[2] = q_[2]; d_[3] = q_[3]; } while (0)
#define CV_MK(dst, d_) do { u32x4 f_; f_.x = d_[0]; f_.y = d_[1]; f_.z = d_[2]; f_.w = d_[3]; dst = __builtin_bit_cast(bf16x8, f_); } while (0)
#pragma unroll
            for (int d = -6; d < 0; ++d) { unsigned t_[4]; CV_RAW(t_, ks0 + d); CV_MK(F[d & 7], t_); }
            const LAS unsigned char* zq = zrd + 272 * (ii + (ks0 >> 3)) + 16 * kg;
            unsigned ra[4]; bf16x8 Bf;
            CV_RAW(ra, ks0); Bf = *(const LAS bf16x8*)(zq);
#pragma unroll 1
            for (int it = 0; it < 40; ++it) {
#pragma unroll
                for (int j = 0; j < 8; ++j) {
                    const int ks = ks0 + it * 8 + j;
                    CV_MK(F[j], ra);
                    const bf16x8 Bc = Bf;
                    const bool lastst = (it == 39 && j == 7);
                    CV_RAW(ra, lastst ? ks : ks + 1);
                    Bf = *(const LAS bf16x8*)(zq + (lastst ? 32 * j : (j == 7 ? 272 : 32 * (j + 1))));
                    acc[0] = MFMA32(F[j], Bc, acc[0]);
                    acc[1] = MFMA32(F[(j + 6) & 7], Bc, acc[1]);
                    acc[2] = MFMA32(F[(j + 4) & 7], Bc, acc[2]);
                    acc[3] = MFMA32(F[(j + 2) & 7], Bc, acc[3]);
                }
                zq += 272;
                { const int ph = (gi + (int)blockIdx.x) & 3;
                  if (ph == 0) { if (cstage == 2) { cvt_store(CVL, ctile, tid); cstage = 0; }
                      asm volatile("s_waitcnt lgkmcnt(0)" ::: "memory"); __builtin_amdgcn_s_barrier(); asm volatile("" ::: "memory");
                      const int t = CVT_T_MOE1 + (int)blockIdx.x + (int)gridDim.x * cslot; if (t < CVT_NTILES) { cvt_decode(a, t, ctile); cvt_load(ctile, cv, tid); cstage = 1; } ++cslot; }
                  else if (ph == 3) { if (cstage == 1) { cvt_pack(CVL, cv, tid); cstage = 2; }
                      asm volatile("s_waitcnt lgkmcnt(0)" ::: "memory"); __builtin_amdgcn_s_barrier(); asm volatile("" ::: "memory"); }
                  ++gi; }
            }
#undef CV_RAW
#undef CV_MK
            __syncthreads();
            { const int cn = (o == 0) ? c : c + (int)gridDim.x; if (cn < 1024) cv_filter_dma(fA, RR + ((size_t)(o ^ 1) * 1024 + cn) * RRS, lane, wave); }
            LAS float* red = (LAS float*)fB + nt * 2048 + lane;
            const float sk = skip[o * 1024 + c], sc = o == 0 ? scl0 : scl1;
            const bf16_t* gsrc = UT + ((size_t)((1 + o) * 2 + bcol) * 1024 + c) * UTS;
            LAS unsigned char* zw = lds + bcol * CV_ZB;
#pragma unroll
            for (int hp = 0; hp < 2; ++hp) {
                if (kh == 1) {
#pragma unroll
                    for (int m2 = 0; m2 < 2; ++m2)
#pragma unroll
                        for (int r = 0; r < 16; ++r) red[(m2 * 16 + r) * 64] = acc[2 * hp + m2][r];
                }
                __syncthreads();
                if (kh == 0) {
                    u32x2 gq[2][4];
#pragma unroll
                    for (int m2 = 0; m2 < 2; ++m2)
#pragma unroll
                        for (int g4 = 0; g4 < 4; ++g4) gq[m2][g4] = *(const u32x2*)(gsrc + (128 * (i0 + ii) + 32 * (2 * hp + m2) + 8 * g4 + 4 * kg));
                    u32x2 wq[2][4];
#pragma unroll
                    for (int m2 = 0; m2 < 2; ++m2)
#pragma unroll
                        for (int g4 = 0; g4 < 4; ++g4) {
                            const int mt = 2 * hp + m2;
                            const int t4 = 128 * (i0 + ii) + 32 * mt + 8 * g4 + 4 * kg;
                            const u32x2 gw2 = gq[m2][g4];
                            LAS u32x2* zp = (LAS u32x2*)(zw + cv_pad(t4 + 1920) * 2);
                            const u32x2 zo = *zp;
                            const float y0 = acc[mt][4 * g4] + red[(m2 * 16 + 4 * g4) * 64], y1 = acc[mt][4 * g4 + 1] + red[(m2 * 16 + 4 * g4 + 1) * 64];
                            const float y2 = acc[mt][4 * g4 + 2] + red[(m2 * 16 + 4 * g4 + 2) * 64], y3 = acc[mt][4 * g4 + 3] + red[(m2 * 16 + 4 * g4 + 3) * 64];
                            const float r0 = bflo(gw2.x) * (y0 * sc + sk * bflo(zo.x)), r1 = bfhi(gw2.x) * (y1 * sc + sk * bfhi(zo.x));
                            const float r2 = bflo(gw2.y) * (y2 * sc + sk * bflo(zo.y)), r3 = bfhi(gw2.y) * (y3 * sc + sk * bfhi(zo.y));
                            u32x2 w; w.x = pkbf(r0, r1); w.y = pkbf(r2, r3);
                            wq[m2][g4] = w;
                            if (o == 0) *zp = w;
                        }
                    if (o != 0) {
#pragma unroll
                        for (int m2 = 0; m2 < 2; ++m2)
#pragma unroll
                            for (int g4 = 0; g4 < 4; ++g4) *(u32x2*)(Z2 + ((size_t)bcol * 1024 + c) * UTS + (128 * (i0 + ii) + 32 * (2 * hp + m2) + 8 * g4 + 4 * kg)) = wq[m2][g4];
                    }
                }
                __syncthreads();
            }
        }
    }
    VM_WAIT();
    __syncthreads();
    if (cstage == 1) { cvt_pack(CVL, cv, tid); cstage = 2; }
    __syncthreads();
    if (cstage == 2) { cvt_store(CVL, ctile, tid); cstage = 0; }
    __syncthreads();
    for (int sl = cslot;; ++sl) { const int t = CVT_T_MOE1 + (int)blockIdx.x + (int)gridDim.x * sl; if (t >= CVT_NTILES) break;
        cvt_decode(a, t, ctile); cvt_load(ctile, cv, tid); cvt_pack(CVL, cv, tid); __syncthreads(); cvt_store(CVL, ctile, tid); __syncthreads(); }
    {
        const float* RRC = (const float*)(a.ws + WS_RRC);
        LAS float* zc = (LAS float*)(lds + wave * 6144);
        LAS float* rc = zc + 512;
        for (int c = gw; c < 1024; c += NGW) {
            float scl[2];
#pragma unroll
            for (int o = 0; o < 2; ++o) { float s = 0.f; if (lane < FQ_CSEG) s = FSQP[(size_t)(FQ_LSEG + lane) * 4096 + o * 2048 + c] + FSQP[(size_t)(FQ_LSEG + lane) * 4096 + o * 2048 + 1024 + c]; scl[o] = 1.0f / sqrtf(wave_sum(s) + EPS); }
            for (int k = lane; k < 1024; k += 64) { const int o = k >> 9, idx = k & 511; rc[k] = idx == 0 ? 0.f : RRC[(size_t)(o * 1024 + c) * 512 + idx]; }
            for (int k = lane; k < 512; k += 64) { const int b = k >> 8, t = k & 255; zc[k] = bf1(UTC[((size_t)(0 * 2 + b) * 1024 + c) * 256 + t]); }
            LDS_WAIT(); __builtin_amdgcn_wave_barrier();
#pragma unroll 1
            for (int o = 0; o < 2; ++o) {
                float y[2][4];
#pragma unroll
                for (int b = 0; b < 2; ++b)
#pragma unroll
                    for (int j = 0; j < 4; ++j) y[b][j] = 0.f;
                for (int s = 0; s < 256; ++s) { const float z0 = zc[s], z1 = zc[256 + s];
#pragma unroll
                    for (int j = 0; j < 4; ++j) { const float rv = rc[o * 512 + s - (lane + 64 * j) + 256]; y[0][j] += rv * z0; y[1][j] += rv * z1; } }
                float zn[2][4];
                const float sk = skip[o * 1024 + c];
#pragma unroll
                for (int b = 0; b < 2; ++b)
#pragma unroll
                    for (int j = 0; j < 4; ++j) { const int t = lane + 64 * j; const float g = bf1(UTC[((size_t)((1 + o) * 2 + b) * 1024 + c) * 256 + t]); zn[b][j] = g * (y[b][j] * (o == 0 ? scl[0] : scl[1]) + sk * zc[b * 256 + t]); }
                LDS_WAIT(); __builtin_amdgcn_wave_barrier();
#pragma unroll
                for (int b = 0; b < 2; ++b)
#pragma unroll
                    for (int j = 0; j < 4; ++j) { const int t = lane + 64 * j; if (o == 0) zc[b * 256 + t] = zn[b][j]; else Z2C[((size_t)b * 1024 + c) * 256 + t] = f2bf1(zn[b][j]); }
                LDS_WAIT(); __builtin_amdgcn_wave_barrier();
            }
        }
    }
}
template <class Epi> DI void small_gemm(LAS unsigned char* lds, int tid, int lane, int wave, int ntiles, int ntn, int K, const Epi& E) {
    const int rl = lane & 31, kg = lane >> 5;
    const int kslice = K >> 3, k0 = wave * kslice;
    LAS float* red = (LAS float*)lds;
    for (int t = blockIdx.x; t < ntiles; t += gridDim.x) {
        const int tm = t / ntn, tn = t - tm * ntn;
        const bf16_t* a0 = E.arow(tm, rl) + k0 + 8 * kg; const bf16_t* a1 = E.arow(tm, 32 + rl) + k0 + 8 * kg;
        const bf16_t* b0 = E.brow(tm, tn, rl) + k0 + 8 * kg; const bf16_t* b1 = E.brow(tm, tn, 32 + rl) + k0 + 8 * kg;
        f32x16 acc[2][2];
#pragma unroll
        for (int i = 0; i < 2; ++i)
#pragma unroll
            for (int j = 0; j < 2; ++j)
#pragma unroll
                for (int r = 0; r < 16; ++r) acc[i][j][r] = 0.f;
#pragma unroll 4
        for (int k = 0; k < kslice; k += 16) {
            const bf16x8 fa0 = *(const bf16x8*)(a0 + k), fa1 = *(const bf16x8*)(a1 + k), fb0 = *(const bf16x8*)(b0 + k), fb1 = *(const bf16x8*)(b1 + k);
            acc[0][0] = MFMA32(fa0, fb0, acc[0][0]); acc[0][1] = MFMA32(fa0, fb1, acc[0][1]);
            acc[1][0] = MFMA32(fa1, fb0, acc[1][0]); acc[1][1] = MFMA32(fa1, fb1, acc[1][1]);
        }
        __syncthreads();
#pragma unroll
        for (int i = 0; i < 2; ++i)
#pragma unroll
            for (int j = 0; j < 2; ++j)
#pragma unroll
                for (int r = 0; r < 16; ++r) red[wave * 4096 + ((i * 2 + j) * 16 + r) * 64 + lane] = acc[i][j][r];
        __syncthreads();
        { const int row = tid >> 3, c8 = (tid & 7) * 8;
          const int mt = row >> 5, rr = row & 31, kgs = (rr >> 2) & 1, r = (rr & 3) + 4 * (rr >> 3);
          const int nt = c8 >> 5;
          const LAS float* rp = red + ((mt * 2 + nt) * 16 + r) * 64 + (c8 & 31) + 32 * kgs;
          float v[8];
#pragma unroll
          for (int j = 0; j < 8; ++j) { float s = 0.f;
#pragma unroll
              for (int w = 0; w < 8; ++w) s += rp[w * 4096 + j];
              v[j] = s; }
          E.store(tm, tn, row, c8, v); }
    }
    __syncthreads();
}
DI float gelu1(float x) { const pg8::f32x2 r = pg8::gelu_pk((pg8::f32x2){x, x}); return r.x; }
struct SmDense {
    const bf16_t* A; int lda; const bf16_t* Bt; int K;
    int mode;
    bf16_t* O; int ldo; const float* bias; float* X; const float* gate;
    DI const bf16_t* arow(int tm, int r) const { return A + (size_t)(TX + 64 * tm + r) * lda; }
    DI const bf16_t* brow(int tm, int tn, int c) const { return Bt + (size_t)(64 * tn + c) * K; }
    DI void store(int tm, int tn, int r, int c8, const float (&v)[8]) const {
        const size_t row = (size_t)TX + 64 * tm + r; const int col = 64 * tn + c8;
        float y[8];
#pragma unroll
        for (int j = 0; j < 8; ++j) y[j] = v[j] + (bias ? bias[col + j] : 0.f);
        if (mode == 2) { float* xp = X + row * 1024 + col;
#pragma unroll
            for (int j = 0; j < 8; ++j) xp[j] += gate[col + j] * y[j]; }
        else { if (mode == 1) {
#pragma unroll
                for (int j = 0; j < 8; ++j) y[j] = gelu1(y[j]); }
            u32x4 w; w.x = pkbf(y[0], y[1]); w.y = pkbf(y[2], y[3]); w.z = pkbf(y[4], y[5]); w.w = pkbf(y[6], y[7]);
            *(u32x4*)(O + row * ldo + col) = w; }
    }
};
struct SmMoeUp {
    const bf16_t* H; const int* seltok; const bf16_t* Wgu; bf16_t* HM;
    DI const bf16_t* arow(int tm, int r) const { int row = seltok[tm * EROWS + 2048 + r]; row = ((unsigned)row < (unsigned)TR) ? row : 0; return H + (size_t)row * 1024; }
    DI const bf16_t* brow(int tm, int tn, int c) const { return Wgu + ((size_t)tm * 4096 + 64 * tn + c) * 1024; }
    DI void store(int tm, int tn, int r, int c8, const float (&v)[8]) const {
        float h[4];
#pragma unroll
        for (int j = 0; j < 4; ++j) h[j] = v[j] * __builtin_amdgcn_rcpf(1.0f + __expf(-v[j])) * v[4 + j];
        u32x2 w; w.x = pkbf(h[0], h[1]); w.y = pkbf(h[2], h[3]);
        *(u32x2*)(HM + ((size_t)tm * EROWS + 2048 + r) * 2048 + (64 * tn + c8) / 2) = w;
    }
};
struct SmMoeDown {
    const bf16_t* HM; const bf16_t* Wdn; bf16_t* Y; const float* g;
    DI const bf16_t* arow(int tm, int r) const { return HM + ((size_t)tm * EROWS + 2048 + r) * 2048; }
    DI const bf16_t* brow(int tm, int tn, int c) const { return Wdn + ((size_t)tm * 1024 + 64 * tn + c) * 2048; }
    DI void store(int tm, int tn, int r, int c8, const float (&v)[8]) const {
        const size_t row = (size_t)tm * EROWS + 2048 + r; const float gs = g[row];
        u32x4 w; w.x = pkbf(v[0] * gs, v[1] * gs); w.y = pkbf(v[2] * gs, v[3] * gs); w.z = pkbf(v[4] * gs, v[5] * gs); w.w = pkbf(v[6] * gs, v[7] * gs);
        *(u32x4*)(Y + row * 1024 + 64 * tn + c8) = w;
    }
};
enum { P_PRO0 = 0, P_A0, P_SG0, P_MOE0 = P_SG0 + 4, P_A1 = P_MOE0 + 4, P_HYIN, P_HYSC, P_HYCONV, P_HYTR, P_HYOUT, P_MOE1, P_A2 = P_MOE1 + 4, P_DAIN, P_DAPREP, P_ATTN, P_DAOUT, P_MOE2,
       P_A3 = P_MOE2 + 4, P_SG3, P_MOE3 = P_SG3 + 4, P_FINAL = P_MOE3 + 4, NPHASE };
template <int LAYER, int PH0, class BarT> DI void moe_block(const Args& a, LAS unsigned char* lds, const BarT& bar, int lo, int hi, int wave, int gw, int NGW) {
    constexpr int MT = 8;
    unsigned char* ws = a.ws;
#ifndef PROBE_MASK
#define PROBE_MASK 0ull
#define PROBE_N 1
#endif
#define PH_REPS(k) (((PROBE_MASK >> (k)) & 1ull) ? PROBE_N : 1)
#ifdef TPROBE_MASK
#define TP_BEGIN(k) if (((TPROBE_MASK >> (k)) & 1ull) && threadIdx.x == 0) { ((volatile LAS unsigned*)(lds + MISC_OFF))[16] = (unsigned)__builtin_amdgcn_s_memrealtime(); }
#define TP_END(k) if (((TPROBE_MASK >> (k)) & 1ull) && threadIdx.x == 0) { volatile LAS unsigned* _tp = (volatile LAS unsigned*)(lds + MISC_OFF); _tp[17] += (unsigned)__builtin_amdgcn_s_memrealtime() - _tp[16]; }
#else
#define TP_BEGIN(k)
#define TP_END(k)
#endif
#define PH_BEGIN(k) if (lo <= (k) && (k) < hi) { TP_BEGIN(k) for (int _rep = 0; _rep < PH_REPS(k); ++_rep) { if (_rep) xcd_barrier(bar); const int lane = lane_id(); const int tid = wave * 64 + lane; (void)tid; (void)lane;
#define PH_END(k) } if ((k) + 1 < hi) xcd_barrier(bar); TP_END(k) }
    PH_BEGIN(PH0 + 0) phase_moe_prep<LAYER>(a, lds, tid, lane, gw, NGW); __syncthreads(); PH_END(PH0 + 0)
    PH_BEGIN(PH0 + 1) phase_topk<LAYER>(a, lds, tid, lane, wave); PH_END(PH0 + 1)
    PH_BEGIN(PH0 + 2) {
        pg8::Gemm g{(const bf16_t*)(ws + WS_H), (const bf16_t*)(ws + WS_WGU) + (size_t)LAYER * 16 * 4096 * 1024, TR, 16 * 4096, 1024, (const int*)(ws + WS_SELTOK)};
        pg8::MoeOrder S{MT, 16, (int)gridDim.x, (int)blockIdx.x}; pg8::EpiSwiGLU E{(bf16_t*)(ws + WS_BUF2)};
        pg8::gemm_phase<pg8::EpiSwiGLU, pg8::MoeOrder, false, true>(lds, g, S, E, nullptr, wave);
        if (LAYER <= 1) { SmMoeUp Es{(const bf16_t*)(ws + WS_H), (const int*)(ws + WS_SELTOK), (const bf16_t*)(ws + WS_WGU) + (size_t)LAYER * 16 * 4096 * 1024, (bf16_t*)(ws + WS_BUF2)};
            small_gemm(lds, tid, lane, wave, 16 * 64, 64, 1024, Es); } } PH_END(PH0 + 2)
    PH_BEGIN(PH0 + 3) {
        pg8::Gemm g{(const bf16_t*)(ws + WS_BUF2), (const bf16_t*)(ws + WS_WDN) + (size_t)LAYER * 16 * 1024 * 2048, 16 * EROWS, 16 * 1024, 2048, nullptr};
        pg8::MoeOrder S{MT, 4, (int)gridDim.x, (int)blockIdx.x}; pg8::EpiDown E{(bf16_t*)(ws + WS_Y), (const float*)(ws + WS_SELG)};
        pg8::gemm_phase<pg8::EpiDown, pg8::MoeOrder, false>(lds, g, S, E, nullptr, wave);
        if (LAYER <= 1) { SmMoeDown Es{(const bf16_t*)(ws + WS_BUF2), (const bf16_t*)(ws + WS_WDN) + (size_t)LAYER * 16 * 1024 * 2048, (bf16_t*)(ws + WS_Y), (const float*)(ws + WS_SELG)};
            small_gemm(lds, tid, lane, wave, 16 * 16, 16, 2048, Es); } } PH_END(PH0 + 3)
}
template <int LAYER, int J, int PH0, class BarT> DI void sg_block(const Args& a, LAS unsigned char* lds, const BarT& bar, int lo, int hi, int wave) {
    constexpr int M = TX, NCHUNK = ((LAYER == 3) ? TX : TR) / 128;
    unsigned char* ws = a.ws;
    PH_BEGIN(PH0 + 0) {
        pg8::Gemm g{(const bf16_t*)(ws + WS_H), (const bf16_t*)(ws + WS_WSGIN) + (size_t)J * 4096 * 1024, M, 4096, 1024, nullptr};
        pg8::StaticOrder S; S.init(M, 4096, (int)gridDim.x, (int)blockIdx.x);
        pg8::EpiBf16<1> E{(bf16_t*)(ws + WS_BUF1), 4096, a.in[I_SGBIN] + J * 4096, 0, 0, (float*)(ws + WS_VSQ), 2048};
        pg8::gemm_phase<pg8::EpiBf16<1>, pg8::StaticOrder, false>(lds, g, S, E, nullptr, wave);
        if (LAYER == 0) { SmDense Es{(const bf16_t*)(ws + WS_H), 1024, (const bf16_t*)(ws + WS_WSGIN) + (size_t)J * 4096 * 1024, 1024, 1, (bf16_t*)(ws + WS_BUF1), 4096, a.in[I_SGBIN] + J * 4096, nullptr, nullptr};
            small_gemm(lds, tid, lane, wave, 8 * 64, 64, 1024, Es); } } PH_END(PH0 + 0)
    PH_BEGIN(PH0 + 1) phase_sg_vnt<J, NCHUNK>(a, lds, tid, lane, wave); PH_END(PH0 + 1)
    PH_BEGIN(PH0 + 2) {
        pg8::Gemm g{(const bf16_t*)(ws + WS_WSBD) + (size_t)J * 4 * 256 * 256, (const bf16_t*)(ws + WS_BUF2), 1024, NCHUNK * 4 * 256, 256, nullptr};
        pg8::SpatOrder S{NCHUNK * 4, (int)gridDim.x, (int)blockIdx.x};
        pg8::EpiSpat E{(bf16_t*)(ws + WS_BUF3), (const bf16_t*)(ws + WS_BUF1), a.in[I_SGBS] + J * 8 * 128};
        pg8::gemm_phase<pg8::EpiSpat, pg8::SpatOrder, false>(lds, g, S, E, nullptr, wave); } PH_END(PH0 + 2)
    PH_BEGIN(PH0 + 3) {
        pg8::Gemm g{(const bf16_t*)(ws + WS_BUF3), (const bf16_t*)(ws + WS_WSGOUT) + (size_t)J * 1024 * 2048, M, 1024, 2048, nullptr};
        pg8::StaticOrder S; S.init(M, 1024, (int)gridDim.x, (int)blockIdx.x);
        pg8::EpiRes E{(float*)(ws + WS_X), a.in[I_SGBOUT] + J * 1024, modp(a, LAYER, 0, 2)};
        pg8::gemm_phase<pg8::EpiRes, pg8::StaticOrder, false>(lds, g, S, E, nullptr, wave);
        if (LAYER == 0) { SmDense Es{(const bf16_t*)(ws + WS_BUF3), 2048, (const bf16_t*)(ws + WS_WSGOUT) + (size_t)J * 1024 * 2048, 2048, 2, nullptr, 0, a.in[I_SGBOUT] + J * 1024, (float*)(ws + WS_X), modp(a, LAYER, 2, 2)};
            small_gemm(lds, tid, lane, wave, 8 * 16, 16, 2048, Es); } } PH_END(PH0 + 3)
}

__global__ void __launch_bounds__(NTHR, 2) mk_fwd(Args a) {
    extern __shared__ __attribute__((aligned(16))) unsigned char lds_raw[];
    LAS unsigned char* lds = (LAS unsigned char*)lds_raw;
    const int wave = __builtin_amdgcn_readfirstlane((int)threadIdx.x >> 6);
    const int G = gridDim.x, gw = blockIdx.x * NWAVES + wave, NGW = G * NWAVES;
    volatile LAS unsigned* MISC = (volatile LAS unsigned*)(lds + MISC_OFF);
    if (threadIdx.x < 32) MISC[threadIdx.x] = 0u;
    __syncthreads();
    unsigned char* ws = a.ws;
    XcdBarrier bar = xcd_barrier_post((unsigned*)(ws + WS_CTL) + CW_BAR, MISC + 8);
    const int lo = a.ph_lo, hi = a.ph_hi;

    PH_BEGIN(P_PRO0)
        pro0_mod(a, lds, tid, lane, wave);
        pro0_small(a, blockIdx.x * NTHR + tid, G * NTHR);
        pro0_filter1(a, lane, gw, NGW);
        __syncthreads();
    PH_END(P_PRO0)
#ifndef TPROBE_SUB
#define TPROBE_SUB 0
#endif
#define TPS_BEGIN(n) if (TPROBE_SUB == (n)) { __syncthreads(); if (threadIdx.x == 0) MISC[16] = (unsigned)__builtin_amdgcn_s_memrealtime(); }
#define TPS_END(n) if (TPROBE_SUB == (n)) { asm volatile("s_waitcnt vmcnt(0)" ::: "memory"); __syncthreads(); if (threadIdx.x == 0) MISC[17] += (unsigned)__builtin_amdgcn_s_memrealtime() - MISC[16]; }
    PH_BEGIN(P_A0)
        TPS_BEGIN(1) phase_A<0>(a, lane, gw, NGW); TPS_END(1)
        TPS_BEGIN(2) pro1_filter2(a, lds, lane, gw, NGW); TPS_END(2)
        TPS_BEGIN(3) cvt_range(a, lds, tid, 0, CVT_T_MOE1);
        __syncthreads(); TPS_END(3)
    PH_END(P_A0)
    sg_block<0, 0, P_SG0>(a, lds, bar, lo, hi, wave);
    moe_block<0, P_MOE0>(a, lds, bar, lo, hi, wave, gw, NGW);
    PH_BEGIN(P_A1) phase_A<1>(a, lane, gw, NGW); PH_END(P_A1)
    PH_BEGIN(P_HYIN) {
        pg8::Gemm g{(const bf16_t*)(ws + WS_H), (const bf16_t*)(ws + WS_WHYIN), TX, 3072, 1024, nullptr};
        pg8::StaticOrder S; S.init(TX, 3072, G, (int)blockIdx.x);
        pg8::EpiBf16<0> E{(bf16_t*)(ws + WS_BUF1), 3072, a.in[I_HYBIN], 0, 0};
        pg8::gemm_phase<pg8::EpiBf16<0>, pg8::StaticOrder, false>(lds, g, S, E, nullptr, wave);
        SmDense Es{(const bf16_t*)(ws + WS_H), 1024, (const bf16_t*)(ws + WS_WHYIN), 1024, 0, (bf16_t*)(ws + WS_BUF1), 3072, a.in[I_HYBIN], nullptr, nullptr};
        small_gemm(lds, tid, lane, wave, 8 * 48, 48, 1024, Es); } PH_END(P_HYIN)
    PH_BEGIN(P_HYSC) phase_hy_shortconv(a, lds, tid); PH_END(P_HYSC)
    PH_BEGIN(P_HYCONV) phase_hy_conv(a, lds, tid, lane, wave, gw, NGW); __syncthreads(); PH_END(P_HYCONV)
    PH_BEGIN(P_HYTR) phase_hy_transpose(a, lds, lane, wave, gw, NGW); __syncthreads(); PH_END(P_HYTR)
    PH_BEGIN(P_HYOUT) {
        pg8::Gemm g{(const bf16_t*)(ws + WS_H), (const bf16_t*)(ws + WS_WHYOUT), TX, 1024, 1024, nullptr};
        pg8::StaticOrder S; S.init(TX, 1024, G, (int)blockIdx.x);
        pg8::EpiRes E{(float*)(ws + WS_X), a.in[I_HYBOUT], modp(a, 1, 0, 2)};
        pg8::gemm_phase<pg8::EpiRes, pg8::StaticOrder, false>(lds, g, S, E, nullptr, wave);
        SmDense Es{(const bf16_t*)(ws + WS_H), 1024, (const bf16_t*)(ws + WS_WHYOUT), 1024, 2, nullptr, 0, a.in[I_HYBOUT], (float*)(ws + WS_X), modp(a, 1, 2, 2)};
        small_gemm(lds, tid, lane, wave, 8 * 16, 16, 1024, Es); } PH_END(P_HYOUT)
    moe_block<1, P_MOE1>(a, lds, bar, lo, hi, wave, gw, NGW);
    PH_BEGIN(P_A2) phase_A<2>(a, lane, gw, NGW); PH_END(P_A2)
    PH_BEGIN(P_DAIN) {
        pg8::Gemm g{(const bf16_t*)(ws + WS_H), (const bf16_t*)(ws + WS_WDAIN), TX, 3072, 1024, nullptr};
        pg8::StaticOrder S; S.init(TX, 3072, G, (int)blockIdx.x);
        pg8::EpiBf16<0> E{(bf16_t*)(ws + WS_BUF1), 3072, nullptr, 0, 0};
        pg8::gemm_phase<pg8::EpiBf16<0>, pg8::StaticOrder, false>(lds, g, S, E, nullptr, wave);
        SmDense Es{(const bf16_t*)(ws + WS_H), 1024, (const bf16_t*)(ws + WS_WDAIN), 1024, 0, (bf16_t*)(ws + WS_BUF1), 3072, nullptr, nullptr, nullptr};
        small_gemm(lds, tid, lane, wave, 8 * 48, 48, 1024, Es); } PH_END(P_DAIN)
    PH_BEGIN(P_DAPREP) phase_da_prep(a, lds, tid); PH_END(P_DAPREP)
    PH_BEGIN(P_ATTN) phase_attn(a, lds, tid, lane, wave); __syncthreads(); PH_END(P_ATTN)
    PH_BEGIN(P_DAOUT) {
        pg8::Gemm g{(const bf16_t*)(ws + WS_BUF3), (const bf16_t*)(ws + WS_WDAOUT), TX, 1024, 1024, nullptr};
        pg8::StaticOrder S; S.init(TX, 1024, G, (int)blockIdx.x);
        pg8::EpiRes E{(float*)(ws + WS_X), nullptr, modp(a, 2, 0, 2)};
        pg8::gemm_phase<pg8::EpiRes, pg8::StaticOrder, false>(lds, g, S, E, nullptr, wave); } PH_END(P_DAOUT)
    moe_block<2, P_MOE2>(a, lds, bar, lo, hi, wave, gw, NGW);
    PH_BEGIN(P_A3) phase_A<3>(a, lane, gw, NGW); PH_END(P_A3)
    sg_block<3, 1, P_SG3>(a, lds, bar, lo, hi, wave);
    moe_block<3, P_MOE3>(a, lds, bar, lo, hi, wave, gw, NGW);
    PH_BEGIN(P_FINAL) phase_A<4>(a, lane, gw, NGW); PH_END(P_FINAL)
#ifdef TPROBE_MASK
    __syncthreads();
    if (threadIdx.x == 0) { const unsigned long long w = (unsigned long long)MISC[17] * TPROBE_MULT, t0 = __builtin_amdgcn_s_memrealtime(); while (__builtin_amdgcn_s_memrealtime() - t0 < w) __builtin_amdgcn_s_sleep(20); }
#endif
}

extern "C" void kernel_launch(void* const* d_in, const int* in_sizes, int n_in, void* d_out, int out_size, void* d_ws, size_t ws_size, hipStream_t stream) {
    static int grid = 0;
    if (grid == 0) {
        if (n_in != N_IN || out_size != TX * D || ws_size < WS_END) { fprintf(stderr, "kernel_launch: unexpected problem (n_in %d, out %d, ws %zu < %zu)\n", n_in, out_size, ws_size, (size_t)WS_END); grid = -1; return; }
        int dev = 0, cus = 0, per_cu = 0;
        if (hipGetDevice(&dev) != hipSuccess || hipDeviceGetAttribute(&cus, hipDeviceAttributeMultiprocessorCount, dev) != hipSuccess) { grid = -1; return; }
        if (hipFuncSetAttribute((const void*)mk_fwd, hipFuncAttributeMaxDynamicSharedMemorySize, LDS_BYTES) != hipSuccess) { fprintf(stderr, "kernel_launch: hipFuncSetAttribute failed\n"); grid = -1; return; }
        if (hipOccupancyMaxActiveBlocksPerMultiprocessor(&per_cu, (const void*)mk_fwd, NTHR, LDS_BYTES) != hipSuccess || per_cu < 1)
            fprintf(stderr, "kernel_launch: occupancy query reports %d workgroups per CU\n", per_cu);
        (void)hipGetLastError();
        grid = cus;
    }
    if (grid < 0) return;
    if (hipMemsetAsync((char*)d_ws + WS_CTL, 0, CTL_ZERO_BYTES, stream) != hipSuccess) return;
    Args a{};
    for (int i = 0; i < N_IN; ++i) a.in[i] = (const float*)d_in[i];
    a.out = (float*)d_out; a.ws = (unsigned char*)d_ws;
#if MK_LAUNCHES == 1
    a.ph_lo = 0; a.ph_hi = NPHASE;
    hipLaunchKernelGGL(mk_fwd, dim3(grid), dim3(NTHR), LDS_BYTES, stream, a);
#else
    for (int p = 0; p < NPHASE; ++p) { a.ph_lo = p; a.ph_hi = p + 1; hipLaunchKernelGGL(mk_fwd, dim3(grid), dim3(NTHR), LDS_BYTES, stream, a); }
#endif
}
```

```cpp
#include <hip/hip_runtime.h>
#include <stdint.h>
#include <stdio.h>
#include <math.h>

#ifndef MK_LAUNCHES
#define MK_LAUNCHES 1
#endif

#define GAS __attribute__((address_space(1)))
#define LAS __attribute__((address_space(3)))
typedef unsigned short bf16_t;
typedef float f32x4 __attribute__((ext_vector_type(4)));
typedef float f32x2 __attribute__((ext_vector_type(2)));
typedef float f32x16 __attribute__((ext_vector_type(16)));
typedef unsigned u32x4 __attribute__((ext_vector_type(4)));
typedef unsigned u32x2 __attribute__((ext_vector_type(2)));
typedef short bf16x8 __attribute__((ext_vector_type(8)));
#define DI __device__ __forceinline__

DI unsigned pkbf(float lo, float hi) { unsigned r; asm volatile("v_cvt_pk_bf16_f32 %0, %1, %2" : "=v"(r) : "v"(lo), "v"(hi)); return r; }
DI float bflo(unsigned w) { return __uint_as_float(w << 16); }
DI float bfhi(unsigned w) { return __uint_as_float(w & 0xffff0000u); }
DI float bf1(bf16_t h) { return __uint_as_float(((unsigned)h) << 16); }
DI bf16_t f2bf1(float f) { return (bf16_t)(pkbf(f, 0.f) & 0xffffu); }
template <int CTRL> DI float dppf(float v) { return __builtin_bit_cast(float, __builtin_amdgcn_update_dpp(0, __builtin_bit_cast(int, v), CTRL, 0xf, 0xf, true)); }
#define DPP_XOR1 0xB1
#define DPP_XOR2 0x4E
#define DPP_ROR(n) (0x120 + (n))
DI float row_sum16(float v) { v += dppf<DPP_ROR(8)>(v); v += dppf<DPP_ROR(4)>(v); v += dppf<DPP_ROR(2)>(v); v += dppf<DPP_ROR(1)>(v); return v; }
DI float row_max16(float v) { v = fmaxf(v, dppf<DPP_ROR(8)>(v)); v = fmaxf(v, dppf<DPP_ROR(4)>(v)); v = fmaxf(v, dppf<DPP_ROR(2)>(v)); v = fmaxf(v, dppf<DPP_ROR(1)>(v)); return v; }
DI float rlane(float v, int l) { return __builtin_bit_cast(float, __builtin_amdgcn_readlane(__builtin_bit_cast(int, v), l)); }
DI float wave_sum(float v) { v = row_sum16(v); return (rlane(v, 0) + rlane(v, 16)) + (rlane(v, 32) + rlane(v, 48)); }
DI float wave_max(float v) { v = row_max16(v); return fmaxf(fmaxf(rlane(v, 0), rlane(v, 16)), fmaxf(rlane(v, 32), rlane(v, 48))); }
DI int lane_id() { int l; asm volatile("v_mbcnt_lo_u32_b32 %0, -1, 0\n\tv_mbcnt_hi_u32_b32 %0, -1, %0" : "=v"(l)); return l; }
#define MFMA32(a, b, c) __builtin_amdgcn_mfma_f32_32x32x16_bf16((a), (b), (c), 0, 0, 0)
#define LDS_WAIT() asm volatile("s_waitcnt lgkmcnt(0)" ::: "memory")
#define VM_WAIT() asm volatile("s_waitcnt vmcnt(0)" ::: "memory")

#define XB_TMO      128
#define XB_XCNT(j)  (256  + 64 * (j))
#define XB_XSUB(j)  (1280 + 64 * (j))
#define XB_XGEN(j)  (2304 + 64 * (j))
#define XB_TOP      3328
#define XB_TOPGEN   3392
#define XCD_BAR_WORDS 3456
#define XB_SPIN_CAP (1u << 18)
__device__ __forceinline__ unsigned xb_ld(unsigned* p)              { return __hip_atomic_load(p, __ATOMIC_RELAXED, __HIP_MEMORY_SCOPE_AGENT); }
__device__ __forceinline__ unsigned xb_add(unsigned* p, unsigned v) { return __hip_atomic_fetch_add(p, v, __ATOMIC_RELAXED, __HIP_MEMORY_SCOPE_AGENT); }
__device__ __forceinline__ unsigned xb_xcc_id() { return (unsigned)__builtin_amdgcn_s_getreg((3 << 11) | 20) & 0xFu; }
#define XB_SPIN(cond, bar) do { unsigned _sp = 0; while (cond) { __builtin_amdgcn_s_sleep(1); \
    if ((++_sp & 255u) == 0u) { if (xb_ld(&(bar)[XB_TMO])) break; if (_sp > XB_SPIN_CAP) { atomicAdd(&(bar)[XB_TMO], 1u); break; } } } } while (0)
struct XcdBarrier { unsigned* bar; unsigned x; volatile LAS unsigned* st; };
__device__ __forceinline__ XcdBarrier xcd_barrier_post(unsigned* bar, volatile LAS unsigned* st) {
    XcdBarrier b; b.bar = bar; b.x = xb_xcc_id(); b.st = st;
    if (threadIdx.x == 0) (void)xb_add(&bar[XB_XCNT(b.x)], 1u);
    return b;
}
__device__ __forceinline__ void xcd_barrier_complete(unsigned* bar, unsigned x, unsigned& nloc, unsigned& nx) {
    const unsigned G = gridDim.x * gridDim.y * gridDim.z;
    unsigned sum, cnt, mine, sp = 0u;
    for (;;) {
        sum = 0u; cnt = 0u; mine = 0u;
#pragma unroll
        for (unsigned j = 0; j < 16; ++j) { const unsigned c = xb_ld(&bar[XB_XCNT(j)]); sum += c; cnt += (c > 0u) ? 1u : 0u; mine = (j == x) ? c : mine; }
        if (sum == G) break;
        __builtin_amdgcn_s_sleep(1);
        if ((++sp & 255u) == 0u) { if (xb_ld(&bar[XB_TMO])) break; if (sp > XB_SPIN_CAP) { atomicAdd(&bar[XB_TMO], 1u); break; } }
    }
    nloc = mine > 0u ? mine : 1u; nx = cnt > 0u ? cnt : 1u;
}
__device__ __forceinline__ void xcd_barrier(const XcdBarrier& b) {
    asm volatile("s_waitcnt vmcnt(0)" ::: "memory");
    __syncthreads();
    if (threadIdx.x == 0) {
        unsigned* bar = b.bar;
        __builtin_amdgcn_s_waitcnt(0);
        unsigned nloc = b.st[0], nx = b.st[1];
        if (nloc == 0u) { xcd_barrier_complete(bar, b.x, nloc, nx); b.st[0] = nloc; b.st[1] = nx; }
        const unsigned old = xb_add(&bar[XB_XSUB(b.x)], 1u);
        const unsigned gen = old / nloc;
        if (old + 1u == (gen + 1u) * nloc) {
            __builtin_amdgcn_fence(__ATOMIC_RELEASE, "agent");
            asm volatile("s_waitcnt vmcnt(0)" ::: "memory");
            const unsigned og = xb_add(&bar[XB_TOP], 1u);
            const unsigned tg = og / nx;
            if (og + 1u == (tg + 1u) * nx) xb_add(&bar[XB_TOPGEN], 1u);
            else XB_SPIN(xb_ld(&bar[XB_TOPGEN]) == tg, bar);
            __builtin_amdgcn_fence(__ATOMIC_ACQUIRE, "agent");
            xb_add(&bar[XB_XGEN(b.x)], 1u);
            asm volatile("s_waitcnt vmcnt(0)" ::: "memory");
        } else {
            XB_SPIN(xb_ld(&bar[XB_XGEN(b.x)]) == gen, bar);
            __builtin_amdgcn_fence(__ATOMIC_ACQUIRE, "agent");
            asm volatile("s_waitcnt vmcnt(0)" ::: "memory");
        }
    }
    __syncthreads();
}
namespace pg8 {
#define PG8_LAS __attribute__((address_space(3)))
typedef unsigned short bf16_t;
typedef short bf16x8 __attribute__((ext_vector_type(8)));
typedef float f32x4 __attribute__((ext_vector_type(4)));
typedef unsigned u32x4 __attribute__((ext_vector_type(4)));
constexpr int BM = 256, BK = 64, HALF = 128, HTB = HALF * BK * 2  , STAGE_BYTES = 8 * HTB, NXCD = 8, WGM = 8;

__host__ __device__ __forceinline__ int lds_byte(int r, int c) { const int st = (r >> 4) * 2 + (c >> 5), rr = r & 15, cc = c & 31, ob = rr * 64 + cc * 2; return st * 1024 + (ob ^ (((ob >> 9) & 1) << 5)); }
__host__ __device__ __forceinline__ void stage_rc(int b, int& R, int& C) { const int st = b / 1024, sb = b % 1024, swz = sb ^ (((sb >> 9) & 1) << 5); R = (st >> 1) * 16 + swz / 64; C = (st & 1) * 32 + (swz % 64) / 2; }
__host__ __device__ __forceinline__ int perm32(int rho) { const int n = rho >> 4, i = rho & 15; return 8 * (i >> 2) + 4 * n + (i & 3); }

struct Unit { int pm, pn; };
struct Gemm { const bf16_t* A; const bf16_t* Bt; int M, N, K; const int* aidx; };

struct StaticOrder {
    int nM, nN, nwg, G, c;
    __host__ __device__ void init(int M, int N, int G_, int c_) { nM = M / BM; nN = N / BM; nwg = nM * nN; G = G_; c = c_; }
    __host__ __device__ bool next(int i, Unit& u) const {
        const long L = (long)i * G + c; if (L >= nwg) return false;
        int wgid = (int)L; { const int q = nwg / NXCD, r = nwg % NXCD, xcd = wgid % NXCD, off = wgid / NXCD; wgid = (xcd < r ? xcd * (q + 1) : r * (q + 1) + (xcd - r) * q) + off; }
        const int nig = WGM * nN, gid = wgid / nig, fm = gid * WGM, gsz = (nM - fm) < WGM ? (nM - fm) : WGM;
        u.pm = fm + ((wgid % nig) % gsz); u.pn = (wgid % nig) / gsz; return true;
    }
    __device__ __forceinline__ void a_ready(const Unit&) const {}
    __device__ __forceinline__ void done(const Unit&) const {}
};
struct CountedOrder : StaticOrder {
    const unsigned* ready; unsigned need; unsigned* tmo;
    __device__ __forceinline__ void a_ready(const Unit& u) const {
        if (threadIdx.x < 64) {
            const unsigned long long t0 = __builtin_amdgcn_s_memrealtime(); unsigned polls = 0;
            while ((unsigned)__builtin_amdgcn_readfirstlane(__hip_atomic_load(ready + 64 * u.pm, __ATOMIC_RELAXED, __HIP_MEMORY_SCOPE_AGENT)) < need) {
                if ((++polls & 255u) == 0u && __builtin_amdgcn_readfirstlane(__hip_atomic_load(tmo, __ATOMIC_RELAXED, __HIP_MEMORY_SCOPE_AGENT)) != 0u) break;
                if (__builtin_amdgcn_s_memrealtime() - t0 > 2000000ull) {
                    if (threadIdx.x == 0) { unsigned expect = 0u; __hip_atomic_compare_exchange_strong(tmo + 1, &expect, 0x600u | (unsigned)(u.pm & 0xff), __ATOMIC_RELAXED, __ATOMIC_RELAXED, __HIP_MEMORY_SCOPE_AGENT); __hip_atomic_store(tmo, 1u, __ATOMIC_RELAXED, __HIP_MEMORY_SCOPE_AGENT); }
                    break; }
                __builtin_amdgcn_s_sleep(2); }
            __builtin_amdgcn_fence(__ATOMIC_ACQUIRE, "agent");
            asm volatile("s_waitcnt vmcnt(0)" ::: "memory");
        }
#if !defined(BROKEN_HOOK_NO_BARRIER)
        asm volatile("" ::: "memory"); __builtin_amdgcn_s_barrier(); asm volatile("" ::: "memory");
#endif
    }
};

__device__ __forceinline__ unsigned cvt_pk_bf16(float lo, float hi) { unsigned r; asm volatile("v_cvt_pk_bf16_f32 %0, %1, %2" : "=v"(r) : "v"(lo), "v"(hi)); return r; }
typedef float f32x2 __attribute__((ext_vector_type(2)));
__device__ __forceinline__ f32x2 gelu_pk(f32x2 v) {
    const f32x2 av = __builtin_elementwise_abs(v), d = av * 0.2316418882f + 1.0f;
    f32x2 t; t.x = __builtin_amdgcn_rcpf(d.x); t.y = __builtin_amdgcn_rcpf(d.y);
    f32x2 q = t * 0.5307027145f + (-0.7265760135f); q = q * t + 0.7107068705f; q = q * t + (-0.142248368f); q = q * t + 0.127414796f; q = q * t;
    const f32x2 s = (v * v) * (-0.72134752044f);
    f32x2 e; e.x = __builtin_amdgcn_exp2f(s.x); e.y = __builtin_amdgcn_exp2f(s.y);
    const f32x2 m = v * (q * e), r = v - m;
    f32x2 o; o.x = v.x < 0.f ? m.x : r.x; o.y = v.y < 0.f ? m.y : r.y; return o;
}

struct EpiF32 {
    static constexpr bool PERM = false, AFTER_DRAIN = false;
    float* C; int ldc; const float* bias;
    __device__ __forceinline__ void operator()(const f32x4 (&acc)[2][2][4][2], const Unit& u, int wr, int wc, int fr, int fq) const {
        const int row0 = u.pm * BM + wr * 64 + fr, col0 = u.pn * BM + wc * 32 + 4 * fq;
        f32x4 bv[2][2];
#pragma unroll
        for (int bj = 0; bj < 2; ++bj)
#pragma unroll
            for (int n = 0; n < 2; ++n) bv[bj][n] = bias ? *(const f32x4*)(bias + col0 + bj * HALF + n * 16) : (f32x4){0.f, 0.f, 0.f, 0.f};
#pragma unroll
        for (int ai = 0; ai < 2; ++ai)
#pragma unroll
            for (int m = 0; m < 4; ++m) { float* rowp = C + (size_t)(row0 + ai * HALF + m * 16) * ldc + col0;
#pragma unroll
                for (int bj = 0; bj < 2; ++bj)
#pragma unroll
                    for (int n = 0; n < 2; ++n) *(f32x4*)(rowp + bj * HALF + n * 16) = acc[ai][bj][m][n] + bv[bj][n]; }
    }
};
template <int ACT  > struct EpiBf16 {
    static constexpr bool PERM = true, AFTER_DRAIN = false;
    bf16_t* O; int ldc; const float* bias; int split_cols; size_t split_stride;
    float* vsq; int vsq_col0;
    __device__ __forceinline__ void operator()(const f32x4 (&acc)[2][2][4][2], const Unit& u, int wr, int wc, int fr, int fq) const {
        const int row0 = u.pm * BM + wr * 64 + fr; int colt = u.pn * BM; bf16_t* base = O;
        if (split_cols) { const int t = colt / split_cols; base += (size_t)t * split_stride; colt -= t * split_cols; }
        const int col0 = colt + wc * 32 + 8 * fq, bcol0 = u.pn * BM + wc * 32 + 8 * fq;
        f32x4 bv[2][2];
#pragma unroll
        for (int bj = 0; bj < 2; ++bj)
#pragma unroll
            for (int n = 0; n < 2; ++n) bv[bj][n] = bias ? *(const f32x4*)(bias + bcol0 + bj * HALF + 4 * n) : (f32x4){0.f, 0.f, 0.f, 0.f};
        const bool dosq = vsq != nullptr && u.pn * BM >= vsq_col0;
#pragma unroll
        for (int ai = 0; ai < 2; ++ai)
#pragma unroll
            for (int m = 0; m < 4; ++m) { bf16_t* rowp = base + (size_t)(row0 + ai * HALF + m * 16) * ldc + col0; float ss = 0.f;
#pragma unroll
                for (int bj = 0; bj < 2; ++bj) { f32x4 v0 = acc[ai][bj][m][0] + bv[bj][0], v1 = acc[ai][bj][m][1] + bv[bj][1];
                    if (ACT == 1) { f32x2 a = gelu_pk((f32x2){v0[0], v0[1]}), b = gelu_pk((f32x2){v0[2], v0[3]}), c = gelu_pk((f32x2){v1[0], v1[1]}), d = gelu_pk((f32x2){v1[2], v1[3]});
                        v0 = (f32x4){a.x, a.y, b.x, b.y}; v1 = (f32x4){c.x, c.y, d.x, d.y}; }
                    if (ACT == 2) {
#pragma unroll
                        for (int j = 0; j < 4; ++j) { v0[j] = 0.5f * v0[j] * (1.0f + erff(v0[j] * 0.70710678f)); v1[j] = 0.5f * v1[j] * (1.0f + erff(v1[j] * 0.70710678f)); } }
                    ss += ((v0[0] * v0[0] + v0[1] * v0[1]) + (v0[2] * v0[2] + v0[3] * v0[3])) + ((v1[0] * v1[0] + v1[1] * v1[1]) + (v1[2] * v1[2] + v1[3] * v1[3]));
                    u32x4 w; w.x = cvt_pk_bf16(v0[0], v0[1]); w.y = cvt_pk_bf16(v0[2], v0[3]); w.z = cvt_pk_bf16(v1[0], v1[1]); w.w = cvt_pk_bf16(v1[2], v1[3]);
                    *(u32x4*)(rowp + bj * HALF) = w; }
                if (dosq) { ss += __shfl_xor(ss, 16); ss += __shfl_xor(ss, 32);
                    if (fq == 0) vsq[(size_t)(row0 + ai * HALF + m * 16) * 32 + ((u.pn * BM - vsq_col0) >> 8) * 4 + wc] = ss; } }
    }
};

struct PanelStats {
    unsigned* xbuf;
    unsigned* cnt;
    unsigned* tmo;
    int ntn; float eps;
    unsigned code;
    __device__ __forceinline__ bool run(const f32x4 (&v)[2][2][4][2], const Unit& u, int wr, int wc, int fr, int fq, PG8_LAS unsigned char* lds, int wid, int lane) const {
        typedef float f32x2v __attribute__((ext_vector_type(2)));
        PG8_LAS f32x2v* P = (PG8_LAS f32x2v*)lds;
        PG8_LAS f32x2v* S = (PG8_LAS f32x2v*)(lds + 8192);
        PG8_LAS unsigned* flag = (PG8_LAS unsigned*)(lds + 8192 + 2048);
#pragma unroll
        for (int ai = 0; ai < 2; ++ai)
#pragma unroll
            for (int m = 0; m < 4; ++m) {
                float s = 0.f;
#pragma unroll
                for (int bj = 0; bj < 2; ++bj)
#pragma unroll
                    for (int n = 0; n < 2; ++n) { const f32x4 x = v[ai][bj][m][n]; s += (x[0] + x[1]) + (x[2] + x[3]); }
                s += __shfl_xor(s, 16); s += __shfl_xor(s, 32);
                const float mw = s * (1.0f / 64.0f); float q = 0.f;
#pragma unroll
                for (int bj = 0; bj < 2; ++bj)
#pragma unroll
                    for (int n = 0; n < 2; ++n) { const f32x4 d = v[ai][bj][m][n] - mw; q += (d[0] * d[0] + d[1] * d[1]) + (d[2] * d[2] + d[3] * d[3]); }
                q += __shfl_xor(q, 16); q += __shfl_xor(q, 32);
                if (fq == 0) P[(ai * HALF + wr * 64 + m * 16 + fr) * 4 + wc] = (f32x2v){mw, q};
            }
        asm volatile("s_waitcnt lgkmcnt(0)" ::: "memory"); __builtin_amdgcn_s_barrier(); asm volatile("" ::: "memory");
#if defined(BROKEN_NO_WAIT)
        if (blockIdx.x >= 64) { const long long t0 = clock64(); while (clock64() - t0 < 60000) __builtin_amdgcn_s_sleep(8); }
#endif
        const int row = wid * 32 + (lane & 31);
        if (lane < 32) {
            const f32x2v a = P[row * 4 + 0], b = P[row * 4 + 1], c = P[row * 4 + 2], d = P[row * 4 + 3];
            const float mt = (a.x + b.x + c.x + d.x) * 0.25f;
            const float da = a.x - mt, db = b.x - mt, dc = c.x - mt, dd = d.x - mt;
            const float m2 = (a.y + b.y) + (c.y + d.y) + 64.0f * ((da * da + db * db) + (dc * dc + dd * dd));
            unsigned long long* slot = (unsigned long long*)xbuf + ((size_t)(u.pm * BM + row) * 4 + u.pn);
            __hip_atomic_store(slot, ((unsigned long long)__float_as_uint(m2) << 32) | __float_as_uint(mt), __ATOMIC_RELAXED, __HIP_MEMORY_SCOPE_AGENT);
        }
        asm volatile("s_waitcnt vmcnt(0)" ::: "memory");
        if (lane == 0) __hip_atomic_fetch_add(cnt + 64 * u.pm, 1u, __ATOMIC_RELAXED, __HIP_MEMORY_SCOPE_AGENT);
        if (wid == 0) {
            bool dead = false; const unsigned long long t0 = __builtin_amdgcn_s_memrealtime(); const unsigned want = 8u * (unsigned)ntn;
            for (;;) {
#if defined(BROKEN_NO_WAIT)
                break;
#endif
                if ((unsigned)__builtin_amdgcn_readfirstlane(__hip_atomic_load(cnt + 64 * u.pm, __ATOMIC_RELAXED, __HIP_MEMORY_SCOPE_AGENT)) >= want) break;
                if (__builtin_amdgcn_s_memrealtime() - t0 > 2000000ull) {
                    if (lane == 0) { unsigned expect = 0u; __hip_atomic_compare_exchange_strong(tmo + 1, &expect, code | (unsigned)(u.pm & 0xff), __ATOMIC_RELAXED, __ATOMIC_RELAXED, __HIP_MEMORY_SCOPE_AGENT);
                                     __hip_atomic_store(tmo, 1u, __ATOMIC_RELAXED, __HIP_MEMORY_SCOPE_AGENT); }
                    dead = true; break; }
                __builtin_amdgcn_s_sleep(2);
            }
            __builtin_amdgcn_fence(__ATOMIC_ACQUIRE, "agent");
            if (lane == 0) flag[0] = dead ? 1u : 0u;
        }
        asm volatile("s_waitcnt vmcnt(0) lgkmcnt(0)" ::: "memory"); __builtin_amdgcn_s_barrier(); asm volatile("" ::: "memory");
        const bool bad = flag[0] != 0u;
        if (lane < 32) {
            const unsigned long long* slot = (const unsigned long long*)xbuf + (size_t)(u.pm * BM + row) * 4; float mt[4], m2[4]; float ms = 0.f;
#pragma unroll
            for (int t = 0; t < 4; ++t) { if (t < ntn) { const unsigned long long w = __hip_atomic_load(slot + t, __ATOMIC_RELAXED, __HIP_MEMORY_SCOPE_AGENT); mt[t] = __uint_as_float((unsigned)w); m2[t] = __uint_as_float((unsigned)(w >> 32)); } else { mt[t] = 0.f; m2[t] = 0.f; } ms += mt[t]; }
            const float mean = ms / (float)ntn; float q = 0.f;
#pragma unroll
            for (int t = 0; t < 4; ++t) if (t < ntn) { const float dm = mt[t] - mean; q += m2[t] + 256.0f * dm * dm; }
            S[row] = (f32x2v){mean, 1.0f / sqrtf(q / (256.0f * (float)ntn) + eps)};
        }
        asm volatile("s_waitcnt lgkmcnt(0)" ::: "memory"); __builtin_amdgcn_s_barrier(); asm volatile("" ::: "memory");
        return bad;
    }
};
struct EpiLnRes {
    static constexpr bool PERM = false, AFTER_DRAIN = true;
    const float* base; float* out; int ldc; const float* bias; PanelStats st; unsigned poison;
    __device__ __forceinline__ void refuse(size_t i0, size_t stride, int M, int N) const { const float q = __builtin_nanf(""); for (size_t i = i0; i < (size_t)M * N; i += stride) out[(i / N) * ldc + i % N] = q;
        if (i0 == 0) { unsigned expect = 0u; __hip_atomic_compare_exchange_strong(st.tmo + 1, &expect, 0x7f0u, __ATOMIC_RELAXED, __ATOMIC_RELAXED, __HIP_MEMORY_SCOPE_AGENT); __hip_atomic_store(st.tmo, 1u, __ATOMIC_RELAXED, __HIP_MEMORY_SCOPE_AGENT); } }
    __device__ __forceinline__ void fused(f32x4 (&acc)[2][2][4][2], const Unit& u, int wr, int wc, int fr, int fq, PG8_LAS unsigned char* lds, int wid, int lane) const {
        typedef float f32x2v __attribute__((ext_vector_type(2)));
        const PG8_LAS f32x2v* S = (const PG8_LAS f32x2v*)(lds + 8192);
        const int col0 = u.pn * BM + wc * 32 + 4 * fq;
#pragma unroll
        for (int bj = 0; bj < 2; ++bj)
#pragma unroll
            for (int n = 0; n < 2; ++n) { const f32x4 bv = bias ? *(const f32x4*)(bias + col0 + bj * HALF + n * 16) : (f32x4){0.f, 0.f, 0.f, 0.f};
#pragma unroll
                for (int ai = 0; ai < 2; ++ai)
#pragma unroll
                    for (int m = 0; m < 4; ++m) acc[ai][bj][m][n] += bv; }
        const bool bad = st.run(acc, u, wr, wc, fr, fq, lds, wid, lane) || poison != 0u;
        const float qnan = __builtin_nanf("");
#pragma unroll
        for (int ai = 0; ai < 2; ++ai)
#pragma unroll
            for (int m = 0; m < 4; ++m) { const int r = ai * HALF + wr * 64 + m * 16 + fr; const f32x2v sr = S[r]; const size_t off = (size_t)(u.pm * BM + r) * ldc + col0;
#pragma unroll
                for (int bj = 0; bj < 2; ++bj)
#pragma unroll
                    for (int n = 0; n < 2; ++n) { const f32x4 bs = *(const f32x4*)(base + off + bj * HALF + n * 16); f32x4 o = bs + (acc[ai][bj][m][n] - sr.x) * sr.y;
                        if (bad) o = (f32x4){qnan, qnan, qnan, qnan}; *(f32x4*)(out + off + bj * HALF + n * 16) = o; }
                asm volatile("" ::: "memory"); }
    }
};
struct EpiLnResLn {
    static constexpr bool PERM = false, AFTER_DRAIN = true;
    const float* base; float* out; bf16_t* xn; int ldc; const float* bias; PanelStats st1, st2; unsigned poison;
    __device__ __forceinline__ void refuse(size_t i0, size_t stride, int M, int N) const { const float q = __builtin_nanf(""); for (size_t i = i0; i < (size_t)M * N; i += stride) { const size_t o = (i / N) * ldc + i % N; out[o] = q; xn[o] = (bf16_t)0x7fc0u; }
        if (i0 == 0) { unsigned expect = 0u; __hip_atomic_compare_exchange_strong(st1.tmo + 1, &expect, 0x7f0u, __ATOMIC_RELAXED, __ATOMIC_RELAXED, __HIP_MEMORY_SCOPE_AGENT); __hip_atomic_store(st1.tmo, 1u, __ATOMIC_RELAXED, __HIP_MEMORY_SCOPE_AGENT); } }
    __device__ __forceinline__ void fused(f32x4 (&acc)[2][2][4][2], const Unit& u, int wr, int wc, int fr, int fq, PG8_LAS unsigned char* lds, int wid, int lane) const {
        typedef float f32x2v __attribute__((ext_vector_type(2))); typedef unsigned u32x2v __attribute__((ext_vector_type(2)));
        const PG8_LAS f32x2v* S = (const PG8_LAS f32x2v*)(lds + 8192);
        const int col0 = u.pn * BM + wc * 32 + 4 * fq;
#pragma unroll
        for (int bj = 0; bj < 2; ++bj)
#pragma unroll
            for (int n = 0; n < 2; ++n) { const f32x4 bv = bias ? *(const f32x4*)(bias + col0 + bj * HALF + n * 16) : (f32x4){0.f, 0.f, 0.f, 0.f};
#pragma unroll
                for (int ai = 0; ai < 2; ++ai)
#pragma unroll
                    for (int m = 0; m < 4; ++m) acc[ai][bj][m][n] += bv; }
        bool bad = st1.run(acc, u, wr, wc, fr, fq, lds, wid, lane) || poison != 0u;
        const float qnan = __builtin_nanf("");
#pragma unroll
        for (int ai = 0; ai < 2; ++ai)
#pragma unroll
            for (int m = 0; m < 4; ++m) { const int r = ai * HALF + wr * 64 + m * 16 + fr; const f32x2v sr = S[r]; const size_t off = (size_t)(u.pm * BM + r) * ldc + col0;
#pragma unroll
                for (int bj = 0; bj < 2; ++bj)
#pragma unroll
                    for (int n = 0; n < 2; ++n) { const f32x4 bs = *(const f32x4*)(base + off + bj * HALF + n * 16); acc[ai][bj][m][n] = bs + (acc[ai][bj][m][n] - sr.x) * sr.y; }
                asm volatile("" : "+v"(acc[ai][0][m][0]), "+v"(acc[ai][0][m][1]), "+v"(acc[ai][1][m][0]), "+v"(acc[ai][1][m][1]));
                if (m & 1) asm volatile("" ::: "memory"); }
        const bool bad1 = bad;
        bad = st2.run(acc, u, wr, wc, fr, fq, lds, wid, lane) || bad;
#pragma unroll
        for (int ai = 0; ai < 2; ++ai)
#pragma unroll
            for (int m = 0; m < 4; ++m) { const int r = ai * HALF + wr * 64 + m * 16 + fr; const f32x2v sr = S[r]; const size_t off = (size_t)(u.pm * BM + r) * ldc + col0;
#pragma unroll
                for (int bj = 0; bj < 2; ++bj)
#pragma unroll
                    for (int n = 0; n < 2; ++n) { const f32x4 x1 = acc[ai][bj][m][n]; *(f32x4*)(out + off + bj * HALF + n * 16) = bad1 ? (f32x4){qnan, qnan, qnan, qnan} : x1;
                        const f32x4 o = (x1 - sr.x) * sr.y; u32x2v w; w.x = cvt_pk_bf16(o[0], o[1]); w.y = cvt_pk_bf16(o[2], o[3]);
                        if (bad) { w.x = 0x7fc07fc0u; w.y = 0x7fc07fc0u; } *(u32x2v*)(xn + off + bj * HALF + n * 16) = w; }
                asm volatile("" ::: "memory"); }
    }
};

template <class Epi, class Sched, bool STAMP = false, bool GATHER = false>
__device__ __forceinline__ void gemm_phase(PG8_LAS unsigned char* lds, const Gemm g, const Sched& S, const Epi& E, unsigned long long* stamps, int wid_in) {
    const int wid = wid_in, lane = lane_id(), tid = wid * 64 + lane, wr = wid >> 2, wc = wid & 3, fr = lane & 15, fq = lane >> 4;
    const int K = g.K, nt = K / BK;
    int ts_lo = 0, ts_hi = 0, nts = 0; const unsigned long long rt_entry = STAMP ? (unsigned long long)wall_clock64() : 0ull;
#define PG8_STAMP() do { if (STAMP && wid == 0 && nts < 64) { const unsigned long long _c = (unsigned long long)clock64(); \
        ts_lo = (lane == nts) ? (int)(unsigned)_c : ts_lo; ts_hi = (lane == nts) ? (int)(unsigned)(_c >> 32) : ts_hi; ++nts; } } while (0)
    PG8_STAMP();
    unsigned voffA[2], voffB[2]; int RA[2], CA[2];
#pragma unroll
    for (int i = 0; i < 2; ++i) { int R, C; stage_rc(tid * 16 + i * 8192, R, C); const int Rb = Epi::PERM ? ((R & ~31) + perm32(R & 31)) : R; RA[i] = R; CA[i] = C;
        voffA[i] = (unsigned)(R * K + C) * 2u; voffB[i] = (unsigned)(Rb * K + C) * 2u; }
    unsigned vga[2][2], vgn[2][2];
#define PG8_GIDX(dst, u_) do { _Pragma("unroll") for (int _h = 0; _h < 2; ++_h) _Pragma("unroll") for (int _i = 0; _i < 2; ++_i) { int _r = g.aidx[(u_).pm * BM + _h * HALF + RA[_i]]; _r = ((unsigned)_r < (unsigned)g.M) ? _r : 0; \
        dst[_h][_i] = (unsigned)(_r * K + CA[_i]) * 2u; } } while (0)
    const size_t kstep = (size_t)(BK * 2);
    const size_t hstep = (size_t)HALF * K * 2;
    const size_t tstep = 2 * hstep;
    const unsigned ldsw = (unsigned)wid * 1024u;
    const int aoff = lds_byte(wr * 64 + fr, fq * 8), boff = lds_byte(wc * 32 + fr, fq * 8);
#define PG8_SA(b, h) (((b) * 2 + (h)) * HTB)
#define PG8_SB(b, h) ((4 + (b) * 2 + (h)) * HTB)
#define PG8_STAGE(bufoff, gbase, voff) do { _Pragma("unroll") for (int _i = 0; _i < 2; ++_i) \
        __builtin_amdgcn_global_load_lds((const unsigned*)((const char*)(gbase) + (voff)[_i]), (PG8_LAS unsigned*)(lds + (bufoff) + ldsw + _i * 8192), 16, 0, 0); } while (0)
#define PG8_STA(bufoff, isnext, h, kt) do { if constexpr (GATHER) { const char* _gb = (const char*)g.A + (size_t)(kt) * kstep; \
        _Pragma("unroll") for (int _i = 0; _i < 2; ++_i) __builtin_amdgcn_global_load_lds((const unsigned*)(_gb + ((isnext) ? vgn[h][_i] : vga[h][_i])), (PG8_LAS unsigned*)(lds + (bufoff) + ldsw + _i * 8192), 16, 0, 0); } \
    else { const char* _gb = ((isnext) ? nA : cA) + (size_t)(h) * hstep + (size_t)(kt) * kstep; PG8_STAGE(bufoff, _gb, voffA); } } while (0)
#define PG8_LDA(dst, b, h) do { _Pragma("unroll") for (int m = 0; m < 4; ++m) _Pragma("unroll") for (int k = 0; k < 2; ++k) dst[m][k] = *(const PG8_LAS bf16x8*)(lds + PG8_SA(b, h) + aoff + m * 2048 + k * 1024); } while (0)
#define PG8_LDB(dst, b, h) do { _Pragma("unroll") for (int n = 0; n < 2; ++n) _Pragma("unroll") for (int k = 0; k < 2; ++k) dst[n][k] = *(const PG8_LAS bf16x8*)(lds + PG8_SB(b, h) + boff + n * 2048 + k * 1024); } while (0)
#define PG8_MMA(ai, bj, At, Bt) do { __builtin_amdgcn_s_setprio(1); _Pragma("unroll") for (int m = 0; m < 4; ++m) _Pragma("unroll") for (int n = 0; n < 2; ++n) _Pragma("unroll") for (int k = 0; k < 2; ++k) \
        acc[ai][bj][m][n] = __builtin_amdgcn_mfma_f32_16x16x32_bf16(Bt[n][k], At[m][k], acc[ai][bj][m][n], 0, 0, 0); __builtin_amdgcn_s_setprio(0); } while (0)
#define PG8_WAIT_V(n) asm volatile("s_waitcnt vmcnt(" #n ")" ::: "memory")
#define PG8_WAIT_L(n) asm volatile("s_waitcnt lgkmcnt(" #n ")" ::: "memory")
#define PG8_BAR __builtin_amdgcn_s_barrier()
#define PG8_SCHED __builtin_amdgcn_sched_barrier(0)
    Unit cur, nxt; int ui = 0;
    if (!S.next(0, cur)) return;
    f32x4 acc[2][2][4][2];
#pragma unroll
    for (int a = 0; a < 2; ++a)
#pragma unroll
        for (int b = 0; b < 2; ++b)
#pragma unroll
            for (int m = 0; m < 4; ++m)
#pragma unroll
                for (int n = 0; n < 2; ++n) acc[a][b][m][n] = (f32x4){0.f, 0.f, 0.f, 0.f};
    bf16x8 At[4][2], B0[2][2], B1[2][2];
    const char* cA = (const char*)g.A + (size_t)cur.pm * tstep; const char* cB = (const char*)g.Bt + (size_t)cur.pn * tstep;
    S.a_ready(cur);
    const char* nA = cA;
    if constexpr (GATHER) { PG8_GIDX(vga, cur); }
    PG8_STAGE(PG8_SB(0, 0), cB, voffB); PG8_STA(PG8_SA(0, 0), false, 0, 0); PG8_STAGE(PG8_SB(0, 1), cB + hstep, voffB); PG8_STA(PG8_SA(0, 1), false, 1, 0);
    if (wr == 1) PG8_BAR;
    PG8_WAIT_V(4); PG8_BAR;
    PG8_STAGE(PG8_SB(1, 0), cB + kstep, voffB); PG8_STA(PG8_SA(1, 0), false, 0, 1); PG8_STAGE(PG8_SB(1, 1), cB + hstep + kstep, voffB);
    PG8_WAIT_V(6); PG8_BAR;
    PG8_STAMP();
    for (;;) {
        const bool has_next = S.next(ui + 1, nxt);
        nA = has_next ? (const char*)g.A + (size_t)nxt.pm * tstep : cA; const char* nB = has_next ? (const char*)g.Bt + (size_t)nxt.pn * tstep : cB;
        if constexpr (GATHER) { if (has_next) { PG8_GIDX(vgn, nxt); } else { _Pragma("unroll") for (int _h = 0; _h < 2; ++_h) _Pragma("unroll") for (int _i = 0; _i < 2; ++_i) vgn[_h][_i] = vga[_h][_i]; } }
        for (int t = 0; t < nt; t += 2) {
            const bool last = (t == nt - 2);
            const char* b2 = last ? nB : cB + (size_t)(t + 2) * kstep;
            const char* b3 = b2 + kstep;
            const int kt2 = last ? 0 : t + 2;
            if (last && has_next) S.a_ready(nxt);
            PG8_LDB(B0, 0, 0); PG8_SCHED; PG8_LDA(At, 0, 0); PG8_STA(PG8_SA(1, 1), false, 1, t + 1);
            PG8_WAIT_L(8); PG8_BAR; PG8_WAIT_L(0); PG8_MMA(0, 0, At, B0); PG8_BAR; PG8_SCHED;
            PG8_LDB(B1, 0, 1); PG8_STAGE(PG8_SB(0, 0), b2, voffB);
            PG8_BAR; PG8_WAIT_L(0); PG8_MMA(0, 1, At, B1); PG8_BAR;
            PG8_LDA(At, 0, 1); PG8_STA(PG8_SA(0, 0), last, 0, kt2);
            PG8_BAR; PG8_WAIT_L(0); PG8_MMA(1, 0, At, B0); PG8_BAR; PG8_SCHED;
            PG8_STAGE(PG8_SB(0, 1), b2 + hstep, voffB);
            PG8_WAIT_V(6); PG8_BAR; PG8_MMA(1, 1, At, B1); PG8_BAR;
            PG8_LDB(B0, 1, 0); PG8_SCHED; PG8_LDA(At, 1, 0); PG8_STA(PG8_SA(0, 1), last, 1, kt2);
            PG8_WAIT_L(8); PG8_BAR; PG8_WAIT_L(0); PG8_MMA(0, 0, At, B0); PG8_BAR; PG8_SCHED;
            PG8_LDB(B1, 1, 1); PG8_STAGE(PG8_SB(1, 0), b3, voffB);
            PG8_BAR; PG8_WAIT_L(0); PG8_MMA(0, 1, At, B1); PG8_BAR;
            PG8_LDA(At, 1, 1); PG8_STA(PG8_SA(1, 0), last, 0, kt2 + 1);
            PG8_BAR; PG8_WAIT_L(0); PG8_MMA(1, 0, At, B0); PG8_BAR; PG8_SCHED;
            PG8_STAGE(PG8_SB(1, 1), b3 + hstep, voffB);
            PG8_WAIT_V(6); PG8_BAR; PG8_MMA(1, 1, At, B1); PG8_BAR;
        }
        PG8_STAMP();
        if constexpr (!Epi::AFTER_DRAIN) { E(acc, cur, wr, wc, fr, fq); S.done(cur); }
        PG8_STAMP();
        if (!has_next) break;
#pragma unroll
        for (int a = 0; a < 2; ++a)
#pragma unroll
            for (int b = 0; b < 2; ++b)
#pragma unroll
                for (int m = 0; m < 4; ++m)
#pragma unroll
                    for (int n = 0; n < 2; ++n) acc[a][b][m][n] = (f32x4){0.f, 0.f, 0.f, 0.f};
        cur = nxt; cA = nA; cB = nB; ++ui;
        if constexpr (GATHER) { _Pragma("unroll") for (int _h = 0; _h < 2; ++_h) _Pragma("unroll") for (int _i = 0; _i < 2; ++_i) vga[_h][_i] = vgn[_h][_i]; }
    }
    PG8_WAIT_V(0);
    if (wr == 0) PG8_BAR;
    PG8_BAR;
    if constexpr (Epi::AFTER_DRAIN) { E.fused(acc, cur, wr, wc, fr, fq, lds, wid, lane); S.done(cur); }
    PG8_STAMP();
    if (STAMP && wid == 0) { stamps[lane] = lane < nts ? (((unsigned long long)(unsigned)ts_hi << 32) | (unsigned)ts_lo) : 0ull;
        if (lane == 62) stamps[62] = rt_entry; if (lane == 63) stamps[63] = (unsigned long long)wall_clock64(); }
#undef PG8_STAMP
#undef PG8_SA
#undef PG8_SB
#undef PG8_STAGE
#undef PG8_STA
#undef PG8_GIDX
#undef PG8_LDA
#undef PG8_LDB
#undef PG8_MMA
#undef PG8_WAIT_V
#undef PG8_WAIT_L
#undef PG8_BAR
#undef PG8_SCHED
}
}
constexpr int D = 1024, NB = 2, SEQ = 8192, CTXL = 256;
constexpr int TX = NB * SEQ;
constexpr int TC = NB * CTXL;
constexpr int TR = TX + TC;
constexpr float EPS = 1e-6f;
constexpr int NEXP = 16, CAPX = 1024, CAPC = 32, EROWS = 2304;
constexpr int FF = 2048;
constexpr int NKEY = CTXL + SEQ;
constexpr int RRS = 16896;
constexpr float QSCALE = 0.125f * 1.4426950408889634f;

enum { I_X = 0, I_C, I_CTX, I_CCTX, I_ADAW, I_ADAB, I_SGWIN, I_SGBIN, I_SGVG, I_SGWS, I_SGBS, I_SGWOUT, I_SGBOUT,
       I_HYWIN, I_HYBIN, I_HYCW, I_HYCB, I_HYFW1, I_HYFB1, I_HYFW2, I_HYFB2, I_HYFW3, I_HYFB3, I_HYFREQ, I_HYFWOUT, I_HYSKIP, I_HYWOUT, I_HYBOUT,
       I_DAWIN, I_DAQG, I_DAKG, I_DALQ1, I_DALK1, I_DALQ2, I_DALK2, I_DASUB, I_DAWOUT, I_ROUTER, I_WGATE, I_WUP, I_WDOWN, N_IN };

constexpr size_t MiB = 1u << 20;
constexpr size_t WS_CTL = 0, CTL_ZERO_BYTES = 1 * MiB;
constexpr size_t WS_MOD = 1 * MiB;
constexpr size_t WS_ROPE = 2 * MiB;
constexpr size_t WS_WRT = 2 * MiB + 512 * 1024;
constexpr size_t WS_HID = 3 * MiB;
constexpr int UTS = 8192;
constexpr int FQ_LSEG = 16, FQ_CSEG = 4;
constexpr size_t WS_FSQP = 6 * MiB;
constexpr size_t WS_AFF = 9 * MiB;
constexpr int AFFC_OFF = 2 * 16 * 8192;
constexpr size_t WS_TOKSLOT = 11 * MiB;
constexpr size_t WS_SELTOK = 13 * MiB;
constexpr size_t WS_SELG = 13 * MiB + 512 * 1024;
constexpr size_t WS_WSBD = 14 * MiB;
constexpr size_t WS_WSGIN = 16 * MiB, WS_WSGOUT = 32 * MiB, WS_WHYIN = 40 * MiB, WS_WHYOUT = 46 * MiB, WS_WDAIN = 48 * MiB, WS_WDAOUT = 54 * MiB;
constexpr size_t WS_VSQ = 56 * MiB;
constexpr size_t WS_WGU = 64 * MiB;
constexpr size_t WS_WDN = 576 * MiB;
constexpr size_t WS_X = 832 * MiB;
constexpr size_t WS_H = 898 * MiB;
constexpr size_t WS_BUF1 = 932 * MiB;
constexpr size_t WS_BUF2 = 1064 * MiB;
constexpr size_t WS_BUF3 = 1164 * MiB;
constexpr size_t WS_Y = 1232 * MiB;
constexpr size_t WS_RR = 1304 * MiB;
constexpr size_t WS_RRC = 1436 * MiB;
constexpr size_t WS_END = 1440 * MiB;
constexpr int CW_BAR = 4096;

constexpr int RING_BYTES = 131072;
constexpr int LDS_BYTES = 163840;
constexpr int MISC_OFF = LDS_BYTES - 256;
constexpr int NWAVES = 8, NTHR = 512;

struct Args { const float* in[N_IN]; float* out; unsigned char* ws; int ph_lo, ph_hi; };
static_assert(sizeof(Args) == N_IN * 8 + 8 + 8 + 8, "Args has no padding");

DI int mod_index(int row) { return row < TX ? (row >> 13) : 2; }
DI const float* modp(const Args& a, int layer, int mi, int piece) { return (const float*)(a.ws + WS_MOD) + ((size_t)(layer * 3 + mi) * 6 + piece) * 1024; }

namespace pg8 {
struct MoeOrder {
    int MT, NT, G, c;
    __device__ bool next(int i, Unit& u) const {
        int e, r;
        if ((G & 7) == 0) { const int per = 2 * MT * NT; const int uu = i * (G >> 3) + (c >> 3); if (uu >= per) return false; e = (c & 7) * 2 + uu / (MT * NT); r = uu % (MT * NT); }
        else { const int L = i * G + c; if (L >= 16 * MT * NT) return false; e = L / (MT * NT); r = L - e * (MT * NT); }
        const int nt = r / MT, mt = r - nt * MT;
        u.pm = e * 9 + mt; u.pn = e * NT + nt; return true;
    }
    __device__ __forceinline__ void a_ready(const Unit&) const {}
    __device__ __forceinline__ void done(const Unit&) const {}
};
struct SpatOrder {
    int nunits, G, c;
    __device__ bool next(int i, Unit& u) const {
        const int L = i * G + c; if (L >= nunits) return false;
        u.pm = L & 3; u.pn = L; return true;
    }
    __device__ __forceinline__ void a_ready(const Unit&) const {}
    __device__ __forceinline__ void done(const Unit&) const {}
};
struct EpiRes {
    static constexpr bool PERM = false, AFTER_DRAIN = false;
    float* X; const float* bias; const float* gate0;
    __device__ __forceinline__ void operator()(const f32x4 (&acc)[2][2][4][2], const Unit& u, int wr, int wc, int fr, int fq) const {
        const int row0 = u.pm * BM + wr * 64 + fr, col0 = u.pn * BM + wc * 32 + 4 * fq;
        const int mi = (u.pm * BM) < TX ? ((u.pm * BM) >> 13) : 2;
        const float* gate = gate0 + (size_t)mi * 6 * 1024;
#pragma unroll
        for (int bj = 0; bj < 2; ++bj)
#pragma unroll
            for (int n = 0; n < 2; ++n) {
                const f32x4 bv = bias ? *(const f32x4*)(bias + col0 + bj * HALF + n * 16) : (f32x4){0.f, 0.f, 0.f, 0.f}; const f32x4 gv = *(const f32x4*)(gate + col0 + bj * HALF + n * 16);
#pragma unroll
                for (int ai = 0; ai < 2; ++ai)
#pragma unroll
                    for (int m = 0; m < 4; ++m) { f32x4* p = (f32x4*)(X + (size_t)(row0 + ai * HALF + m * 16) * 1024 + col0 + bj * HALF + n * 16); *p = *p + gv * (acc[ai][bj][m][n] + bv); }
                asm volatile("" ::: "memory"); }
    }
};
struct EpiSwiGLU {
    static constexpr bool PERM = true, AFTER_DRAIN = false;
    bf16_t* O;
    __device__ __forceinline__ void operator()(const f32x4 (&acc)[2][2][4][2], const Unit& u, int wr, int wc, int fr, int fq) const {
        const int row0 = u.pm * BM + wr * 64 + fr; const int e = u.pm / 9; const int pnl = u.pn - e * 16;
        const int col0 = pnl * 128 + wc * 16 + 4 * fq;
#pragma unroll
        for (int ai = 0; ai < 2; ++ai)
#pragma unroll
            for (int m = 0; m < 4; ++m) { bf16_t* rowp = O + (size_t)(row0 + ai * HALF + m * 16) * 2048 + col0;
#pragma unroll
                for (int bj = 0; bj < 2; ++bj) { const f32x4 g = acc[ai][bj][m][0], up = acc[ai][bj][m][1]; f32x4 h;
#pragma unroll
                    for (int j = 0; j < 4; ++j) h[j] = g[j] * __builtin_amdgcn_rcpf(1.0f + __expf(-g[j])) * up[j];
                    u32x2 w; w.x = cvt_pk_bf16(h[0], h[1]); w.y = cvt_pk_bf16(h[2], h[3]);
                    *(u32x2*)(rowp + bj * 64) = w; } }
    }
};
struct EpiDown {
    static constexpr bool PERM = true, AFTER_DRAIN = false;
    bf16_t* O; const float* g;
    __device__ __forceinline__ void operator()(const f32x4 (&acc)[2][2][4][2], const Unit& u, int wr, int wc, int fr, int fq) const {
        const int row0 = u.pm * BM + wr * 64 + fr; const int e = u.pm / 9; const int pnl = u.pn - e * 4;
        const int col0 = pnl * BM + wc * 32 + 8 * fq;
        float gsv[2][4];
#pragma unroll
        for (int ai = 0; ai < 2; ++ai)
#pragma unroll
            for (int m = 0; m < 4; ++m) gsv[ai][m] = g[row0 + ai * HALF + m * 16];
#pragma unroll
        for (int ai = 0; ai < 2; ++ai)
#pragma unroll
            for (int m = 0; m < 4; ++m) { const int row = row0 + ai * HALF + m * 16; const float gs = gsv[ai][m]; bf16_t* rowp = O + (size_t)row * 1024 + col0;
#pragma unroll
                for (int bj = 0; bj < 2; ++bj) { const f32x4 v0 = acc[ai][bj][m][0] * gs, v1 = acc[ai][bj][m][1] * gs;
                    u32x4 w; w.x = cvt_pk_bf16(v0[0], v0[1]); w.y = cvt_pk_bf16(v0[2], v0[3]); w.z = cvt_pk_bf16(v1[0], v1[1]); w.w = cvt_pk_bf16(v1[2], v1[3]);
                    *(u32x4*)(rowp + bj * HALF) = w; } }
    }
};
struct EpiSpat {
    static constexpr bool PERM = true, AFTER_DRAIN = false;
    bf16_t* TT; const bf16_t* ZZ; const float* bs;
    __device__ __forceinline__ void operator()(const f32x4 (&acc)[2][2][4][2], const Unit& u, int wr, int wc, int fr, int fq) const {
        const int chunk = u.pn >> 2, gp = u.pn & 3;
        asm volatile("" : "+v"(fr), "+v"(fq));
        const unsigned lz = (unsigned)(fr * 4096 + 8 * fq) * 2u, lt = (unsigned)(fr * 2048 + 8 * fq) * 2u;
#pragma unroll
        for (int ai = 0; ai < 2; ++ai)
#pragma unroll
            for (int mp = 0; mp < 2; ++mp) {
                const int g = 2 * gp + ai;
                u32x4 uu[2][2]; float bb[2];
#pragma unroll
                for (int mm = 0; mm < 2; ++mm) { const int pu = wr * 64 + (2 * mp + mm) * 16; bb[mm] = bs[g * 128 + pu + fr];
#pragma unroll
                    for (int bj = 0; bj < 2; ++bj) { const int chu = g * 256 + bj * HALF + wc * 32; uu[mm][bj] = *(const u32x4*)((const char*)(ZZ + ((size_t)chunk * 128 + pu) * 4096 + chu) + lz); } }
#pragma unroll
                for (int mm = 0; mm < 2; ++mm) { const int m = 2 * mp + mm; const int pu = wr * 64 + m * 16; const float b = bb[mm];
#pragma unroll
                    for (int bj = 0; bj < 2; ++bj) { const int chu = g * 256 + bj * HALF + wc * 32; const u32x4 u4 = uu[mm][bj];
                        const f32x4 v0 = acc[ai][bj][m][0] + b, v1 = acc[ai][bj][m][1] + b;
                        u32x4 w;
                        w.x = cvt_pk_bf16(__uint_as_float(u4.x << 16) * v0[0], __uint_as_float(u4.x & 0xffff0000u) * v0[1]);
                        w.y = cvt_pk_bf16(__uint_as_float(u4.y << 16) * v0[2], __uint_as_float(u4.y & 0xffff0000u) * v0[3]);
                        w.z = cvt_pk_bf16(__uint_as_float(u4.z << 16) * v1[0], __uint_as_float(u4.z & 0xffff0000u) * v1[1]);
                        w.w = cvt_pk_bf16(__uint_as_float(u4.w << 16) * v1[2], __uint_as_float(u4.w & 0xffff0000u) * v1[3]);
                        *(u32x4*)((char*)(TT + ((size_t)chunk * 128 + pu) * 2048 + chu) + lt) = w; } }
                asm volatile("" ::: "memory"); }
    }
};
}
struct CvtTile { const float* src; bf16_t* dst; int K, N, mode; };
constexpr int CVT_SG = 384, CVT_MOE = 6144, CVT_PROJ = 256;
constexpr int CVT_T_MOE0 = CVT_SG, CVT_T_HY = CVT_T_MOE0 + CVT_MOE, CVT_T_MOE1 = CVT_T_HY + CVT_PROJ, CVT_T_DA = CVT_T_MOE1 + CVT_MOE, CVT_T_MOE2 = CVT_T_DA + CVT_PROJ,
              CVT_T_SG3 = CVT_T_MOE2 + CVT_MOE, CVT_T_MOE3 = CVT_T_SG3 + CVT_SG, CVT_NTILES = CVT_T_MOE3 + CVT_MOE;
DI void cvt_sg(const Args& a, int j, int& r, CvtTile& d) {
    unsigned char* ws = a.ws;
    if (r < 256) { d.K = 1024; d.N = 4096; d.mode = 0; d.src = a.in[I_SGWIN] + (size_t)j * 1024 * 4096; d.dst = (bf16_t*)(ws + WS_WSGIN) + (size_t)j * 4096 * 1024; }
    else { r -= 256; d.K = 2048; d.N = 1024; d.mode = 0; d.src = a.in[I_SGWOUT] + (size_t)j * 2048 * 1024; d.dst = (bf16_t*)(ws + WS_WSGOUT) + (size_t)j * 1024 * 2048; }
}
DI void cvt_moe(const Args& a, int layer, int& r, CvtTile& d) {
    unsigned char* ws = a.ws; const int which = r >> 11, mm = layer * 16 + ((r >> 7) & 15); r &= 127;
    if (which == 0) { d.K = 1024; d.N = 2048; d.mode = 1; d.src = a.in[I_WGATE] + (size_t)mm * 1024 * 2048; d.dst = (bf16_t*)(ws + WS_WGU) + (size_t)mm * 4096 * 1024; }
    else if (which == 1) { d.K = 1024; d.N = 2048; d.mode = 2; d.src = a.in[I_WUP] + (size_t)mm * 1024 * 2048; d.dst = (bf16_t*)(ws + WS_WGU) + (size_t)mm * 4096 * 1024; }
    else { d.K = 2048; d.N = 1024; d.mode = 0; d.src = a.in[I_WDOWN] + (size_t)mm * 2048 * 1024; d.dst = (bf16_t*)(ws + WS_WDN) + (size_t)mm * 1024 * 2048; }
}
DI void cvt_decode(const Args& a, int t, CvtTile& d) {
    unsigned char* ws = a.ws; int r = t;
    if (r < CVT_T_MOE0) cvt_sg(a, 0, r, d);
    else if (r < CVT_T_HY) { r -= CVT_T_MOE0; cvt_moe(a, 0, r, d); }
    else if (r < CVT_T_MOE1) { r -= CVT_T_HY; if (r < 192) { d.K = 1024; d.N = 3072; d.mode = 0; d.src = a.in[I_HYWIN]; d.dst = (bf16_t*)(ws + WS_WHYIN); } else { r -= 192; d.K = 1024; d.N = 1024; d.mode = 0; d.src = a.in[I_HYWOUT]; d.dst = (bf16_t*)(ws + WS_WHYOUT); } }
    else if (r < CVT_T_DA) { r -= CVT_T_MOE1; cvt_moe(a, 1, r, d); }
    else if (r < CVT_T_MOE2) { r -= CVT_T_DA; if (r < 192) { d.K = 1024; d.N = 3072; d.mode = 0; d.src = a.in[I_DAWIN]; d.dst = (bf16_t*)(ws + WS_WDAIN); } else { r -= 192; d.K = 1024; d.N = 1024; d.mode = 0; d.src = a.in[I_DAWOUT]; d.dst = (bf16_t*)(ws + WS_WDAOUT); } }
    else if (r < CVT_T_SG3) { r -= CVT_T_MOE2; cvt_moe(a, 2, r, d); }
    else if (r < CVT_T_MOE3) { r -= CVT_T_SG3; cvt_sg(a, 1, r, d); }
    else { r -= CVT_T_MOE3; cvt_moe(a, 3, r, d); }
    const int ntn = d.N >> 7; const int kt = r / ntn, nt = r - kt * ntn;
    d.src += (size_t)(kt * 128) * d.N + nt * 128; d.dst += kt * 128;
    d.mode |= (nt << 8);
}
DI void cvt_load(const CvtTile& d, float (&v)[32], int tid) {
    const int nl = tid & 127, kq = tid >> 7; const float* p = d.src + (size_t)(kq * 32) * d.N + nl;
#pragma unroll
    for (int i = 0; i < 32; ++i) v[i] = p[(size_t)i * d.N];
}
DI void cvt_pack(LAS unsigned* L, const float (&v)[32], int tid) {
    const int nl = tid & 127, kq = tid >> 7;
#pragma unroll
    for (int i = 0; i < 16; ++i) L[nl * 65 + kq * 16 + i] = pkbf(v[2 * i], v[2 * i + 1]);
}
DI void cvt_store(const LAS unsigned* L, const CvtTile& cur, int tid) {
    const int kq2 = tid & 15, nb = cur.mode >> 8, mode = cur.mode & 255;
#pragma unroll
    for (int j = 0; j < 4; ++j) { const int n = (tid >> 4) + 32 * j; const LAS unsigned* lp = L + n * 65 + 4 * kq2;
        u32x4 o; o.x = lp[0]; o.y = lp[1]; o.z = lp[2]; o.w = lp[3];
        const int na = nb * 128 + n; const int row = mode == 0 ? na : (((na >> 2) << 3) + (na & 3) + (mode == 2 ? 4 : 0));
        *(u32x4*)(cur.dst + (size_t)row * cur.K + 8 * kq2) = o; }
}
DI void cvt_load_w(const CvtTile& d, float (&v)[32], int wave, int lane) {
    const int nl = lane & 15, kg = lane >> 4; const float* p = d.src + (size_t)(kg * 32) * d.N + wave * 16 + nl;
#pragma unroll
    for (int i = 0; i < 32; ++i) v[i] = p[(size_t)i * d.N];
}
DI void cvt_pack_w(LAS unsigned* Lw, const float (&v)[32], int lane) {
    const int nl = lane & 15, kg = lane >> 4;
#pragma unroll
    for (int i = 0; i < 16; ++i) Lw[nl * 65 + kg * 16 + i] = pkbf(v[2 * i], v[2 * i + 1]);
}
DI void cvt_store_w(const LAS unsigned* Lw, const CvtTile& cur, int wave, int lane) {
    const int kq2 = lane & 15, nb = cur.mode >> 8, mode = cur.mode & 255;
#pragma unroll
    for (int j = 0; j < 4; ++j) { const int n = (lane >> 4) + 4 * j; const LAS unsigned* lp = Lw + n * 65 + 4 * kq2;
        u32x4 o; o.x = lp[0]; o.y = lp[1]; o.z = lp[2]; o.w = lp[3];
        const int na = nb * 128 + wave * 16 + n; const int row = mode == 0 ? na : (((na >> 2) << 3) + (na & 3) + (mode == 2 ? 4 : 0));
        *(u32x4*)(cur.dst + (size_t)row * cur.K + 8 * kq2) = o; }
}
DI void cvt_range(const Args& a, LAS unsigned char* lds, int tid, int lo, int hi) {
    LAS unsigned* L = (LAS unsigned*)lds;
    int t = lo + blockIdx.x;
    if (t >= hi) return;
    CvtTile cur; cvt_decode(a, t, cur);
    float v[32]; cvt_load(cur, v, tid);
    for (;;) {
        const int tn = t + gridDim.x; const bool more = tn < hi;
        CvtTile nxt = cur; float vn[32];
        if (more) { cvt_decode(a, tn, nxt); cvt_load(nxt, vn, tid); }
        cvt_pack(L, v, tid);
        __syncthreads();
        cvt_store(L, cur, tid);
        __syncthreads();
        if (!more) break;
        t = tn; cur = nxt;
#pragma unroll
        for (int i = 0; i < 32; ++i) v[i] = vn[i];
    }
}
DI void pro0_small(const Args& a, int gtid, int gthreads) {
    bf16_t* sbd = (bf16_t*)(a.ws + WS_WSBD);
    for (int i = gtid; i < 2 * 4 * 256 * 256; i += gthreads) {
        const int col = i & 255, row = (i >> 8) & 255, gp = (i >> 16) & 3, j = i >> 18;
        const int gsel = row >> 7, p = row & 127, gl = col >> 7, q = col & 127;
        const float v = (gsel == gl) ? a.in[I_SGWS][(((size_t)j * 8 + 2 * gp + gsel) * 128 + p) * 128 + q] : 0.f;
        sbd[i] = f2bf1(v);
    }
    float* rope = (float*)(a.ws + WS_ROPE);
    for (int i = gtid; i < 2048; i += gthreads) {
        const int pos = i >> 4, f = i & 15;
        const float inv = powf(10000.0f, -(float)f / 16.0f);
        const float ang = (float)pos * inv;
        rope[2 * i] = cosf(ang); rope[2 * i + 1] = sinf(ang);
    }
    float* wrt = (float*)(a.ws + WS_WRT);
    for (int i = gtid; i < 4 * 16384; i += gthreads) wrt[i] = a.in[I_ROUTER][(size_t)(i >> 14) * 16384 + (i & 1023) * 16 + ((i >> 10) & 15)];
    bf16_t* rr = (bf16_t*)(a.ws + WS_RR);
    for (int i = gtid; i < 2048 * 513; i += gthreads) {
        const int row = i / 513, k = i % 513;
        const int idx = k == 512 ? 0 : 16384 + k;
        rr[(size_t)row * RRS + idx] = 0;
    }
}
DI void pro0_mod(const Args& a, LAS unsigned char* lds, int tid, int lane, int wave) {
    LAS float* sc = (LAS float*)lds;
    for (int i = tid; i < 3072; i += NTHR) { const int r = i >> 10, k = i & 1023; const float v = (r < 2) ? a.in[I_C][r * 1024 + k] : a.in[I_CCTX][k]; sc[i] = v / (1.0f + expf(-v)); }
    __syncthreads();
    LAS float* red = (LAS float*)(lds + 12288);
    float* MOD = (float*)(a.ws + WS_MOD);
    for (int it = blockIdx.x; it < 384; it += gridDim.x) {
        const int l = it / 96, cg = it % 96, col = cg * 64 + lane;
        const float* w = a.in[I_ADAW] + (size_t)l * 1024 * 6144 + col;
        float a0 = 0.f, a1 = 0.f, a2 = 0.f;
#pragma unroll 16
        for (int k = wave * 128; k < wave * 128 + 128; ++k) { const float wv = w[(size_t)k * 6144]; a0 += sc[k] * wv; a1 += sc[1024 + k] * wv; a2 += sc[2048 + k] * wv; }
        red[(wave * 3 + 0) * 64 + lane] = a0; red[(wave * 3 + 1) * 64 + lane] = a1; red[(wave * 3 + 2) * 64 + lane] = a2;
        __syncthreads();
        if (wave < 3) { float s = 0.f;
#pragma unroll
            for (int w8 = 0; w8 < 8; ++w8) s += red[(w8 * 3 + wave) * 64 + lane];
            MOD[(size_t)(l * 3 + wave) * 6144 + col] = s + a.in[I_ADAB][l * 6144 + col]; }
        __syncthreads();
    }
}
DI void pro0_filter1(const Args& a, int lane, int gw, int NGW) {
    float w1c[33], w2c[64], w3c[64];
#pragma unroll
    for (int i = 0; i < 33; ++i) w1c[i] = a.in[I_HYFW1][i * 64 + lane];
#pragma unroll
    for (int i = 0; i < 64; ++i) { w2c[i] = a.in[I_HYFW2][i * 64 + lane]; w3c[i] = a.in[I_HYFW3][i * 64 + lane]; }
    const float b1 = a.in[I_HYFB1][lane], b2 = a.in[I_HYFB2][lane], b3 = a.in[I_HYFB3][lane], fr = a.in[I_HYFREQ][lane];
    float* HID = (float*)(a.ws + WS_HID);
    for (int tt = gw; tt < 8448; tt += NGW) {
        const int n = tt < 8192 ? 8192 : 256, t = tt < 8192 ? tt : tt - 8192;
        const float tl = (float)t / (float)(n - 1);
        const float w = (6.283185307179586f / (float)n) * (float)t;
        float z = tl;
        if (lane >= 1 && lane <= 16) { const float f = 1e-4f + (float)(lane - 1) * ((15.0f - 1e-4f) / 15.0f); z = cosf(f * w); }
        else if (lane >= 17 && lane <= 32) { const float f = 1e-4f + (float)(lane - 17) * ((15.0f - 1e-4f) / 15.0f); z = -sinf(f * w); }
        float p = b1;
#pragma unroll
        for (int i = 0; i < 33; ++i) p += __uint_as_float(__builtin_amdgcn_readlane(__float_as_uint(z), i)) * w1c[i];
        float h = sinf(fr * p);
        p = b2;
#pragma unroll
        for (int i = 0; i < 64; ++i) p += __uint_as_float(__builtin_amdgcn_readlane(__float_as_uint(h), i)) * w2c[i];
        h = sinf(fr * p);
        p = b3;
#pragma unroll
        for (int i = 0; i < 64; ++i) p += __uint_as_float(__builtin_amdgcn_readlane(__float_as_uint(h), i)) * w3c[i];
        h = sinf(fr * p);
        HID[(size_t)tt * 64 + lane] = h;
    }
}
DI void split_bf16(const float (&x)[8], bf16x8& hi, bf16x8& lo) {
    u32x4 h, l;
    unsigned hw[4], lw[4];
#pragma unroll
    for (int i = 0; i < 4; ++i) { const unsigned p = pkbf(x[2 * i], x[2 * i + 1]); hw[i] = p; lw[i] = pkbf(x[2 * i] - bflo(p), x[2 * i + 1] - bfhi(p)); }
    h.x = hw[0]; h.y = hw[1]; h.z = hw[2]; h.w = hw[3]; l.x = lw[0]; l.y = lw[1]; l.z = lw[2]; l.w = lw[3];
    hi = __builtin_bit_cast(bf16x8, h); lo = __builtin_bit_cast(bf16x8, l);
}
DI void pro1_filter2(const Args& a, LAS unsigned char* lds, int lane, int gw, int NGW) {
    LAS unsigned char* SG = lds + 34816 + (gw & 7) * 4608;
    const float* HID = (const float*)(a.ws + WS_HID);
    const float* wout = a.in[I_HYFWOUT];
    float* FSQP = (float*)(a.ws + WS_FSQP);
    bf16_t* RR0 = (bf16_t*)(a.ws + WS_RR);
    float* RRC = (float*)(a.ws + WS_RRC);
    const float dmin = logf(0.01f) / 1.5f, dmax = logf(0.01f) / 0.3f;
    const int l32 = lane & 31, kg = lane >> 5;
    const int G_ = NGW >> 3, uw = (gw & 7) * G_ + (gw >> 3);
    for (int unit = uw; unit < 128 * (FQ_LSEG + FQ_CSEG); unit += NGW) {
        const int ct = unit & 127, seg = unit >> 7;
        const int col0 = ct * 32, o = col0 >> 11, side = (col0 >> 10) & 1;
        bf16x8 whi[4], wlo[4];
#pragma unroll
        for (int ks = 0; ks < 4; ++ks) { float w[8];
#pragma unroll
            for (int j = 0; j < 8; ++j) w[j] = wout[(size_t)(16 * ks + 8 * kg + j) * 4096 + col0 + l32];
            split_bf16(w, whi[ks], wlo[ks]); }
        const unsigned cc = (unsigned)((col0 + l32) & 1023), row = (unsigned)(o * 1024) + cc;
        const float dl2 = -fabsf(dmin + (float)cc * ((dmax - dmin) / 1023.0f)) * 1.4426950408889634f;
        const bool lat = seg < FQ_LSEG;
        const int n = lat ? 8192 : 256, ntile = lat ? 8192 / FQ_LSEG / 32 : 256 / FQ_CSEG / 32, tbase = lat ? seg * (8192 / FQ_LSEG) : (seg - FQ_LSEG) * (256 / FQ_CSEG), ttoff = lat ? 0 : 8192;
        const float rn1 = 1.0f / (float)(n - 1);
        const int toff = side == 0 ? 1 : 0;
        const bool extra = (side == 0) && tbase == 0;
        const int ntl = ntile + (extra ? 1 : 0);
        float sq = 0.f;
        f32x4 hq[8];
#define FQ_TB(tile) ((tile) == ntile ? 0 : tbase + toff + (tile) * 32)
#define FQ_LOAD(tile) do { int tl_ = FQ_TB(tile) + l32; tl_ = tl_ < n ? tl_ : n - 1;   \
            const f32x4* hp = (const f32x4*)(HID + (size_t)(ttoff + tl_) * 64 + 8 * kg); _Pragma("unroll") for (int ks = 0; ks < 4; ++ks) { hq[2 * ks] = hp[4 * ks]; hq[2 * ks + 1] = hp[4 * ks + 1]; } } while (0)
        FQ_LOAD(0);
        for (int tile = 0; tile < ntl; ++tile) {
            const bool ex = tile == ntile;
            const int tb = FQ_TB(tile);
            f32x16 acc;
#pragma unroll
            for (int r = 0; r < 16; ++r) acc[r] = 0.f;
#pragma unroll
            for (int ks = 0; ks < 4; ++ks) { const f32x4 h0 = hq[2 * ks], h1 = hq[2 * ks + 1]; const float hv[8] = {h0[0], h0[1], h0[2], h0[3], h1[0], h1[1], h1[2], h1[3]};
                bf16x8 hhi, hlo; split_bf16(hv, hhi, hlo);
                acc = MFMA32(hhi, whi[ks], acc); acc = MFMA32(hlo, whi[ks], acc); acc = MFMA32(hhi, wlo[ks], acc); }
            if (tile + 1 < ntl) FQ_LOAD(tile + 1);
#pragma unroll
            for (int g = 0; g < 4; ++g) {
                const int t0g = tb + 8 * g + 4 * kg;
                float v[4];
#pragma unroll
                for (int q = 0; q < 4; ++q) { const int t = t0g + q; const bool ok = ex ? (t == 0) : ((t < n) && !(side == 1 && t == 0));
                    const float x = acc[4 * g + q] * __builtin_amdgcn_exp2f((float)t * rn1 * dl2); v[q] = ok ? x : 0.f; sq += v[q] * v[q]; }
                if (ex) { if (g == 0 && kg == 0) { if (lat) RR0[row * (unsigned)RRS + (unsigned)n] = f2bf1(v[0]); else RRC[row * 512u + (unsigned)n] = v[0]; } }
                else if (lat) { const int tl = (tile & 1) * 32 + 8 * g + 4 * kg;
                    u32x2 w; if (side == 0) { w.x = pkbf(v[3], v[2]); w.y = pkbf(v[1], v[0]); } else { w.x = pkbf(v[0], v[1]); w.y = pkbf(v[2], v[3]); }
                    *(LAS u32x2*)(SG + l32 * 144 + (side == 0 ? 60 - tl : tl) * 2) = w; }
                else if (side == 0) { const unsigned idx = (unsigned)(n - t0g - 3);
                    if (lat) { u32x2 w; w.x = pkbf(v[3], v[2]); w.y = pkbf(v[1], v[0]); *(u32x2*)(RR0 + (row * (unsigned)RRS + idx)) = w; }
                    else *(f32x4*)(RRC + (row * 512u + idx)) = (f32x4){v[3], v[2], v[1], v[0]}; }
                else { const unsigned idx = (unsigned)(n + t0g);
                    if (t0g == 0) {
#pragma unroll
                        for (int q = 1; q < 4; ++q) { if (lat) RR0[row * (unsigned)RRS + idx + q] = f2bf1(v[q]); else RRC[row * 512u + idx + q] = v[q]; } }
                    else if (lat) { u32x2 w; w.x = pkbf(v[0], v[1]); w.y = pkbf(v[2], v[3]); *(u32x2*)(RR0 + (row * (unsigned)RRS + idx)) = w; }
                    else *(f32x4*)(RRC + (row * 512u + idx)) = (f32x4){v[0], v[1], v[2], v[3]}; }
            }
            if (lat && !ex && (tile & 1)) {
                LDS_WAIT(); __builtin_amdgcn_wave_barrier();
                const int tp0 = tb - 32;
                const unsigned idx0 = side == 0 ? (unsigned)(n - tp0 - 63) : (unsigned)(n + tp0);
                const int piece = lane & 7;
#pragma unroll
                for (int j = 0; j < 4; ++j) { const int col = (lane >> 3) + 8 * j;
                    const u32x4 ov = *(const LAS u32x4*)(SG + col * 144 + piece * 16);
                    bf16_t* dp = RR0 + (((unsigned)(o * 1024) + (unsigned)((col0 + col) & 1023)) * (unsigned)RRS + idx0 + (unsigned)piece * 8u);
                    if (side == 1 && tp0 == 0 && piece == 0) {
                        dp[1] = (bf16_t)(ov.x >> 16); *(unsigned*)(dp + 2) = ov.y; *(u32x2*)(dp + 4) = (u32x2){ov.z, ov.w}; }
                    else *(u32x4*)dp = ov; }
                __builtin_amdgcn_wave_barrier();
            }
        }
#undef FQ_TB
#undef FQ_LOAD
        sq += __shfl_xor(sq, 32);
        if (kg == 0) FSQP[(size_t)seg * 4096 + col0 + l32] = sq;
    }
}

template <int LAYER> DI void phase_A(const Args& a, int lane, int gw, int NGW) {
    constexpr int nrows = (LAYER >= 3) ? TX : TR;
    float* X = (float*)(a.ws + WS_X); bf16_t* H = (bf16_t*)(a.ws + WS_H);
    const int* TS = (const int*)(a.ws + WS_TOKSLOT); const bf16_t* Y = (const bf16_t*)(a.ws + WS_Y);
    for (int r = gw; r < nrows; r += NGW) {
        const int mi = mod_index(r);
        f32x4 v[4];
        if (LAYER == 0) { const f32x4* src = (const f32x4*)(r < TX ? a.in[I_X] + (size_t)r * 1024 : a.in[I_CTX] + (size_t)(r - TX) * 1024) + lane;
#pragma unroll
            for (int j = 0; j < 4; ++j) v[j] = src[64 * j]; }
        else {
            const f32x4* src = (const f32x4*)(X + (size_t)r * 1024) + lane;
#pragma unroll
            for (int j = 0; j < 4; ++j) v[j] = src[64 * j];
            const bool has = (r < TX) || (LAYER - 1 <= 1);
            if (has) {
                f32x4 acc[4];
#pragma unroll
                for (int j = 0; j < 4; ++j) acc[j] = (f32x4){0.f, 0.f, 0.f, 0.f};
                const int tsv = lane < 16 ? (r < TX ? TS[(size_t)((r >> 13) * 16 + lane) * 8192 + (r & 8191)] : TS[AFFC_OFF + (((r - TX) >> 8) * 16 + lane) * 256 + ((r - TX) & 255)]) : -1;
                unsigned long long msk = __ballot(tsv >= 0);
                while (msk) {
                    int sl[4], ex[4];
#pragma unroll
                    for (int q = 0; q < 4; ++q) { if (msk) { const int e = __builtin_ctzll(msk); msk &= msk - 1; ex[q] = e; sl[q] = __builtin_amdgcn_readlane(tsv, e); } else { ex[q] = 0; sl[q] = -1; } }
                    u32x2 w[4][4];
#pragma unroll
                    for (int q = 0; q < 4; ++q) { if (sl[q] >= 0) { const u32x2* yp = (const u32x2*)(Y + ((size_t)ex[q] * EROWS + sl[q]) * 1024) + lane;
#pragma unroll
                            for (int j = 0; j < 4; ++j) w[q][j] = yp[64 * j]; }
                        else {
#pragma unroll
                            for (int j = 0; j < 4; ++j) w[q][j] = (u32x2){0u, 0u}; } }
#pragma unroll
                    for (int q = 0; q < 4; ++q)
#pragma unroll
                        for (int j = 0; j < 4; ++j) acc[j] += (f32x4){bflo(w[q][j].x), bfhi(w[q][j].x), bflo(w[q][j].y), bfhi(w[q][j].y)};
                }
                const f32x4* g2 = (const f32x4*)modp(a, LAYER - 1, mi, 5) + lane;
#pragma unroll
                for (int j = 0; j < 4; ++j) v[j] += g2[64 * j] * acc[j];
            }
        }
        if (LAYER == 4) { f32x4* o = (f32x4*)(a.out + (size_t)r * 1024) + lane;
#pragma unroll
            for (int j = 0; j < 4; ++j) o[64 * j] = v[j];
            continue; }
        { f32x4* o = (f32x4*)(X + (size_t)r * 1024) + lane;
#pragma unroll
          for (int j = 0; j < 4; ++j) o[64 * j] = v[j]; }
        float ss = 0.f;
#pragma unroll
        for (int j = 0; j < 4; ++j) ss += (v[j][0] * v[j][0] + v[j][1] * v[j][1]) + (v[j][2] * v[j][2] + v[j][3] * v[j][3]);
        const float rs = 1.0f / sqrtf(wave_sum(ss) * (1.0f / 1024.0f) + EPS);
        constexpr int LY = LAYER < 4 ? LAYER : 0;
        const f32x4* sh = (const f32x4*)modp(a, LY, mi, 0) + lane; const f32x4* sc = (const f32x4*)modp(a, LY, mi, 1) + lane;
        u32x2* ho = (u32x2*)(H + (size_t)r * 1024) + lane;
#pragma unroll
        for (int j = 0; j < 4; ++j) { const f32x4 y = v[j] * rs * (sc[64 * j] + 1.0f) + sh[64 * j]; u32x2 w; w.x = pkbf(y[0], y[1]); w.y = pkbf(y[2], y[3]); ho[64 * j] = w; }
    }
}

template <int LAYER> DI void phase_moe_prep(const Args& a, LAS unsigned char* lds, int tid, int lane, int gw, int NGW) {
    constexpr int nrows = (LAYER >= 2) ? TX : TR;
    LAS float* wr = (LAS float*)lds;
    { const u32x4* src = (const u32x4*)(a.ws + WS_WRT) + (size_t)LAYER * 4096;
#pragma unroll
      for (int n = 0; n < 8; ++n) ((LAS u32x4*)lds)[tid + NTHR * n] = src[tid + NTHR * n]; }
    __syncthreads();
    const float* X = (const float*)(a.ws + WS_X); bf16_t* H = (bf16_t*)(a.ws + WS_H); float* AFF = (float*)(a.ws + WS_AFF);
    const bool b0 = lane & 1, b1 = lane & 2, b2 = lane & 4, b3 = lane & 8, b4 = lane & 16;
    constexpr int NR = 2, NG = nrows / NR, NGX = TX / NR;
    const int nlat = (NGX - gw + NGW - 1) / NGW, tstride = NGW >> 3, ntail = ((gw & 7) == 5 && (gw >> 3) < NG - NGX) ? (NG - NGX - (gw >> 3) + tstride - 1) / tstride : 0;
    const int ntrip = nlat + ntail;
#define MP_GROUP(it) ((it) < nlat ? gw + (it) * NGW : NGX + (gw >> 3) + ((it) - nlat) * tstride)
    f32x4 v[NR][4], nx[NR][4];
    if (ntrip > 0) { const int r0 = NR * MP_GROUP(0);
#pragma unroll
        for (int q = 0; q < NR; ++q) { const f32x4* src = (const f32x4*)(X + (size_t)(r0 + q) * 1024) + lane;
#pragma unroll
            for (int j = 0; j < 4; ++j) v[q][j] = src[64 * j]; } }
    for (int it = 0; it < ntrip; ++it) {
        const int r0 = NR * MP_GROUP(it), mi = mod_index(r0);
        const f32x4* sh = (const f32x4*)modp(a, LAYER, mi, 3) + lane; const f32x4* sc = (const f32x4*)modp(a, LAYER, mi, 4) + lane;
        f32x4 shv[4], scv[4];
#pragma unroll
        for (int j = 0; j < 4; ++j) { shv[j] = sh[64 * j]; scv[j] = sc[64 * j] + 1.0f; }
        if (it + 1 < ntrip) { const int r1 = NR * MP_GROUP(it + 1);
#pragma unroll
            for (int q = 0; q < NR; ++q) { const f32x4* src = (const f32x4*)(X + (size_t)(r1 + q) * 1024) + lane;
#pragma unroll
                for (int j = 0; j < 4; ++j) nx[q][j] = src[64 * j]; } }
#pragma unroll
        for (int q = 0; q < NR; ++q) {
            float ss = 0.f;
#pragma unroll
            for (int j = 0; j < 4; ++j) ss += (v[q][j][0] * v[q][j][0] + v[q][j][1] * v[q][j][1]) + (v[q][j][2] * v[q][j][2] + v[q][j][3] * v[q][j][3]);
            const float rs = 1.0f / sqrtf(wave_sum(ss) * (1.0f / 1024.0f) + EPS);
            u32x2* ho = (u32x2*)(H + (size_t)(r0 + q) * 1024) + lane;
#pragma unroll
            for (int j = 0; j < 4; ++j) { v[q][j] = v[q][j] * rs * scv[j] + shv[j]; u32x2 w; w.x = pkbf(v[q][j][0], v[q][j][1]); w.y = pkbf(v[q][j][2], v[q][j][3]); ho[64 * j] = w; }
        }
        float u[NR];
#pragma unroll
        for (int h = 0; h < 2; ++h) {
            float s[NR][8];
#pragma unroll
            for (int e = 0; e < 8; ++e) {
                f32x4 w4[4];
#pragma unroll
                for (int j = 0; j < 4; ++j) w4[j] = *(const LAS f32x4*)(wr + (8 * h + e) * 1024 + j * 256 + lane * 4);
#pragma unroll
                for (int q = 0; q < NR; ++q) { f32x2 t = (f32x2){0.f, 0.f};
#pragma unroll
                    for (int j = 0; j < 4; ++j) { t += (f32x2){v[q][j][0], v[q][j][1]} * (f32x2){w4[j][0], w4[j][1]}; t += (f32x2){v[q][j][2], v[q][j][3]} * (f32x2){w4[j][2], w4[j][3]}; }
                    s[q][e] = t.x + t.y; }
            }
#pragma unroll
            for (int q = 0; q < NR; ++q) {
                float t4[4], t2[2];
#pragma unroll
                for (int i = 0; i < 4; ++i) t4[i] = (b0 ? s[q][2 * i + 1] : s[q][2 * i]) + dppf<DPP_XOR1>(b0 ? s[q][2 * i] : s[q][2 * i + 1]);
#pragma unroll
                for (int i = 0; i < 2; ++i) t2[i] = (b1 ? t4[2 * i + 1] : t4[2 * i]) + dppf<DPP_XOR2>(b1 ? t4[2 * i] : t4[2 * i + 1]);
                float t1 = (b2 ? t2[1] : t2[0]) + dppf<DPP_ROR(4)>(b2 ? t2[0] : t2[1]);
                t1 += dppf<DPP_ROR(8)>(t1);
                u[q] = (h == 0) ? t1 : (b3 ? t1 : u[q]);
            }
        }
        float lg = (b4 ? u[1] : u[0]) + __shfl_xor(b4 ? u[0] : u[1], 16);
        lg += __shfl_xor(lg, 32);
        const float ex = expf(lg - row_max16(lg)), pr = ex / row_sum16(ex);
        if (lane < 32) { const int r = r0 + (lane >> 4), e = lane & 15;
            if (r < TX) AFF[(size_t)((r >> 13) * 16 + e) * 8192 + (r & 8191)] = pr; else AFF[AFFC_OFF + (((r - TX) >> 8) * 16 + e) * 256 + ((r - TX) & 255)] = pr; }
#pragma unroll
        for (int q = 0; q < NR; ++q)
#pragma unroll
            for (int j = 0; j < 4; ++j) v[q][j] = nx[q][j];
    }
#undef MP_GROUP
}

template <int LAYER> DI void phase_topk(const Args& a, LAS unsigned char* lds, int tid, int lane, int wave) {
    constexpr int nprob = (LAYER >= 2) ? 32 : 64;
    const float* AFF = (const float*)(a.ws + WS_AFF);
    int* TS = (int*)(a.ws + WS_TOKSLOT); int* SELTOK = (int*)(a.ws + WS_SELTOK); float* SELG = (float*)(a.ws + WS_SELG);
    LAS unsigned* red = (LAS unsigned*)lds;
    LAS unsigned* scan = (LAS unsigned*)(lds + 256);
    LAS unsigned* hist = (LAS unsigned*)(lds + 512);
    for (int p = blockIdx.x; p < nprob; p += gridDim.x) {
        const bool isx = p < 32; const int pb = isx ? p : p - 32; const int b = pb >> 4, e = pb & 15;
        const int N = isx ? 8192 : 256, cap = isx ? CAPX : CAPC, rowbase = isx ? b * 8192 : TX + b * 256, slotbase = isx ? b * 1024 : 2048 + b * 32;
        const size_t pbase = isx ? (size_t)pb * 8192 : (size_t)AFFC_OFF + pb * 256;
        unsigned key[16];
        const bool active = tid * 16 < N;
#pragma unroll
        for (int i4 = 0; i4 < 4; ++i4) { u32x4 k4 = (u32x4){0u, 0u, 0u, 0u}; if (active) k4 = *(const u32x4*)(AFF + pbase + tid * 16 + i4 * 4);
            key[4 * i4] = k4.x; key[4 * i4 + 1] = k4.y; key[4 * i4 + 2] = k4.z; key[4 * i4 + 3] = k4.w; }
        unsigned T = 0u; unsigned kneed = (unsigned)cap;
#pragma unroll 1
        for (int pass = 0; pass < 4; ++pass) {
            const int shift = pass == 0 ? 23 : pass == 1 ? 15 : pass == 2 ? 7 : 0;
            const int nbits = pass == 3 ? 7 : 8;
            if (tid < 256) hist[tid] = 0u;
            __syncthreads();
            if (active) {
#pragma unroll
                for (int i = 0; i < 16; ++i) { const unsigned kk = key[i]; if ((kk >> (shift + nbits)) == (T >> (shift + nbits))) __hip_atomic_fetch_add(&hist[(kk >> shift) & ((1u << nbits) - 1u)], 1u, __ATOMIC_RELAXED, __HIP_MEMORY_SCOPE_WORKGROUP); }
            }
            __syncthreads();
            if (wave == 0) {
                const unsigned h0 = hist[4 * lane], h1 = hist[4 * lane + 1], h2 = hist[4 * lane + 2], h3 = hist[4 * lane + 3];
                unsigned suf = h0 + h1 + h2 + h3;
#pragma unroll
                for (int o = 1; o < 64; o <<= 1) { const unsigned t2 = __shfl_down(suf, o); if (lane + o < 64) suf += t2; }
                const unsigned above = suf - (h0 + h1 + h2 + h3);
                unsigned a3 = above, a2 = a3 + h3, a1 = a2 + h2, a0 = a1 + h1;
                int dsel = -1; unsigned asel = 0;
                if (a3 < kneed && kneed <= a3 + h3) { dsel = 4 * lane + 3; asel = a3; }
                else if (a2 < kneed && kneed <= a2 + h2) { dsel = 4 * lane + 2; asel = a2; }
                else if (a1 < kneed && kneed <= a1 + h1) { dsel = 4 * lane + 1; asel = a1; }
                else if (a0 < kneed && kneed <= a0 + h0) { dsel = 4 * lane; asel = a0; }
                if (dsel >= 0) { red[0] = (unsigned)dsel; red[1] = kneed - asel; }
            }
            __syncthreads();
            T |= red[0] << shift; kneed = red[1];
        }
        unsigned cg = 0, ce = 0;
#pragma unroll
        for (int i = 0; i < 16; ++i) { cg += (active && key[i] > T) ? 1u : 0u; ce += (active && key[i] == T) ? 1u : 0u; }
        unsigned ig = cg, ie = ce;
#pragma unroll
        for (int o = 1; o < 64; o <<= 1) { const unsigned tg = __shfl_up(ig, o), te = __shfl_up(ie, o); if (lane >= o) { ig += tg; ie += te; } }
        __syncthreads();
        if (lane == 63) { scan[wave * 2] = ig; scan[wave * 2 + 1] = ie; }
        __syncthreads();
        unsigned bg = 0, be = 0, totg = 0;
#pragma unroll
        for (int w8 = 0; w8 < 8; ++w8) { const unsigned g8 = scan[w8 * 2], e8 = scan[w8 * 2 + 1]; if (w8 < wave) { bg += g8; be += e8; } totg += g8; }
        unsigned pg = bg + ig - cg, pe = be + ie - ce;
        const unsigned need_eq = (unsigned)cap - totg;
        if (active) {
            int slots[16];
#pragma unroll
            for (int i = 0; i < 16; ++i) {
                const int row = rowbase + tid * 16 + i;
                const bool gt = key[i] > T, eq = key[i] == T;
                const bool sel = gt || (eq && pe < need_eq);
                int slot = -1;
                if (sel) { slot = slotbase + (int)(pg + (pe < need_eq ? pe : need_eq)); SELTOK[e * EROWS + slot] = row; SELG[e * EROWS + slot] = __uint_as_float(key[i]); }
                slots[i] = slot;
                pg += gt ? 1u : 0u; pe += eq ? 1u : 0u;
            }
#pragma unroll
            for (int i4 = 0; i4 < 4; ++i4) *(u32x4*)(TS + pbase + tid * 16 + i4 * 4) = (u32x4){(unsigned)slots[4 * i4], (unsigned)slots[4 * i4 + 1], (unsigned)slots[4 * i4 + 2], (unsigned)slots[4 * i4 + 3]};
        }
        __syncthreads();
    }
}

template <int LAYER> DI void phase_gather(const Args& a, int lane, int gw, int NGW) {
    constexpr int ER = (LAYER >= 2) ? 2048 : 2304, VALID = (LAYER >= 2) ? 2048 : 2112;
    const int* SELTOK = (const int*)(a.ws + WS_SELTOK); const bf16_t* H = (const bf16_t*)(a.ws + WS_H); bf16_t* XS = (bf16_t*)(a.ws + WS_BUF1);
    for (int sr = gw; sr < 16 * ER; sr += NGW) {
        const int e = sr / ER, s = sr - e * ER;
        u32x4* dst = (u32x4*)(XS + ((size_t)e * EROWS + s) * 1024) + lane;
        if (s < VALID) { const int row = __builtin_amdgcn_readfirstlane(SELTOK[e * EROWS + s]); const u32x4* src = (const u32x4*)(H + (size_t)row * 1024) + lane; dst[0] = src[0]; dst[64] = src[64]; }
        else { dst[0] = (u32x4){0u, 0u, 0u, 0u}; dst[64] = (u32x4){0u, 0u, 0u, 0u}; }
    }
}

template <int J, int NCHUNK> DI void phase_sg_vnt(const Args& a, LAS unsigned char* lds, int tid, int lane, int wave) {
    const bf16_t* ZZ = (const bf16_t*)(a.ws + WS_BUF1); bf16_t* VNT = (bf16_t*)(a.ws + WS_BUF2);
    const float* VSQ = (const float*)(a.ws + WS_VSQ);
    const float* gain = a.in[I_SGVG] + J * 2048;
    LAS float* rsq = (LAS float*)lds;
    LAS bf16_t* T = (LAS bf16_t*)(lds + 512);
    constexpr int NLAT = TX / 64, NCTXU = (NCHUNK * 2 - NLAT) * 8;
    for (int unit = blockIdx.x; unit < NLAT + NCTXU; unit += gridDim.x) {
        const bool lat = unit < NLAT;
        const int hc = lat ? unit : NLAT + ((unit - NLAT) >> 3);
        const int chunk = hc >> 1, q0 = (hc & 1) * 64;
        const int g0 = lat ? 0 : ((unit - NLAT) & 7), g1 = lat ? 8 : g0 + 1;
        if (lat) {
            const f32x4 p = *(const f32x4*)(VSQ + ((size_t)chunk * 128 + q0 + (tid >> 3)) * 32 + (tid & 7) * 4);
            float ss = (p[0] + p[1]) + (p[2] + p[3]);
            ss += dppf<DPP_XOR1>(ss); ss += dppf<DPP_XOR2>(ss); ss += dppf<0x141>(ss);
            if ((tid & 7) == 0) rsq[tid >> 3] = 1.0f / sqrtf(ss * (1.0f / 2048.0f) + EPS);
        } else {
#pragma unroll
            for (int qb = 0; qb < 2; ++qb) {
                u32x4 w[4][4];
#pragma unroll
                for (int qi = 0; qi < 4; ++qi) { const u32x4* vp = (const u32x4*)(ZZ + ((size_t)chunk * 128 + q0 + wave * 8 + qb * 4 + qi) * 4096 + 2048) + lane;
#pragma unroll
                    for (int j = 0; j < 4; ++j) w[qi][j] = vp[64 * j]; }
#pragma unroll
                for (int qi = 0; qi < 4; ++qi) { float ss = 0.f;
#pragma unroll
                    for (int j = 0; j < 4; ++j) { const u32x4 x = w[qi][j]; const float x0 = bflo(x.x), x1 = bfhi(x.x), x2 = bflo(x.y), x3 = bfhi(x.y), x4 = bflo(x.z), x5 = bfhi(x.z), x6 = bflo(x.w), x7 = bfhi(x.w);
                        ss += (x0 * x0 + x1 * x1) + (x2 * x2 + x3 * x3) + (x4 * x4 + x5 * x5) + (x6 * x6 + x7 * x7); }
                    ss = wave_sum(ss);
                    if (lane == 0) rsq[wave * 8 + qb * 4 + qi] = 1.0f / sqrtf(ss * (1.0f / 2048.0f) + EPS); }
            }
        }
        const int qa = tid >> 5, c8 = (tid & 31) * 8, ng = lat ? 8 : 1;
        u32x4 buf[8][4];
#pragma unroll
        for (int gi = 0; gi < 8; ++gi) if (gi < ng) {
#pragma unroll
            for (int k = 0; k < 4; ++k) buf[gi][k] = *(const u32x4*)(ZZ + ((size_t)chunk * 128 + q0 + qa + 16 * k) * 4096 + 2048 + (g0 + gi) * 256 + c8); }
        __syncthreads();
#pragma unroll
        for (int gi = 0; gi < 8; ++gi) if (gi < ng) {
            const int g = g0 + gi;
            const f32x4 g0v = *(const f32x4*)(gain + g * 256 + c8), g1v = *(const f32x4*)(gain + g * 256 + c8 + 4);
#pragma unroll
            for (int k = 0; k < 4; ++k) { const int q = qa + 16 * k; const u32x4 w = buf[gi][k]; const float r = rsq[q];
                LAS unsigned* tp = (LAS unsigned*)(T + q * 258 + c8);
                tp[0] = pkbf(bflo(w.x) * r * g0v[0], bfhi(w.x) * r * g0v[1]); tp[1] = pkbf(bflo(w.y) * r * g0v[2], bfhi(w.y) * r * g0v[3]);
                tp[2] = pkbf(bflo(w.z) * r * g1v[0], bfhi(w.z) * r * g1v[1]); tp[3] = pkbf(bflo(w.w) * r * g1v[2], bfhi(w.w) * r * g1v[3]); }
            __syncthreads();
#pragma unroll
            for (int i4 = 0; i4 < 4; ++i4) { const int it = tid + NTHR * i4, q8 = it & 7, c = it >> 3;
                const LAS bf16_t* tp = T + (q8 * 8) * 258 + c;
                u32x4 o; o.x = (unsigned)tp[0] | ((unsigned)tp[258] << 16); o.y = (unsigned)tp[2 * 258] | ((unsigned)tp[3 * 258] << 16);
                o.z = (unsigned)tp[4 * 258] | ((unsigned)tp[5 * 258] << 16); o.w = (unsigned)tp[6 * 258] | ((unsigned)tp[7 * 258] << 16);
                *(u32x4*)(VNT + ((size_t)(chunk * 4 + (g >> 1)) * 256 + c) * 256 + (g & 1) * 128 + q0 + q8 * 8) = o; }
            __syncthreads();
        }
    }
}

DI void phase_hy_shortconv(const Args& a, LAS unsigned char* lds, int tid) {
    const bf16_t* UP = (const bf16_t*)(a.ws + WS_BUF1); bf16_t* UT = (bf16_t*)(a.ws + WS_BUF2); bf16_t* UTC = UT + (size_t)3 * 2 * 1024 * UTS;
    const float* cw = a.in[I_HYCW]; const float* cb = a.in[I_HYCB];
    LAS bf16_t* T = (LAS bf16_t*)lds;
    u32x4 w[3], nw[3]; f32x4 fw[2], nfw[2];
#define SC_LOAD(unit_, dw, dfw) do { const int tblk_ = (unit_) / 24, chb_ = (unit_) % 24; const bool isx_ = tblk_ < 256; \
        _Pragma("unroll") for (int i = 0; i < 2; ++i) { const int chg_ = chb_ * 128 + (tid >> 3) + 64 * i; dfw[i] = (f32x4){cw[chg_], cw[3072 + chg_], cw[2 * 3072 + chg_], cb[chg_]}; } \
        const int b_ = isx_ ? tblk_ >> 7 : (tblk_ - 256) >> 2, tb0_ = isx_ ? (tblk_ & 127) * 64 : ((tblk_ - 256) & 3) * 64, n_ = isx_ ? 8192 : 256; \
        const size_t rowbase_ = isx_ ? (size_t)b_ * 8192 : (size_t)TX + b_ * 256; \
        _Pragma("unroll") for (int k = 0; k < 3; ++k) { const int it = tid + NTHR * k; const int rr = it >> 4, c8 = (it & 15) * 8; const int t = tb0_ - 1 + rr; dw[k] = (u32x4){0u, 0u, 0u, 0u}; \
            if (it < 66 * 16 && t >= 0 && t < n_) dw[k] = *(const u32x4*)(UP + (rowbase_ + t) * 3072 + chb_ * 128 + c8); } } while (0)
    if ((int)blockIdx.x < 264 * 24) SC_LOAD((int)blockIdx.x, w, fw);
    for (int unit = blockIdx.x; unit < 264 * 24; unit += gridDim.x) {
        const int tblk = unit / 24, chb = unit % 24;
        const bool isx = tblk < 256;
        const int b = isx ? tblk >> 7 : (tblk - 256) >> 2, tb0 = isx ? (tblk & 127) * 64 : ((tblk - 256) & 3) * 64;
        if (unit + (int)gridDim.x < 264 * 24) SC_LOAD(unit + (int)gridDim.x, nw, nfw);
#pragma unroll
        for (int k = 0; k < 3; ++k) { const int it = tid + NTHR * k; const int rr = it >> 4, c8 = (it & 15) * 8;
            if (it < 66 * 16) { LAS unsigned* tp = (LAS unsigned*)(T + rr * 130 + c8); tp[0] = w[k].x; tp[1] = w[k].y; tp[2] = w[k].z; tp[3] = w[k].w; } }
        __syncthreads();
#pragma unroll
        for (int i2 = 0; i2 < 2; ++i2) { const int t8 = tid & 7, ch = (tid >> 3) + 64 * i2; const int chg = chb * 128 + ch;
            const float w0 = fw[i2][0], w1 = fw[i2][1], w2 = fw[i2][2], bb = fw[i2][3];
            float in[10];
#pragma unroll
            for (int k = 0; k < 10; ++k) in[k] = bf1(T[(t8 * 8 + k) * 130 + ch]);
            float o[8];
#pragma unroll
            for (int j = 0; j < 8; ++j) o[j] = w0 * in[j] + w1 * in[j + 1] + w2 * in[j + 2] + bb;
            u32x4 ov; ov.x = pkbf(o[0], o[1]); ov.y = pkbf(o[2], o[3]); ov.z = pkbf(o[4], o[5]); ov.w = pkbf(o[6], o[7]);
            const int part = chg >> 10, c = chg & 1023;
            if (isx) *(u32x4*)(UT + ((size_t)(part * 2 + b) * 1024 + c) * UTS + tb0 + t8 * 8) = ov;
            else *(u32x4*)(UTC + ((size_t)(part * 2 + b) * 1024 + c) * 256 + tb0 + t8 * 8) = ov; }
        __syncthreads();
#pragma unroll
        for (int k = 0; k < 3; ++k) w[k] = nw[k];
        fw[0] = nfw[0]; fw[1] = nfw[1];
    }
#undef SC_LOAD
}
DI void phase_hy_transpose(const Args& a, LAS unsigned char* lds, int lane, int wave, int gw, int NGW) {
    const bf16_t* Z2 = (const bf16_t*)(a.ws + WS_BUF3); const bf16_t* Z2C = Z2 + (size_t)2 * 1024 * UTS; bf16_t* ZA = (bf16_t*)(a.ws + WS_H);
    LAS bf16_t* T = (LAS bf16_t*)(lds + wave * 8704);
    const int l8 = lane >> 3, p8 = lane & 7;
    u32x4 w[8], nw[8];
#define TR_LOAD(unit_, dw) do { const bool isx_ = (unit_) < 4096; const int u_ = isx_ ? (unit_) : (unit_) - 4096; const int ntb_ = isx_ ? 128 : 4; const int b_ = u_ / (16 * ntb_), cb_ = (u_ / ntb_) & 15, tb_ = u_ % ntb_; \
        const size_t rs_ = isx_ ? (size_t)UTS : (size_t)256; const bf16_t* base_ = (isx_ ? Z2 : Z2C) + ((size_t)b_ * 1024 + cb_ * 64 + l8) * rs_ + tb_ * 64 + p8 * 8; \
        _Pragma("unroll") for (int k = 0; k < 8; ++k) dw[k] = *(const u32x4*)(base_ + (size_t)(8 * k) * rs_); } while (0)
    if (gw < 4096 + 128) TR_LOAD(gw, w);
    for (int unit = gw; unit < 4096 + 128; unit += NGW) {
        const bool isx = unit < 4096; const int u = isx ? unit : unit - 4096;
        const int ntb = isx ? 128 : 4; const int b = u / (16 * ntb), cb = (u / ntb) & 15, tb = u % ntb;
        if (unit + NGW < 4096 + 128) TR_LOAD(unit + NGW, nw);
#pragma unroll
        for (int k = 0; k < 8; ++k) { LAS unsigned* tp = (LAS unsigned*)(T + (8 * k + l8) * 66 + p8 * 8); tp[0] = w[k].x; tp[1] = w[k].y; tp[2] = w[k].z; tp[3] = w[k].w; }
        LDS_WAIT(); __builtin_amdgcn_wave_barrier();
        bf16_t* dst = ZA + ((isx ? (size_t)b * 8192 : (size_t)TX + b * 256) + tb * 64 + l8) * 1024 + cb * 64 + p8 * 8;
#pragma unroll
        for (int k = 0; k < 8; ++k) { const LAS bf16_t* tp = T + (p8 * 8) * 66 + 8 * k + l8; u32x4 o;
            o.x = (unsigned)tp[0] | ((unsigned)tp[66] << 16); o.y = (unsigned)tp[2 * 66] | ((unsigned)tp[3 * 66] << 16);
            o.z = (unsigned)tp[4 * 66] | ((unsigned)tp[5 * 66] << 16); o.w = (unsigned)tp[6 * 66] | ((unsigned)tp[7 * 66] << 16);
            *(u32x4*)(dst + (size_t)(8 * k) * 1024) = o; }
        LDS_WAIT(); __builtin_amdgcn_wave_barrier();
#pragma unroll
        for (int k = 0; k < 8; ++k) w[k] = nw[k];
    }
#undef TR_LOAD
}

DI void phase_da_prep(const Args& a, LAS unsigned char* lds, int tid) {
    const bf16_t* QKV = (const bf16_t*)(a.ws + WS_BUF1);
    bf16_t* Qn = (bf16_t*)(a.ws + WS_BUF2); bf16_t* Kn = Qn + (size_t)2 * 8 * 2 * 8192 * 64; bf16_t* VT = Kn + (size_t)2 * 8 * 2 * NKEY * 64;
    const float* rope = (const float*)(a.ws + WS_ROPE);
    LAS bf16_t* T = (LAS bf16_t*)lds;
    const int vid = tid >> 1, half = tid & 1, rl = vid & 63, which = vid >> 6; const int isk = which >> 1, m = which & 1;
    u32x4 wv[2], wq[4], nv[2], nq[4]; f32x4 rp4[8], nrp4[8];
    f32x4 gn4[8];
    { const f32x4* gp = (const f32x4*)((isk ? a.in[I_DAKG] : a.in[I_DAQG]) + half * 32);
#pragma unroll
      for (int k = 0; k < 8; ++k) gn4[k] = gp[k]; }
#define DP_LOAD(unit_, dv, dq, drp) do { const int rb_ = (unit_) >> 3, h_ = (unit_) & 7, r0_ = rb_ * 64; \
        if (r0_ < TX) { const int t_ = (r0_ + rl) & 8191; const f32x4* rq_ = (const f32x4*)(rope + (half == 0 ? (t_ >> 6) : (t_ & 63)) * 32); _Pragma("unroll") for (int k = 0; k < 8; ++k) drp[k] = rq_[k]; } \
        _Pragma("unroll") for (int k = 0; k < 2; ++k) { const int it = tid + NTHR * k; const int rl_ = it >> 4, c8 = (it & 15) * 8; dv[k] = *(const u32x4*)(QKV + (size_t)(r0_ + rl_) * 3072 + 2048 + h_ * 128 + c8); } \
        if (isk || r0_ < TX) { const u32x4* sp = (const u32x4*)(QKV + (size_t)(r0_ + rl) * 3072 + isk * 1024 + h_ * 128 + m * 64 + half * 32); _Pragma("unroll") for (int k = 0; k < 4; ++k) dq[k] = sp[k]; } } while (0)
    if ((int)blockIdx.x < 264 * 8) DP_LOAD((int)blockIdx.x, wv, wq, rp4);
    for (int unit = blockIdx.x; unit < 264 * 8; unit += gridDim.x) {
        const int rb = unit >> 3, h = unit & 7; const int r0 = rb * 64;
        const bool isx = r0 < TX;
        const int b = isx ? r0 >> 13 : (r0 - TX) >> 8;
        const int key0 = isx ? 256 + (r0 & 8191) : (r0 - TX) & 255;
        if (unit + (int)gridDim.x < 264 * 8) DP_LOAD(unit + (int)gridDim.x, nv, nq, nrp4);
#pragma unroll
        for (int k = 0; k < 2; ++k) { const int it = tid + NTHR * k; const int rl_ = it >> 4, c8 = (it & 15) * 8; LAS unsigned* tp = (LAS unsigned*)(T + rl_ * 130 + c8); tp[0] = wv[k].x; tp[1] = wv[k].y; tp[2] = wv[k].z; tp[3] = wv[k].w; }
        { const int r = r0 + rl;
          if (isk || isx) {
            float x[32];
#pragma unroll
            for (int k = 0; k < 4; ++k) { const u32x4 w = wq[k]; x[8 * k] = bflo(w.x); x[8 * k + 1] = bfhi(w.x); x[8 * k + 2] = bflo(w.y); x[8 * k + 3] = bfhi(w.y); x[8 * k + 4] = bflo(w.z); x[8 * k + 5] = bfhi(w.z); x[8 * k + 6] = bflo(w.w); x[8 * k + 7] = bfhi(w.w); }
            float ss = 0.f;
#pragma unroll
            for (int k = 0; k < 32; ++k) ss += x[k] * x[k];
            ss += dppf<DPP_XOR1>(ss);
            const float rinv = 1.0f / sqrtf(ss * (1.0f / 64.0f) + EPS);
#pragma unroll
            for (int k = 0; k < 32; ++k) x[k] = x[k] * rinv * gn4[k >> 2][k & 3];
            if (isx) {
#pragma unroll
                for (int f = 0; f < 16; ++f) { const float cs = rp4[f >> 1][2 * (f & 1)], sn = rp4[f >> 1][2 * (f & 1) + 1]; const float x1 = x[f], x2 = x[16 + f]; x[f] = x1 * cs - x2 * sn; x[16 + f] = x2 * cs + x1 * sn; } }
            if (!isk) {
#pragma unroll
                for (int k = 0; k < 32; ++k) x[k] *= QSCALE; }
            LAS u32x4* sp = (LAS u32x4*)(lds + 16640 + which * 8192 + rl * 128 + half * 64);
#pragma unroll
            for (int k = 0; k < 4; ++k) { u32x4 o; o.x = pkbf(x[8 * k], x[8 * k + 1]); o.y = pkbf(x[8 * k + 2], x[8 * k + 3]); o.z = pkbf(x[8 * k + 4], x[8 * k + 5]); o.w = pkbf(x[8 * k + 6], x[8 * k + 7]); sp[k ^ (rl & 3)] = o; }
          } }
        __syncthreads();
#pragma unroll
        for (int j = 0; j < 4; ++j) { const int xx = tid + NTHR * j, wh = xx >> 9, xr = xx & 511, rr = xr >> 3, pp = xr & 7;
            if (wh >= 2 || isx) {
                const u32x4 o = *(const LAS u32x4*)(lds + 16640 + wh * 8192 + rr * 128 + (pp >> 2) * 64 + ((pp & 3) ^ (rr & 3)) * 16);
                bf16_t* dp = (wh >> 1) ? Kn + ((size_t)((b * 8 + h) * 2 + (wh & 1)) * NKEY + key0) * 64 : Qn + ((size_t)((b * 8 + h) * 2 + (wh & 1)) * 8192 + (r0 & 8191)) * 64;
                ((u32x4*)dp)[xr] = o; } }
        for (int it = tid; it < 1024; it += NTHR) { const int e = it >> 3, j8 = it & 7; const int kb = 16 * (j8 >> 1) + 4 * (j8 & 1);
            const LAS bf16_t* tp = T + e;
            u32x4 o; o.x = (unsigned)tp[(kb + 0) * 130] | ((unsigned)tp[(kb + 1) * 130] << 16); o.y = (unsigned)tp[(kb + 2) * 130] | ((unsigned)tp[(kb + 3) * 130] << 16);
            o.z = (unsigned)tp[(kb + 8) * 130] | ((unsigned)tp[(kb + 9) * 130] << 16); o.w = (unsigned)tp[(kb + 10) * 130] | ((unsigned)tp[(kb + 11) * 130] << 16);
            *(u32x4*)(VT + ((size_t)(b * 8 + h) * 128 + e) * NKEY + key0 + j8 * 8) = o; }
        __syncthreads();
#pragma unroll
        for (int k = 0; k < 2; ++k) wv[k] = nv[k];
#pragma unroll
        for (int k = 0; k < 4; ++k) wq[k] = nq[k];
#pragma unroll
        for (int k = 0; k < 8; ++k) rp4[k] = nrp4[k];
    }
#undef DP_LOAD
}
DI bf16x8 pack8(const f32x16& x, int s) {
    u32x4 p;
    if (s == 0) { p.x = pkbf(x[0], x[1]); p.y = pkbf(x[2], x[3]); p.z = pkbf(x[4], x[5]); p.w = pkbf(x[6], x[7]); }
    else { p.x = pkbf(x[8], x[9]); p.y = pkbf(x[10], x[11]); p.z = pkbf(x[12], x[13]); p.w = pkbf(x[14], x[15]); }
    return __builtin_bit_cast(bf16x8, p);
}
constexpr int AT_STAGE = 32768;
DI void attn_issue_tile(LAS unsigned char* lds, int stage, const bf16_t* K0t, const bf16_t* K1t, const bf16_t* VTt, unsigned koff, unsigned voff0, unsigned voff1, int wave) {
    LAS unsigned char* sb = lds + stage * AT_STAGE;
    __builtin_amdgcn_global_load_lds((const unsigned*)((const char*)K0t + koff), (LAS unsigned*)(sb + wave * 1024), 16, 0, 0);
    __builtin_amdgcn_global_load_lds((const unsigned*)((const char*)K1t + koff), (LAS unsigned*)(sb + 8192 + wave * 1024), 16, 0, 0);
    __builtin_amdgcn_global_load_lds((const unsigned*)((const char*)VTt + voff0), (LAS unsigned*)(sb + 16384 + wave * 1024), 16, 0, 0);
    __builtin_amdgcn_global_load_lds((const unsigned*)((const char*)(VTt + (size_t)64 * NKEY) + voff1), (LAS unsigned*)(sb + 16384 + 8192 + wave * 1024), 16, 0, 0);
}
DI void phase_attn(const Args& a, LAS unsigned char* lds, int tid, int lane, int wave) {
    const bf16_t* Qn = (const bf16_t*)(a.ws + WS_BUF2); const bf16_t* Kn = Qn + (size_t)2 * 8 * 2 * 8192 * 64; const bf16_t* VT = Kn + (size_t)2 * 8 * 2 * NKEY * 64;
    bf16_t* AO = (bf16_t*)(a.ws + WS_BUF3);
    const float lam_init = 0.8f - 0.6f * expf(-0.3f * 2.0f);
    const int G = gridDim.x, blk = blockIdx.x;
    const int ql = lane & 31, kg = lane >> 5;
    const int pr = wave >> 1, m = wave & 1;
    for (int i = 0;; ++i) {
        int bh, qb;
        if (G == 256) { if (i >= 2) break; bh = (blk & 7) + 8 * i; qb = blk >> 3; }
        else { const int L = i * G + blk; if (L >= 512) break; bh = L >> 5; qb = L & 31; }
        const int b = bh >> 3, h = bh & 7;
        const int t0 = qb * 256 + pr * 64;
        const bf16_t* K0g = Kn + (size_t)(bh * 2 + 0) * NKEY * 64; const bf16_t* K1g = Kn + (size_t)(bh * 2 + 1) * NKEY * 64; const bf16_t* VTg = VT + (size_t)bh * 128 * NKEY;
        unsigned koff, voff0, voff1;
        { const int key = tid >> 3, cl = (tid & 7) ^ ((key >> 1) & 7); koff = (unsigned)(key * 64 + cl * 8) * 2u;
          const int e0 = tid >> 3, c0 = (tid & 7) ^ ((e0 >> 1) & 7); voff0 = (unsigned)(e0 * NKEY + c0 * 8) * 2u;
          voff1 = voff0; }
        __syncthreads();
        attn_issue_tile(lds, 0, K0g, K1g, VTg, koff, voff0, voff1, wave);
        bf16x8 qf[4];
        LAS unsigned char* qlds = lds + 3 * AT_STAGE + wave * 4096;
        { int qlv = ql, kgv = kg; asm volatile("" : "+v"(qlv), "+v"(kgv));
          const unsigned qoff = (unsigned)(qlv * 64 + kgv * 8);
          const bf16_t* qbase = Qn + ((size_t)(bh * 2 + m) * 8192 + t0) * 64;
#pragma unroll
          for (int ks = 0; ks < 4; ++ks) qf[ks] = *(const bf16x8*)(qbase + (qoff + ks * 16));
#pragma unroll
          for (int ks = 0; ks < 4; ++ks) { const bf16x8 qb_ = *(const bf16x8*)(qbase + (qoff + 2048 + ks * 16)); *(LAS bf16x8*)(qlds + ks * 1024 + (qlv + 32 * kgv) * 16) = qb_; } }
        f32x16 O[2][4];
#pragma unroll
        for (int g2 = 0; g2 < 2; ++g2)
#pragma unroll
            for (int et = 0; et < 4; ++et)
#pragma unroll
                for (int r = 0; r < 16; ++r) O[g2][et][r] = 0.f;
        float lsum[2] = {0.f, 0.f};
        attn_issue_tile(lds, 1, K0g + 4096, K1g + 4096, VTg + 64, koff, voff0, voff1, wave);
        asm volatile("s_waitcnt vmcnt(4)" ::: "memory"); __builtin_amdgcn_s_barrier(); asm volatile("" ::: "memory");
        int st = 0, st2 = 2;
        for (int kt = 0; kt < NKEY / 64; ++kt) {
            int lanev = lane; asm volatile("" : "+v"(lanev));
            const int tidv = wave * 64 + lanev, qlv = lanev & 31, kgv = lanev >> 5;
            unsigned koff, voff0, voff1;
            { const int key = tidv >> 3, cl = (tidv & 7) ^ ((key >> 1) & 7); koff = (unsigned)(key * 64 + cl * 8) * 2u; voff0 = (unsigned)(key * NKEY + cl * 8) * 2u; voff1 = voff0; }
            unsigned kro[4];
            { const int ksw = (qlv >> 1) & 7;
#pragma unroll
              for (int ks = 0; ks < 4; ++ks) kro[ks] = (unsigned)(qlv * 128 + (((2 * ks + kgv) ^ ksw) << 4)); }
            if (kt + 2 < NKEY / 64) attn_issue_tile(lds, st2, K0g + (size_t)(kt + 2) * 4096, K1g + (size_t)(kt + 2) * 4096, VTg + (size_t)(kt + 2) * 64, koff, voff0, voff1, wave);
            const LAS unsigned char* sb = lds + st * AT_STAGE + m * 8192;
            const LAS unsigned char* sv = lds + st * AT_STAGE + 16384;
#pragma unroll
            for (int k2 = 0; k2 < 2; ++k2) {
                bf16x8 kf[4];
#pragma unroll
                for (int ks = 0; ks < 4; ++ks) kf[ks] = *(const LAS bf16x8*)(sb + kro[ks] + k2 * 4096);
                f32x16 SA, SB;
#pragma unroll
                for (int r = 0; r < 16; ++r) { SA[r] = 0.f; SB[r] = 0.f; }
#pragma unroll
                for (int ks = 0; ks < 4; ++ks) { const bf16x8 qb_ = *(const LAS bf16x8*)(qlds + ks * 1024 + lanev * 16); SA = MFMA32(kf[ks], qf[ks], SA); SB = MFMA32(kf[ks], qb_, SB); }
                __builtin_amdgcn_sched_barrier(0);
                { float ps = 0.f;
#pragma unroll
                  for (int r = 0; r < 16; ++r) { SA[r] = __builtin_amdgcn_exp2f(SA[r]); ps += SA[r]; }
                  lsum[0] += ps; }
                { float ps = 0.f;
#pragma unroll
                  for (int r = 0; r < 16; ++r) { SB[r] = __builtin_amdgcn_exp2f(SB[r]); ps += SB[r]; }
                  lsum[1] += ps; }
                const bf16x8 pA0 = pack8(SA, 0), pA1 = pack8(SA, 1), pB0 = pack8(SB, 0), pB1 = pack8(SB, 1);
#pragma unroll
                for (int s2 = 0; s2 < 2; ++s2) {
#pragma unroll
                    for (int eh = 0; eh < 2; ++eh) {
                        const bf16x8 va_ = *(const LAS bf16x8*)(sv + kro[2 * k2 + s2] + (2 * eh) * 4096), vb_ = *(const LAS bf16x8*)(sv + kro[2 * k2 + s2] + (2 * eh + 1) * 4096);
                        const bf16x8 pa_ = s2 ? pA1 : pA0, pb_ = s2 ? pB1 : pB0;
                        O[0][2 * eh] = MFMA32(va_, pa_, O[0][2 * eh]); O[0][2 * eh + 1] = MFMA32(vb_, pa_, O[0][2 * eh + 1]);
                        O[1][2 * eh] = MFMA32(va_, pb_, O[1][2 * eh]); O[1][2 * eh + 1] = MFMA32(vb_, pb_, O[1][2 * eh + 1]); } }
                __builtin_amdgcn_sched_barrier(0);
            }
            if (kt + 2 < NKEY / 64) asm volatile("s_waitcnt vmcnt(4) lgkmcnt(0)" ::: "memory"); else asm volatile("s_waitcnt vmcnt(0) lgkmcnt(0)" ::: "memory");
            __builtin_amdgcn_s_barrier(); asm volatile("" ::: "memory");
            st = (st == 2) ? 0 : st + 1; st2 = (st2 == 2) ? 0 : st2 + 1;
        }
        float lam;
        { int lv = lane; asm volatile("" : "+v"(lv)); const float q1 = a.in[I_DALQ1][lv] * a.in[I_DALK1][lv], q2 = a.in[I_DALQ2][lv] * a.in[I_DALK2][lv];
          lam = expf(wave_sum(q1)) - expf(wave_sum(q2)) + lam_init; }
        LAS float* xb = (LAS float*)lds + pr * 8192 + lane;
#pragma unroll
        for (int g2 = 0; g2 < 2; ++g2) {
            const float ltot = lsum[g2] + __shfl_xor(lsum[g2], 32);
            if (m == 1) { const float i1 = lam / ltot;
#pragma unroll
                for (int et = 0; et < 4; ++et)
#pragma unroll
                    for (int r = 0; r < 16; ++r) xb[(g2 * 64 + et * 16 + r) * 64] = O[g2][et][r] * i1; }
            else lsum[g2] = 1.0f / ltot;
        }
        __syncthreads();
        if (m == 0) {
            int ql2 = ql, kg2 = kg; asm volatile("" : "+v"(ql2), "+v"(kg2));
            const float* sg = a.in[I_DASUB];
#pragma unroll
            for (int g2 = 0; g2 < 2; ++g2) {
                const float i0 = lsum[g2];
                float ss = 0.f;
#pragma unroll
                for (int et = 0; et < 4; ++et)
#pragma unroll
                    for (int r = 0; r < 16; ++r) { const float o = O[g2][et][r] * i0 - xb[(g2 * 64 + et * 16 + r) * 64]; O[g2][et][r] = o; ss += o * o; }
                ss += __shfl_xor(ss, 32);
                const float rn = (1.0f / sqrtf(ss * (1.0f / 128.0f) + EPS)) * (1.0f - lam_init);
                bf16_t* obase = AO + ((size_t)b * 8192 + t0 + g2 * 32) * 1024 + h * 128; const unsigned ooff = (unsigned)(ql2 * 1024 + 4 * kg2);
#pragma unroll
                for (int et = 0; et < 4; ++et)
#pragma unroll
                    for (int g4 = 0; g4 < 4; ++g4) { const int e0 = et * 32 + 8 * g4; const f32x4 gv = *(const f32x4*)(sg + (unsigned)(e0 + 4 * kg2));
                        u32x2 w; w.x = pkbf(O[g2][et][4 * g4] * rn * gv[0], O[g2][et][4 * g4 + 1] * rn * gv[1]); w.y = pkbf(O[g2][et][4 * g4 + 2] * rn * gv[2], O[g2][et][4 * g4 + 3] * rn * gv[3]);
                        *(u32x2*)(obase + (ooff + e0)) = w; }
            }
        }
    }
}
constexpr int CV_ZB = 25856;
constexpr int CV_FB = RRS * 2;
constexpr int CV_FO = 2 * CV_ZB;
DI int cv_pad(int y) { return y + ((y >> 7) << 3); }
DI void cv_filter_dma(LAS unsigned char* dst, const bf16_t* src, int lane, int wave) {
#pragma unroll
    for (int j = 0; j < 5; ++j) { const int i = wave + 8 * j; if (i < 33) __builtin_amdgcn_global_load_lds((const unsigned*)((const char*)src + i * 1024 + lane * 16), (LAS unsigned*)(dst + i * 1024), 16, 0, 0); }
}
DI void phase_hy_conv(const Args& a, LAS unsigned char* lds, int tid, int lane, int wave, int gw, int NGW) {
    const bf16_t* UT = (const bf16_t*)(a.ws + WS_BUF2); const bf16_t* UTC = UT + (size_t)3 * 2 * 1024 * UTS;
    bf16_t* Z2 = (bf16_t*)(a.ws + WS_BUF3); bf16_t* Z2C = Z2 + (size_t)2 * 1024 * UTS;
    const float* FSQP = (const float*)(a.ws + WS_FSQP);
    const bf16_t* RR = (const bf16_t*)(a.ws + WS_RR);
    const float* skip = a.in[I_HYSKIP];
    const int nt = wave & 3, kh = wave >> 2;
    const int ql = lane & 31, kg = lane >> 5, bcol = ql >> 4, ii = ql & 15, i0 = 16 * nt;
    const int par = ql & 1;
    LAS unsigned char* const fA = lds + CV_FO; LAS unsigned char* const fB = lds + CV_FO + CV_FB + 64;
    LAS unsigned* const CVL = (LAS unsigned*)(lds + 119808);
    float cv[32]; CvtTile ctile; ctile.src = nullptr; ctile.dst = nullptr; ctile.K = 0; ctile.N = 0; ctile.mode = 0;
    int gi = 0, cstage = 0, cslot = 0;
    __syncthreads();
    if ((int)blockIdx.x < 1024) cv_filter_dma(fA, RR + (size_t)blockIdx.x * RRS, lane, wave);
    for (int c = blockIdx.x; c < 1024; c += gridDim.x) {
        { u32x4 w[2][3];
#pragma unroll
          for (int b = 0; b < 2; ++b) { const bf16_t* vsrc = UT + ((size_t)(0 * 2 + b) * 1024 + c) * UTS;
#pragma unroll
              for (int k = 0; k < 3; ++k) { const int y = (tid + NTHR * k) * 8; w[b][k] = (u32x4){0u, 0u, 0u, 0u}; if (y >= 1920 && y < 1920 + 8192) w[b][k] = *(const u32x4*)(vsrc + (y - 1920)); } }
#pragma unroll
          for (int b = 0; b < 2; ++b)
#pragma unroll
              for (int k = 0; k < 3; ++k) { const int y = (tid + NTHR * k) * 8; if (y < 12160) *(LAS u32x4*)(lds + b * CV_ZB + cv_pad(y) * 2) = w[b][k]; } }
        float scl0, scl1;
        { float s0 = 0.f, s1 = 0.f;
          if (lane < FQ_LSEG) { s0 = FSQP[(size_t)lane * 4096 + c] + FSQP[(size_t)lane * 4096 + 1024 + c]; s1 = FSQP[(size_t)lane * 4096 + 2048 + c] + FSQP[(size_t)lane * 4096 + 3072 + c]; }
          scl0 = 1.0f / sqrtf(wave_sum(s0) + EPS); scl1 = 1.0f / sqrtf(wave_sum(s1) + EPS); }
        const LAS unsigned char* zrd = lds + bcol * CV_ZB;
        const int ybase = 128 * ii + 8 * kg;
#pragma unroll 1
        for (int o = 0; o < 2; ++o) {
            VM_WAIT(); __syncthreads();
            for (int d = tid; d < RRS / 2 - 1; d += NTHR) { const LAS unsigned* sa = (const LAS unsigned*)fA + d; ((LAS unsigned*)fB)[d] = __builtin_amdgcn_alignbit(sa[1], sa[0], 16); }
            __syncthreads();
            const LAS unsigned char* rp = (par ? fB : fA) + 2 * (6272 - 128 * i0 + 8 * kg - ql - par);
            f32x16 acc[4];
#pragma unroll
            for (int mt = 0; mt < 4; ++mt)
#pragma unroll
                for (int r = 0; r < 16; ++r) acc[mt][r] = 0.f;
            bf16x8 F[8];
            const int ks0 = kh * 320;
#define CV_RAW(d_, ks_) do { const LAS unsigned* q_ = (const LAS unsigned*)(rp + 32 * (ks_)); d_[0] = q_[0]; d_[1] = q_[1]; d_[2] = q_[2]; d_[3] = q_[3]; } while (0)
#define CV_MK(dst, d_) do { u32x4 f_; f_.x = d_[0]; f_.y = d_[1]; f_.z = d_[2]; f_.w = d_[3]; dst = __builtin_bit_cast(bf16x8, f_); } while (0)
#pragma unroll
            for (int d = -6; d < 0; ++d) { unsigned t_[4]; CV_RAW(t_, ks0 + d); CV_MK(F[d & 7], t_); }
            const LAS unsigned char* zq = zrd + 272 * (ii + (ks0 >> 3)) + 16 * kg;
            unsigned ra[4]; bf16x8 Bf;
            CV_RAW(ra, ks0); Bf = *(const LAS bf16x8*)(zq);
#pragma unroll 1
            for (int it = 0; it < 40; ++it) {
#pragma unroll
                for (int j = 0; j < 8; ++j) {
                    const int ks = ks0 + it * 8 + j;
                    CV_MK(F[j], ra);
                    const bf16x8 Bc = Bf;
                    const bool lastst = (it == 39 && j == 7);
                    CV_RAW(ra, lastst ? ks : ks + 1);
                    Bf = *(const LAS bf16x8*)(zq + (lastst ? 32 * j : (j == 7 ? 272 : 32 * (j + 1))));
                    acc[0] = MFMA32(F[j], Bc, acc[0]);
                    acc[1] = MFMA32(F[(j + 6) & 7], Bc, acc[1]);
                    acc[2] = MFMA32(F[(j + 4) & 7], Bc, acc[2]);
                    acc[3] = MFMA32(F[(j + 2) & 7], Bc, acc[3]);
                }
                zq += 272;
                { const int ph = (gi + (int)blockIdx.x) & 3;
                  if (ph == 0) { if (cstage == 2) { cvt_store_w(CVL + wave * (16 * 65), ctile, wave, lane_id()); cstage = 0; }
                      const int t = CVT_T_MOE1 + (int)blockIdx.x + (int)gridDim.x * cslot; if (t < CVT_NTILES) { cvt_decode(a, t, ctile); cvt_load_w(ctile, cv, wave, lane_id()); cstage = 1; } ++cslot; }
                  else if (ph == 3) { if (cstage == 1) { cvt_pack_w(CVL + wave * (16 * 65), cv, lane_id()); cstage = 2; } }
                  ++gi; }
            }
#undef CV_RAW
#undef CV_MK
            __syncthreads();
            { const int cn = (o == 0) ? c : c + (int)gridDim.x; if (cn < 1024) cv_filter_dma(fA, RR + ((size_t)(o ^ 1) * 1024 + cn) * RRS, lane, wave); }
            LAS float* red = (LAS float*)fB + nt * 2048 + lane;
            const float sk = skip[o * 1024 + c], sc = o == 0 ? scl0 : scl1;
            const bf16_t* gsrc = UT + ((size_t)((1 + o) * 2 + bcol) * 1024 + c) * UTS;
            LAS unsigned char* zw = lds + bcol * CV_ZB;
#pragma unroll
            for (int hp = 0; hp < 2; ++hp) {
                if (kh == 1) {
#pragma unroll
                    for (int m2 = 0; m2 < 2; ++m2)
#pragma unroll
                        for (int r = 0; r < 16; ++r) red[(m2 * 16 + r) * 64] = acc[2 * hp + m2][r];
                }
                __syncthreads();
                if (kh == 0) {
                    u32x2 gq[2][4];
#pragma unroll
                    for (int m2 = 0; m2 < 2; ++m2)
#pragma unroll
                        for (int g4 = 0; g4 < 4; ++g4) gq[m2][g4] = *(const u32x2*)(gsrc + (128 * (i0 + ii) + 32 * (2 * hp + m2) + 8 * g4 + 4 * kg));
                    u32x2 wq[2][4];
#pragma unroll
                    for (int m2 = 0; m2 < 2; ++m2)
#pragma unroll
                        for (int g4 = 0; g4 < 4; ++g4) {
                            const int mt = 2 * hp + m2;
                            const int t4 = 128 * (i0 + ii) + 32 * mt + 8 * g4 + 4 * kg;
                            const u32x2 gw2 = gq[m2][g4];
                            LAS u32x2* zp = (LAS u32x2*)(zw + cv_pad(t4 + 1920) * 2);
                            const u32x2 zo = *zp;
                            const float y0 = acc[mt][4 * g4] + red[(m2 * 16 + 4 * g4) * 64], y1 = acc[mt][4 * g4 + 1] + red[(m2 * 16 + 4 * g4 + 1) * 64];
                            const float y2 = acc[mt][4 * g4 + 2] + red[(m2 * 16 + 4 * g4 + 2) * 64], y3 = acc[mt][4 * g4 + 3] + red[(m2 * 16 + 4 * g4 + 3) * 64];
                            const float r0 = bflo(gw2.x) * (y0 * sc + sk * bflo(zo.x)), r1 = bfhi(gw2.x) * (y1 * sc + sk * bfhi(zo.x));
                            const float r2 = bflo(gw2.y) * (y2 * sc + sk * bflo(zo.y)), r3 = bfhi(gw2.y) * (y3 * sc + sk * bfhi(zo.y));
                            u32x2 w; w.x = pkbf(r0, r1); w.y = pkbf(r2, r3);
                            wq[m2][g4] = w;
                            if (o == 0) *zp = w;
                        }
                    if (o != 0) {
#pragma unroll
                        for (int m2 = 0; m2 < 2; ++m2)
#pragma unroll
                            for (int g4 = 0; g4 < 4; ++g4) *(u32x2*)(Z2 + ((size_t)bcol * 1024 + c) * UTS + (128 * (i0 + ii) + 32 * (2 * hp + m2) + 8 * g4 + 4 * kg)) = wq[m2][g4];
                    }
                }
                __syncthreads();
            }
        }
    }
    VM_WAIT();
    __syncthreads();
    if (cstage == 1) { cvt_pack_w(CVL + wave * (16 * 65), cv, lane_id()); cstage = 2; }
    if (cstage == 2) { cvt_store_w(CVL + wave * (16 * 65), ctile, wave, lane_id()); cstage = 0; }
    for (int sl = cslot;; ++sl) { const int t = CVT_T_MOE1 + (int)blockIdx.x + (int)gridDim.x * sl; if (t >= CVT_NTILES) break;
        cvt_decode(a, t, ctile); cvt_load_w(ctile, cv, wave, lane_id()); cvt_pack_w(CVL + wave * (16 * 65), cv, lane_id()); cvt_store_w(CVL + wave * (16 * 65), ctile, wave, lane_id()); }
    __syncthreads();
    {
        const float* RRC = (const float*)(a.ws + WS_RRC);
        LAS float* zc = (LAS float*)(lds + wave * 6144);
        LAS float* rc = zc + 512;
        for (int c = gw; c < 1024; c += NGW) {
            float scl[2];
#pragma unroll
            for (int o = 0; o < 2; ++o) { float s = 0.f; if (lane < FQ_CSEG) s = FSQP[(size_t)(FQ_LSEG + lane) * 4096 + o * 2048 + c] + FSQP[(size_t)(FQ_LSEG + lane) * 4096 + o * 2048 + 1024 + c]; scl[o] = 1.0f / sqrtf(wave_sum(s) + EPS); }
            for (int k = lane; k < 1024; k += 64) { const int o = k >> 9, idx = k & 511; rc[k] = idx == 0 ? 0.f : RRC[(size_t)(o * 1024 + c) * 512 + idx]; }
            for (int k = lane; k < 512; k += 64) { const int b = k >> 8, t = k & 255; zc[k] = bf1(UTC[((size_t)(0 * 2 + b) * 1024 + c) * 256 + t]); }
            LDS_WAIT(); __builtin_amdgcn_wave_barrier();
#pragma unroll 1
            for (int o = 0; o < 2; ++o) {
                float y[2][4];
#pragma unroll
                for (int b = 0; b < 2; ++b)
#pragma unroll
                    for (int j = 0; j < 4; ++j) y[b][j] = 0.f;
                for (int s = 0; s < 256; ++s) { const float z0 = zc[s], z1 = zc[256 + s];
#pragma unroll
                    for (int j = 0; j < 4; ++j) { const float rv = rc[o * 512 + s - (lane + 64 * j) + 256]; y[0][j] += rv * z0; y[1][j] += rv * z1; } }
                float zn[2][4];
                const float sk = skip[o * 1024 + c];
#pragma unroll
                for (int b = 0; b < 2; ++b)
#pragma unroll
                    for (int j = 0; j < 4; ++j) { const int t = lane + 64 * j; const float g = bf1(UTC[((size_t)((1 + o) * 2 + b) * 1024 + c) * 256 + t]); zn[b][j] = g * (y[b][j] * (o == 0 ? scl[0] : scl[1]) + sk * zc[b * 256 + t]); }
                LDS_WAIT(); __builtin_amdgcn_wave_barrier();
#pragma unroll
                for (int b = 0; b < 2; ++b)
#pragma unroll
                    for (int j = 0; j < 4; ++j) { const int t = lane + 64 * j; if (o == 0) zc[b * 256 + t] = zn[b][j]; else Z2C[((size_t)b * 1024 + c) * 256 + t] = f2bf1(zn[b][j]); }
                LDS_WAIT(); __builtin_amdgcn_wave_barrier();
            }
        }
    }
}
template <class Epi> DI void small_gemm(LAS unsigned char* lds, int tid, int lane, int wave, int ntiles, int ntn, int K, const Epi& E) {
    const int rl = lane & 31, kg = lane >> 5;
    const int kslice = K >> 3, k0 = wave * kslice;
    LAS float* red = (LAS float*)lds;
    for (int t = blockIdx.x; t < ntiles; t += gridDim.x) {
        const int tm = t / ntn, tn = t - tm * ntn;
        const bf16_t* a0 = E.arow(tm, rl) + k0 + 8 * kg; const bf16_t* a1 = E.arow(tm, 32 + rl) + k0 + 8 * kg;
        const bf16_t* b0 = E.brow(tm, tn, rl) + k0 + 8 * kg; const bf16_t* b1 = E.brow(tm, tn, 32 + rl) + k0 + 8 * kg;
        f32x16 acc[2][2];
#pragma unroll
        for (int i = 0; i < 2; ++i)
#pragma unroll
            for (int j = 0; j < 2; ++j)
#pragma unroll
                for (int r = 0; r < 16; ++r) acc[i][j][r] = 0.f;
#pragma unroll 4
        for (int k = 0; k < kslice; k += 16) {
            const bf16x8 fa0 = *(const bf16x8*)(a0 + k), fa1 = *(const bf16x8*)(a1 + k), fb0 = *(const bf16x8*)(b0 + k), fb1 = *(const bf16x8*)(b1 + k);
            acc[0][0] = MFMA32(fa0, fb0, acc[0][0]); acc[0][1] = MFMA32(fa0, fb1, acc[0][1]);
            acc[1][0] = MFMA32(fa1, fb0, acc[1][0]); acc[1][1] = MFMA32(fa1, fb1, acc[1][1]);
        }
        __syncthreads();
#pragma unroll
        for (int i = 0; i < 2; ++i)
#pragma unroll
            for (int j = 0; j < 2; ++j)
#pragma unroll
                for (int r = 0; r < 16; ++r) red[wave * 4096 + ((i * 2 + j) * 16 + r) * 64 + lane] = acc[i][j][r];
        __syncthreads();
        { const int row = tid >> 3, c8 = (tid & 7) * 8;
          const int mt = row >> 5, rr = row & 31, kgs = (rr >> 2) & 1, r = (rr & 3) + 4 * (rr >> 3);
          const int nt = c8 >> 5;
          const LAS float* rp = red + ((mt * 2 + nt) * 16 + r) * 64 + (c8 & 31) + 32 * kgs;
          float v[8];
#pragma unroll
          for (int j = 0; j < 8; ++j) { float s = 0.f;
#pragma unroll
              for (int w = 0; w < 8; ++w) s += rp[w * 4096 + j];
              v[j] = s; }
          E.store(tm, tn, row, c8, v); }
    }
    __syncthreads();
}
DI float gelu1(float x) { const pg8::f32x2 r = pg8::gelu_pk((pg8::f32x2){x, x}); return r.x; }
struct SmDense {
    const bf16_t* A; int lda; const bf16_t* Bt; int K;
    int mode;
    bf16_t* O; int ldo; const float* bias; float* X; const float* gate;
    DI const bf16_t* arow(int tm, int r) const { return A + (size_t)(TX + 64 * tm + r) * lda; }
    DI const bf16_t* brow(int tm, int tn, int c) const { return Bt + (size_t)(64 * tn + c) * K; }
    DI void store(int tm, int tn, int r, int c8, const float (&v)[8]) const {
        const size_t row = (size_t)TX + 64 * tm + r; const int col = 64 * tn + c8;
        float y[8];
#pragma unroll
        for (int j = 0; j < 8; ++j) y[j] = v[j] + (bias ? bias[col + j] : 0.f);
        if (mode == 2) { float* xp = X + row * 1024 + col;
#pragma unroll
            for (int j = 0; j < 8; ++j) xp[j] += gate[col + j] * y[j]; }
        else { if (mode == 1) {
#pragma unroll
                for (int j = 0; j < 8; ++j) y[j] = gelu1(y[j]); }
            u32x4 w; w.x = pkbf(y[0], y[1]); w.y = pkbf(y[2], y[3]); w.z = pkbf(y[4], y[5]); w.w = pkbf(y[6], y[7]);
            *(u32x4*)(O + row * ldo + col) = w; }
    }
};
struct SmMoeUp {
    const bf16_t* H; const int* seltok; const bf16_t* Wgu; bf16_t* HM;
    DI const bf16_t* arow(int tm, int r) const { int row = seltok[tm * EROWS + 2048 + r]; row = ((unsigned)row < (unsigned)TR) ? row : 0; return H + (size_t)row * 1024; }
    DI const bf16_t* brow(int tm, int tn, int c) const { return Wgu + ((size_t)tm * 4096 + 64 * tn + c) * 1024; }
    DI void store(int tm, int tn, int r, int c8, const float (&v)[8]) const {
        float h[4];
#pragma unroll
        for (int j = 0; j < 4; ++j) h[j] = v[j] * __builtin_amdgcn_rcpf(1.0f + __expf(-v[j])) * v[4 + j];
        u32x2 w; w.x = pkbf(h[0], h[1]); w.y = pkbf(h[2], h[3]);
        *(u32x2*)(HM + ((size_t)tm * EROWS + 2048 + r) * 2048 + (64 * tn + c8) / 2) = w;
    }
};
struct SmMoeDown {
    const bf16_t* HM; const bf16_t* Wdn; bf16_t* Y; const float* g;
    DI const bf16_t* arow(int tm, int r) const { return HM + ((size_t)tm * EROWS + 2048 + r) * 2048; }
    DI const bf16_t* brow(int tm, int tn, int c) const { return Wdn + ((size_t)tm * 1024 + 64 * tn + c) * 2048; }
    DI void store(int tm, int tn, int r, int c8, const float (&v)[8]) const {
        const size_t row = (size_t)tm * EROWS + 2048 + r; const float gs = g[row];
        u32x4 w; w.x = pkbf(v[0] * gs, v[1] * gs); w.y = pkbf(v[2] * gs, v[3] * gs); w.z = pkbf(v[4] * gs, v[5] * gs); w.w = pkbf(v[6] * gs, v[7] * gs);
        *(u32x4*)(Y + row * 1024 + 64 * tn + c8) = w;
    }
};
enum { P_PRO0 = 0, P_A0, P_SG0, P_MOE0 = P_SG0 + 4, P_A1 = P_MOE0 + 4, P_HYIN, P_HYSC, P_HYCONV, P_HYTR, P_HYOUT, P_MOE1, P_A2 = P_MOE1 + 4, P_DAIN, P_DAPREP, P_ATTN, P_DAOUT, P_MOE2,
       P_A3 = P_MOE2 + 4, P_SG3, P_MOE3 = P_SG3 + 4, P_FINAL = P_MOE3 + 4, NPHASE };
template <int LAYER, int PH0, class BarT> DI void moe_block(const Args& a, LAS unsigned char* lds, const BarT& bar, int lo, int hi, int wave, int gw, int NGW) {
    constexpr int MT = 8;
    unsigned char* ws = a.ws;
#ifndef PROBE_MASK
#define PROBE_MASK 0ull
#define PROBE_N 1
#endif
#define PH_REPS(k) (((PROBE_MASK >> (k)) & 1ull) ? PROBE_N : 1)
#ifdef TPROBE_MASK
#define TP_BEGIN(k) if (((TPROBE_MASK >> (k)) & 1ull) && threadIdx.x == 0) { ((volatile LAS unsigned*)(lds + MISC_OFF))[16] = (unsigned)__builtin_amdgcn_s_memrealtime(); }
#define TP_END(k) if (((TPROBE_MASK >> (k)) & 1ull) && threadIdx.x == 0) { volatile LAS unsigned* _tp = (volatile LAS unsigned*)(lds + MISC_OFF); _tp[17] += (unsigned)__builtin_amdgcn_s_memrealtime() - _tp[16]; }
#else
#define TP_BEGIN(k)
#define TP_END(k)
#endif
#define PH_BEGIN(k) if (lo <= (k) && (k) < hi) { TP_BEGIN(k) for (int _rep = 0; _rep < PH_REPS(k); ++_rep) { if (_rep) xcd_barrier(bar); const int lane = lane_id(); const int tid = wave * 64 + lane; (void)tid; (void)lane;
#define PH_END(k) } if ((k) + 1 < hi) xcd_barrier(bar); TP_END(k) }
    PH_BEGIN(PH0 + 0) phase_moe_prep<LAYER>(a, lds, tid, lane, gw, NGW); __syncthreads(); PH_END(PH0 + 0)
    PH_BEGIN(PH0 + 1) phase_topk<LAYER>(a, lds, tid, lane, wave); PH_END(PH0 + 1)
    PH_BEGIN(PH0 + 2) {
        pg8::Gemm g{(const bf16_t*)(ws + WS_H), (const bf16_t*)(ws + WS_WGU) + (size_t)LAYER * 16 * 4096 * 1024, TR, 16 * 4096, 1024, (const int*)(ws + WS_SELTOK)};
        pg8::MoeOrder S{MT, 16, (int)gridDim.x, (int)blockIdx.x}; pg8::EpiSwiGLU E{(bf16_t*)(ws + WS_BUF2)};
        pg8::gemm_phase<pg8::EpiSwiGLU, pg8::MoeOrder, false, true>(lds, g, S, E, nullptr, wave);
        if (LAYER <= 1) { SmMoeUp Es{(const bf16_t*)(ws + WS_H), (const int*)(ws + WS_SELTOK), (const bf16_t*)(ws + WS_WGU) + (size_t)LAYER * 16 * 4096 * 1024, (bf16_t*)(ws + WS_BUF2)};
            small_gemm(lds, tid, lane, wave, 16 * 64, 64, 1024, Es); } } PH_END(PH0 + 2)
    PH_BEGIN(PH0 + 3) {
        pg8::Gemm g{(const bf16_t*)(ws + WS_BUF2), (const bf16_t*)(ws + WS_WDN) + (size_t)LAYER * 16 * 1024 * 2048, 16 * EROWS, 16 * 1024, 2048, nullptr};
        pg8::MoeOrder S{MT, 4, (int)gridDim.x, (int)blockIdx.x}; pg8::EpiDown E{(bf16_t*)(ws + WS_Y), (const float*)(ws + WS_SELG)};
        pg8::gemm_phase<pg8::EpiDown, pg8::MoeOrder, false>(lds, g, S, E, nullptr, wave);
        if (LAYER <= 1) { SmMoeDown Es{(const bf16_t*)(ws + WS_BUF2), (const bf16_t*)(ws + WS_WDN) + (size_t)LAYER * 16 * 1024 * 2048, (bf16_t*)(ws + WS_Y), (const float*)(ws + WS_SELG)};
            small_gemm(lds, tid, lane, wave, 16 * 16, 16, 2048, Es); } } PH_END(PH0 + 3)
}
template <int LAYER, int J, int PH0, class BarT> DI void sg_block(const Args& a, LAS unsigned char* lds, const BarT& bar, int lo, int hi, int wave) {
    constexpr int M = TX, NCHUNK = ((LAYER == 3) ? TX : TR) / 128;
    unsigned char* ws = a.ws;
    PH_BEGIN(PH0 + 0) {
        pg8::Gemm g{(const bf16_t*)(ws + WS_H), (const bf16_t*)(ws + WS_WSGIN) + (size_t)J * 4096 * 1024, M, 4096, 1024, nullptr};
        pg8::StaticOrder S; S.init(M, 4096, (int)gridDim.x, (int)blockIdx.x);
        pg8::EpiBf16<1> E{(bf16_t*)(ws + WS_BUF1), 4096, a.in[I_SGBIN] + J * 4096, 0, 0, (float*)(ws + WS_VSQ), 2048};
        pg8::gemm_phase<pg8::EpiBf16<1>, pg8::StaticOrder, false>(lds, g, S, E, nullptr, wave);
        if (LAYER == 0) { SmDense Es{(const bf16_t*)(ws + WS_H), 1024, (const bf16_t*)(ws + WS_WSGIN) + (size_t)J * 4096 * 1024, 1024, 1, (bf16_t*)(ws + WS_BUF1), 4096, a.in[I_SGBIN] + J * 4096, nullptr, nullptr};
            small_gemm(lds, tid, lane, wave, 8 * 64, 64, 1024, Es); } } PH_END(PH0 + 0)
    PH_BEGIN(PH0 + 1) phase_sg_vnt<J, NCHUNK>(a, lds, tid, lane, wave); PH_END(PH0 + 1)
    PH_BEGIN(PH0 + 2) {
        pg8::Gemm g{(const bf16_t*)(ws + WS_WSBD) + (size_t)J * 4 * 256 * 256, (const bf16_t*)(ws + WS_BUF2), 1024, NCHUNK * 4 * 256, 256, nullptr};
        pg8::SpatOrder S{NCHUNK * 4, (int)gridDim.x, (int)blockIdx.x};
        pg8::EpiSpat E{(bf16_t*)(ws + WS_BUF3), (const bf16_t*)(ws + WS_BUF1), a.in[I_SGBS] + J * 8 * 128};
        pg8::gemm_phase<pg8::EpiSpat, pg8::SpatOrder, false>(lds, g, S, E, nullptr, wave); } PH_END(PH0 + 2)
    PH_BEGIN(PH0 + 3) {
        pg8::Gemm g{(const bf16_t*)(ws + WS_BUF3), (const bf16_t*)(ws + WS_WSGOUT) + (size_t)J * 1024 * 2048, M, 1024, 2048, nullptr};
        pg8::StaticOrder S; S.init(M, 1024, (int)gridDim.x, (int)blockIdx.x);
        pg8::EpiRes E{(float*)(ws + WS_X), a.in[I_SGBOUT] + J * 1024, modp(a, LAYER, 0, 2)};
        pg8::gemm_phase<pg8::EpiRes, pg8::StaticOrder, false>(lds, g, S, E, nullptr, wave);
        if (LAYER == 0) { SmDense Es{(const bf16_t*)(ws + WS_BUF3), 2048, (const bf16_t*)(ws + WS_WSGOUT) + (size_t)J * 1024 * 2048, 2048, 2, nullptr, 0, a.in[I_SGBOUT] + J * 1024, (float*)(ws + WS_X), modp(a, LAYER, 2, 2)};
            small_gemm(lds, tid, lane, wave, 8 * 16, 16, 2048, Es); } } PH_END(PH0 + 3)
}

__global__ void __launch_bounds__(NTHR, 2) mk_fwd(Args a) {
    extern __shared__ __attribute__((aligned(16))) unsigned char lds_raw[];
    LAS unsigned char* lds = (LAS unsigned char*)lds_raw;
    const int wave = __builtin_amdgcn_readfirstlane((int)threadIdx.x >> 6);
    const int G = gridDim.x, gw = blockIdx.x * NWAVES + wave, NGW = G * NWAVES;
    volatile LAS unsigned* MISC = (volatile LAS unsigned*)(lds + MISC_OFF);
    if (threadIdx.x < 32) MISC[threadIdx.x] = 0u;
    __syncthreads();
    unsigned char* ws = a.ws;
    XcdBarrier bar = xcd_barrier_post((unsigned*)(ws + WS_CTL) + CW_BAR, MISC + 8);
    const int lo = a.ph_lo, hi = a.ph_hi;

    PH_BEGIN(P_PRO0)
        pro0_mod(a, lds, tid, lane, wave);
        pro0_small(a, blockIdx.x * NTHR + tid, G * NTHR);
        pro0_filter1(a, lane, gw, NGW);
        __syncthreads();
    PH_END(P_PRO0)
#ifndef TPROBE_SUB
#define TPROBE_SUB 0
#endif
#define TPS_BEGIN(n) if (TPROBE_SUB == (n)) { __syncthreads(); if (threadIdx.x == 0) MISC[16] = (unsigned)__builtin_amdgcn_s_memrealtime(); }
#define TPS_END(n) if (TPROBE_SUB == (n)) { asm volatile("s_waitcnt vmcnt(0)" ::: "memory"); __syncthreads(); if (threadIdx.x == 0) MISC[17] += (unsigned)__builtin_amdgcn_s_memrealtime() - MISC[16]; }
    PH_BEGIN(P_A0)
        TPS_BEGIN(1) phase_A<0>(a, lane, gw, NGW); TPS_END(1)
        TPS_BEGIN(2) pro1_filter2(a, lds, lane, gw, NGW); TPS_END(2)
        TPS_BEGIN(3) cvt_range(a, lds, tid, 0, CVT_T_MOE1);
        __syncthreads(); TPS_END(3)
    PH_END(P_A0)
    sg_block<0, 0, P_SG0>(a, lds, bar, lo, hi, wave);
    moe_block<0, P_MOE0>(a, lds, bar, lo, hi, wave, gw, NGW);
    PH_BEGIN(P_A1) phase_A<1>(a, lane, gw, NGW); PH_END(P_A1)
    PH_BEGIN(P_HYIN) {
        pg8::Gemm g{(const bf16_t*)(ws + WS_H), (const bf16_t*)(ws + WS_WHYIN), TX, 3072, 1024, nullptr};
        pg8::StaticOrder S; S.init(TX, 3072, G, (int)blockIdx.x);
        pg8::EpiBf16<0> E{(bf16_t*)(ws + WS_BUF1), 3072, a.in[I_HYBIN], 0, 0};
        pg8::gemm_phase<pg8::EpiBf16<0>, pg8::StaticOrder, false>(lds, g, S, E, nullptr, wave);
        SmDense Es{(const bf16_t*)(ws + WS_H), 1024, (const bf16_t*)(ws + WS_WHYIN), 1024, 0, (bf16_t*)(ws + WS_BUF1), 3072, a.in[I_HYBIN], nullptr, nullptr};
        small_gemm(lds, tid, lane, wave, 8 * 48, 48, 1024, Es); } PH_END(P_HYIN)
    PH_BEGIN(P_HYSC) phase_hy_shortconv(a, lds, tid); PH_END(P_HYSC)
    PH_BEGIN(P_HYCONV) phase_hy_conv(a, lds, tid, lane, wave, gw, NGW); __syncthreads(); PH_END(P_HYCONV)
    PH_BEGIN(P_HYTR) phase_hy_transpose(a, lds, lane, wave, gw, NGW); __syncthreads(); PH_END(P_HYTR)
    PH_BEGIN(P_HYOUT) {
        pg8::Gemm g{(const bf16_t*)(ws + WS_H), (const bf16_t*)(ws + WS_WHYOUT), TX, 1024, 1024, nullptr};
        pg8::StaticOrder S; S.init(TX, 1024, G, (int)blockIdx.x);
        pg8::EpiRes E{(float*)(ws + WS_X), a.in[I_HYBOUT], modp(a, 1, 0, 2)};
        pg8::gemm_phase<pg8::EpiRes, pg8::StaticOrder, false>(lds, g, S, E, nullptr, wave);
        SmDense Es{(const bf16_t*)(ws + WS_H), 1024, (const bf16_t*)(ws + WS_WHYOUT), 1024, 2, nullptr, 0, a.in[I_HYBOUT], (float*)(ws + WS_X), modp(a, 1, 2, 2)};
        small_gemm(lds, tid, lane, wave, 8 * 16, 16, 1024, Es); } PH_END(P_HYOUT)
    moe_block<1, P_MOE1>(a, lds, bar, lo, hi, wave, gw, NGW);
    PH_BEGIN(P_A2) phase_A<2>(a, lane, gw, NGW); PH_END(P_A2)
    PH_BEGIN(P_DAIN) {
        pg8::Gemm g{(const bf16_t*)(ws + WS_H), (const bf16_t*)(ws + WS_WDAIN), TX, 3072, 1024, nullptr};
        pg8::StaticOrder S; S.init(TX, 3072, G, (int)blockIdx.x);
        pg8::EpiBf16<0> E{(bf16_t*)(ws + WS_BUF1), 3072, nullptr, 0, 0};
        pg8::gemm_phase<pg8::EpiBf16<0>, pg8::StaticOrder, false>(lds, g, S, E, nullptr, wave);
        SmDense Es{(const bf16_t*)(ws + WS_H), 1024, (const bf16_t*)(ws + WS_WDAIN), 1024, 0, (bf16_t*)(ws + WS_BUF1), 3072, nullptr, nullptr, nullptr};
        small_gemm(lds, tid, lane, wave, 8 * 48, 48, 1024, Es); } PH_END(P_DAIN)
    PH_BEGIN(P_DAPREP) phase_da_prep(a, lds, tid); PH_END(P_DAPREP)
    PH_BEGIN(P_ATTN) phase_attn(a, lds, tid, lane, wave); __syncthreads(); PH_END(P_ATTN)
    PH_BEGIN(P_DAOUT) {
        pg8::Gemm g{(const bf16_t*)(ws + WS_BUF3), (const bf16_t*)(ws + WS_WDAOUT), TX, 1024, 1024, nullptr};
        pg8::StaticOrder S; S.init(TX, 1024, G, (int)blockIdx.x);
        pg8::EpiRes E{(float*)(ws + WS_X), nullptr, modp(a, 2, 0, 2)};
        pg8::gemm_phase<pg8::EpiRes, pg8::StaticOrder, false>(lds, g, S, E, nullptr, wave); } PH_END(P_DAOUT)
    moe_block<2, P_MOE2>(a, lds, bar, lo, hi, wave, gw, NGW);
    PH_BEGIN(P_A3) phase_A<3>(a, lane, gw, NGW); PH_END(P_A3)
    sg_block<3, 1, P_SG3>(a, lds, bar, lo, hi, wave);
    moe_block<3, P_MOE3>(a, lds, bar, lo, hi, wave, gw, NGW);
    PH_BEGIN(P_FINAL) phase_A<4>(a, lane, gw, NGW); PH_END(P_FINAL)
#ifdef TPROBE_MASK
    __syncthreads();
    if (threadIdx.x == 0) { const unsigned long long w = (unsigned long long)MISC[17] * TPROBE_MULT, t0 = __builtin_amdgcn_s_memrealtime(); while (__builtin_amdgcn_s_memrealtime() - t0 < w) __builtin_amdgcn_s_sleep(20); }
#endif
}

extern "C" void kernel_launch(void* const* d_in, const int* in_sizes, int n_in, void* d_out, int out_size, void* d_ws, size_t ws_size, hipStream_t stream) {
    static int grid = 0;
    if (grid == 0) {
        if (n_in != N_IN || out_size != TX * D || ws_size < WS_END) { fprintf(stderr, "kernel_launch: unexpected problem (n_in %d, out %d, ws %zu < %zu)\n", n_in, out_size, ws_size, (size_t)WS_END); grid = -1; return; }
        int dev = 0, cus = 0, per_cu = 0;
        if (hipGetDevice(&dev) != hipSuccess || hipDeviceGetAttribute(&cus, hipDeviceAttributeMultiprocessorCount, dev) != hipSuccess) { grid = -1; return; }
        if (hipFuncSetAttribute((const void*)mk_fwd, hipFuncAttributeMaxDynamicSharedMemorySize, LDS_BYTES) != hipSuccess) { fprintf(stderr, "kernel_launch: hipFuncSetAttribute failed\n"); grid = -1; return; }
        if (hipOccupancyMaxActiveBlocksPerMultiprocessor(&per_cu, (const void*)mk_fwd, NTHR, LDS_BYTES) != hipSuccess || per_cu < 1)
            fprintf(stderr, "kernel_launch: occupancy query reports %d workgroups per CU\n", per_cu);
        (void)hipGetLastError();
        grid = cus;
    }
    if (grid < 0) return;
    if (hipMemsetAsync((char*)d_ws + WS_CTL, 0, CTL_ZERO_BYTES, stream) != hipSuccess) return;
    Args a{};
    for (int i = 0; i < N_IN; ++i) a.in[i] = (const float*)d_in[i];
    a.out = (float*)d_out; a.ws = (unsigned char*)d_ws;
#if MK_LAUNCHES == 1
    a.ph_lo = 0; a.ph_hi = NPHASE;
    hipLaunchKernelGGL(mk_fwd, dim3(grid), dim3(NTHR), LDS_BYTES, stream, a);
#else
    for (int p = 0; p < NPHASE; ++p) { a.ph_lo = p; a.ph_hi = p + 1; hipLaunchKernelGGL(mk_fwd, dim3(grid), dim3(NTHR), LDS_BYTES, stream, a); }
#endif
}
```

```cpp
#include <hip/hip_runtime.h>
#include <stdint.h>
#include <stdio.h>
#include <math.h>

#ifndef MK_LAUNCHES
#define MK_LAUNCHES 1
#endif

#define GAS __attribute__((address_space(1)))
#define LAS __attribute__((address_space(3)))
typedef unsigned short bf16_t;
typedef float f32x4 __attribute__((ext_vector_type(4)));
typedef float f32x2 __attribute__((ext_vector_type(2)));
typedef float f32x16 __attribute__((ext_vector_type(16)));
typedef unsigned u32x4 __attribute__((ext_vector_type(4)));
typedef unsigned u32x2 __attribute__((ext_vector_type(2)));
typedef short bf16x8 __attribute__((ext_vector_type(8)));
#define DI __device__ __forceinline__

DI unsigned pkbf(float lo, float hi) { unsigned r; asm volatile("v_cvt_pk_bf16_f32 %0, %1, %2" : "=v"(r) : "v"(lo), "v"(hi)); return r; }
DI float bflo(unsigned w) { return __uint_as_float(w << 16); }
DI float bfhi(unsigned w) { return __uint_as_float(w & 0xffff0000u); }
DI float bf1(bf16_t h) { return __uint_as_float(((unsigned)h) << 16); }
DI bf16_t f2bf1(float f) { return (bf16_t)(pkbf(f, 0.f) & 0xffffu); }
template <int CTRL> DI float dppf(float v) { return __builtin_bit_cast(float, __builtin_amdgcn_update_dpp(0, __builtin_bit_cast(int, v), CTRL, 0xf, 0xf, true)); }
#define DPP_XOR1 0xB1
#define DPP_XOR2 0x4E
#define DPP_ROR(n) (0x120 + (n))
DI float row_sum16(float v) { v += dppf<DPP_ROR(8)>(v); v += dppf<DPP_ROR(4)>(v); v += dppf<DPP_ROR(2)>(v); v += dppf<DPP_ROR(1)>(v); return v; }
DI float row_max16(float v) { v = fmaxf(v, dppf<DPP_ROR(8)>(v)); v = fmaxf(v, dppf<DPP_ROR(4)>(v)); v = fmaxf(v, dppf<DPP_ROR(2)>(v)); v = fmaxf(v, dppf<DPP_ROR(1)>(v)); return v; }
DI float rlane(float v, int l) { return __builtin_bit_cast(float, __builtin_amdgcn_readlane(__builtin_bit_cast(int, v), l)); }
DI float wave_sum(float v) { v = row_sum16(v); return (rlane(v, 0) + rlane(v, 16)) + (rlane(v, 32) + rlane(v, 48)); }
DI float wave_max(float v) { v = row_max16(v); return fmaxf(fmaxf(rlane(v, 0), rlane(v, 16)), fmaxf(rlane(v, 32), rlane(v, 48))); }
DI int lane_id() { int l; asm volatile("v_mbcnt_lo_u32_b32 %0, -1, 0\n\tv_mbcnt_hi_u32_b32 %0, -1, %0" : "=v"(l)); return l; }
#define MFMA32(a, b, c) __builtin_amdgcn_mfma_f32_32x32x16_bf16((a), (b), (c), 0, 0, 0)
#define LDS_WAIT() asm volatile("s_waitcnt lgkmcnt(0)" ::: "memory")
#define VM_WAIT() asm volatile("s_waitcnt vmcnt(0)" ::: "memory")

#define XB_TMO      128
#define XB_XCNT(j)  (256  + 64 * (j))
#define XB_XSUB(j)  (1280 + 64 * (j))
#define XB_XGEN(j)  (2304 + 64 * (j))
#define XB_TOP      3328
#define XB_TOPGEN   3392
#define XCD_BAR_WORDS 3456
#define XB_SPIN_CAP (1u << 18)
__device__ __forceinline__ unsigned xb_ld(unsigned* p)              { return __hip_atomic_load(p, __ATOMIC_RELAXED, __HIP_MEMORY_SCOPE_AGENT); }
__device__ __forceinline__ unsigned xb_add(unsigned* p, unsigned v) { return __hip_atomic_fetch_add(p, v, __ATOMIC_RELAXED, __HIP_MEMORY_SCOPE_AGENT); }
__device__ __forceinline__ unsigned xb_xcc_id() { return (unsigned)__builtin_amdgcn_s_getreg((3 << 11) | 20) & 0xFu; }
#define XB_SPIN(cond, bar) do { unsigned _sp = 0; while (cond) { __builtin_amdgcn_s_sleep(1); \
    if ((++_sp & 255u) == 0u) { if (xb_ld(&(bar)[XB_TMO])) break; if (_sp > XB_SPIN_CAP) { atomicAdd(&(bar)[XB_TMO], 1u); break; } } } } while (0)
struct XcdBarrier { unsigned* bar; unsigned x; volatile LAS unsigned* st; };
__device__ __forceinline__ XcdBarrier xcd_barrier_post(unsigned* bar, volatile LAS unsigned* st) {
    XcdBarrier b; b.bar = bar; b.x = xb_xcc_id(); b.st = st;
    if (threadIdx.x == 0) (void)xb_add(&bar[XB_XCNT(b.x)], 1u);
    return b;
}
__device__ __forceinline__ void xcd_barrier_complete(unsigned* bar, unsigned x, unsigned& nloc, unsigned& nx) {
    const unsigned G = gridDim.x * gridDim.y * gridDim.z;
    unsigned sum, cnt, mine, sp = 0u;
    for (;;) {
        sum = 0u; cnt = 0u; mine = 0u;
#pragma unroll
        for (unsigned j = 0; j < 16; ++j) { const unsigned c = xb_ld(&bar[XB_XCNT(j)]); sum += c; cnt += (c > 0u) ? 1u : 0u; mine = (j == x) ? c : mine; }
        if (sum == G) break;
        __builtin_amdgcn_s_sleep(1);
        if ((++sp & 255u) == 0u) { if (xb_ld(&bar[XB_TMO])) break; if (sp > XB_SPIN_CAP) { atomicAdd(&bar[XB_TMO], 1u); break; } }
    }
    nloc = mine > 0u ? mine : 1u; nx = cnt > 0u ? cnt : 1u;
}
__device__ __forceinline__ void xcd_barrier(const XcdBarrier& b) {
    asm volatile("s_waitcnt vmcnt(0)" ::: "memory");
    __syncthreads();
    if (threadIdx.x == 0) {
        unsigned* bar = b.bar;
        __builtin_amdgcn_s_waitcnt(0);
        unsigned nloc = b.st[0], nx = b.st[1];
        if (nloc == 0u) { xcd_barrier_complete(bar, b.x, nloc, nx); b.st[0] = nloc; b.st[1] = nx; }
        const unsigned old = xb_add(&bar[XB_XSUB(b.x)], 1u);
        const unsigned gen = old / nloc;
        if (old + 1u == (gen + 1u) * nloc) {
            __builtin_amdgcn_fence(__ATOMIC_RELEASE, "agent");
            asm volatile("s_waitcnt vmcnt(0)" ::: "memory");
            const unsigned og = xb_add(&bar[XB_TOP], 1u);
            const unsigned tg = og / nx;
            if (og + 1u == (tg + 1u) * nx) xb_add(&bar[XB_TOPGEN], 1u);
            else XB_SPIN(xb_ld(&bar[XB_TOPGEN]) == tg, bar);
            __builtin_amdgcn_fence(__ATOMIC_ACQUIRE, "agent");
            xb_add(&bar[XB_XGEN(b.x)], 1u);
            asm volatile("s_waitcnt vmcnt(0)" ::: "memory");
        } else {
            XB_SPIN(xb_ld(&bar[XB_XGEN(b.x)]) == gen, bar);
            __builtin_amdgcn_fence(__ATOMIC_ACQUIRE, "agent");
            asm volatile("s_waitcnt vmcnt(0)" ::: "memory");
        }
    }
    __syncthreads();
}
namespace pg8 {
#define PG8_LAS __attribute__((address_space(3)))
typedef unsigned short bf16_t;
typedef short bf16x8 __attribute__((ext_vector_type(8)));
typedef float f32x4 __attribute__((ext_vector_type(4)));
typedef unsigned u32x4 __attribute__((ext_vector_type(4)));
constexpr int BM = 256, BK = 64, HALF = 128, HTB = HALF * BK * 2  , STAGE_BYTES = 8 * HTB, NXCD = 8, WGM = 8;

__host__ __device__ __forceinline__ int lds_byte(int r, int c) { const int st = (r >> 4) * 2 + (c >> 5), rr = r & 15, cc = c & 31, ob = rr * 64 + cc * 2; return st * 1024 + (ob ^ (((ob >> 9) & 1) << 5)); }
__host__ __device__ __forceinline__ void stage_rc(int b, int& R, int& C) { const int st = b / 1024, sb = b % 1024, swz = sb ^ (((sb >> 9) & 1) << 5); R = (st >> 1) * 16 + swz / 64; C = (st & 1) * 32 + (swz % 64) / 2; }
__host__ __device__ __forceinline__ int perm32(int rho) { const int n = rho >> 4, i = rho & 15; return 8 * (i >> 2) + 4 * n + (i & 3); }

struct Unit { int pm, pn; };
struct Gemm { const bf16_t* A; const bf16_t* Bt; int M, N, K; const int* aidx; };

struct StaticOrder {
    int nM, nN, nwg, G, c;
    __host__ __device__ void init(int M, int N, int G_, int c_) { nM = M / BM; nN = N / BM; nwg = nM * nN; G = G_; c = c_; }
    __host__ __device__ bool next(int i, Unit& u) const {
        const long L = (long)i * G + c; if (L >= nwg) return false;
        int wgid = (int)L; { const int q = nwg / NXCD, r = nwg % NXCD, xcd = wgid % NXCD, off = wgid / NXCD; wgid = (xcd < r ? xcd * (q + 1) : r * (q + 1) + (xcd - r) * q) + off; }
        const int nig = WGM * nN, gid = wgid / nig, fm = gid * WGM, gsz = (nM - fm) < WGM ? (nM - fm) : WGM;
        u.pm = fm + ((wgid % nig) % gsz); u.pn = (wgid % nig) / gsz; return true;
    }
    __device__ __forceinline__ void a_ready(const Unit&) const {}
    __device__ __forceinline__ void done(const Unit&) const {}
};
struct CountedOrder : StaticOrder {
    const unsigned* ready; unsigned need; unsigned* tmo;
    __device__ __forceinline__ void a_ready(const Unit& u) const {
        if (threadIdx.x < 64) {
            const unsigned long long t0 = __builtin_amdgcn_s_memrealtime(); unsigned polls = 0;
            while ((unsigned)__builtin_amdgcn_readfirstlane(__hip_atomic_load(ready + 64 * u.pm, __ATOMIC_RELAXED, __HIP_MEMORY_SCOPE_AGENT)) < need) {
                if ((++polls & 255u) == 0u && __builtin_amdgcn_readfirstlane(__hip_atomic_load(tmo, __ATOMIC_RELAXED, __HIP_MEMORY_SCOPE_AGENT)) != 0u) break;
                if (__builtin_amdgcn_s_memrealtime() - t0 > 2000000ull) {
                    if (threadIdx.x == 0) { unsigned expect = 0u; __hip_atomic_compare_exchange_strong(tmo + 1, &expect, 0x600u | (unsigned)(u.pm & 0xff), __ATOMIC_RELAXED, __ATOMIC_RELAXED, __HIP_MEMORY_SCOPE_AGENT); __hip_atomic_store(tmo, 1u, __ATOMIC_RELAXED, __HIP_MEMORY_SCOPE_AGENT); }
                    break; }
                __builtin_amdgcn_s_sleep(2); }
            __builtin_amdgcn_fence(__ATOMIC_ACQUIRE, "agent");
            asm volatile("s_waitcnt vmcnt(0)" ::: "memory");
        }
#if !defined(BROKEN_HOOK_NO_BARRIER)
        asm volatile("" ::: "memory"); __builtin_amdgcn_s_barrier(); asm volatile("" ::: "memory");
#endif
    }
};

__device__ __forceinline__ unsigned cvt_pk_bf16(float lo, float hi) { unsigned r; asm volatile("v_cvt_pk_bf16_f32 %0, %1, %2" : "=v"(r) : "v"(lo), "v"(hi)); return r; }
typedef float f32x2 __attribute__((ext_vector_type(2)));
__device__ __forceinline__ f32x2 gelu_pk(f32x2 v) {
    const f32x2 av = __builtin_elementwise_abs(v), d = av * 0.2316418882f + 1.0f;
    f32x2 t; t.x = __builtin_amdgcn_rcpf(d.x); t.y = __builtin_amdgcn_rcpf(d.y);
    f32x2 q = t * 0.5307027145f + (-0.7265760135f); q = q * t + 0.7107068705f; q = q * t + (-0.142248368f); q = q * t + 0.127414796f; q = q * t;
    const f32x2 s = (v * v) * (-0.72134752044f);
    f32x2 e; e.x = __builtin_amdgcn_exp2f(s.x); e.y = __builtin_amdgcn_exp2f(s.y);
    const f32x2 m = v * (q * e), r = v - m;
    f32x2 o; o.x = v.x < 0.f ? m.x : r.x; o.y = v.y < 0.f ? m.y : r.y; return o;
}

struct EpiF32 {
    static constexpr bool PERM = false, AFTER_DRAIN = false;
    float* C; int ldc; const float* bias;
    __device__ __forceinline__ void operator()(const f32x4 (&acc)[2][2][4][2], const Unit& u, int wr, int wc, int fr, int fq) const {
        const int row0 = u.pm * BM + wr * 64 + fr, col0 = u.pn * BM + wc * 32 + 4 * fq;
        f32x4 bv[2][2];
#pragma unroll
        for (int bj = 0; bj < 2; ++bj)
#pragma unroll
            for (int n = 0; n < 2; ++n) bv[bj][n] = bias ? *(const f32x4*)(bias + col0 + bj * HALF + n * 16) : (f32x4){0.f, 0.f, 0.f, 0.f};
#pragma unroll
        for (int ai = 0; ai < 2; ++ai)
#pragma unroll
            for (int m = 0; m < 4; ++m) { float* rowp = C + (size_t)(row0 + ai * HALF + m * 16) * ldc + col0;
#pragma unroll
                for (int bj = 0; bj < 2; ++bj)
#pragma unroll
                    for (int n = 0; n < 2; ++n) *(f32x4*)(rowp + bj * HALF + n * 16) = acc[ai][bj][m][n] + bv[bj][n]; }
    }
};
template <int ACT  > struct EpiBf16 {
    static constexpr bool PERM = true, AFTER_DRAIN = false;
    bf16_t* O; int ldc; const float* bias; int split_cols; size_t split_stride;
    float* vsq; int vsq_col0;
    __device__ __forceinline__ void operator()(const f32x4 (&acc)[2][2][4][2], const Unit& u, int wr, int wc, int fr, int fq) const {
        const int row0 = u.pm * BM + wr * 64 + fr; int colt = u.pn * BM; bf16_t* base = O;
        if (split_cols) { const int t = colt / split_cols; base += (size_t)t * split_stride; colt -= t * split_cols; }
        const int col0 = colt + wc * 32 + 8 * fq, bcol0 = u.pn * BM + wc * 32 + 8 * fq;
        f32x4 bv[2][2];
#pragma unroll
        for (int bj = 0; bj < 2; ++bj)
#pragma unroll
            for (int n = 0; n < 2; ++n) bv[bj][n] = bias ? *(const f32x4*)(bias + bcol0 + bj * HALF + 4 * n) : (f32x4){0.f, 0.f, 0.f, 0.f};
        const bool dosq = vsq != nullptr && u.pn * BM >= vsq_col0;
#pragma unroll
        for (int ai = 0; ai < 2; ++ai)
#pragma unroll
            for (int m = 0; m < 4; ++m) { bf16_t* rowp = base + (size_t)(row0 + ai * HALF + m * 16) * ldc + col0; float ss = 0.f;
#pragma unroll
                for (int bj = 0; bj < 2; ++bj) { f32x4 v0 = acc[ai][bj][m][0] + bv[bj][0], v1 = acc[ai][bj][m][1] + bv[bj][1];
                    if (ACT == 1) { f32x2 a = gelu_pk((f32x2){v0[0], v0[1]}), b = gelu_pk((f32x2){v0[2], v0[3]}), c = gelu_pk((f32x2){v1[0], v1[1]}), d = gelu_pk((f32x2){v1[2], v1[3]});
                        v0 = (f32x4){a.x, a.y, b.x, b.y}; v1 = (f32x4){c.x, c.y, d.x, d.y}; }
                    if (ACT == 2) {
#pragma unroll
                        for (int j = 0; j < 4; ++j) { v0[j] = 0.5f * v0[j] * (1.0f + erff(v0[j] * 0.70710678f)); v1[j] = 0.5f * v1[j] * (1.0f + erff(v1[j] * 0.70710678f)); } }
                    ss += ((v0[0] * v0[0] + v0[1] * v0[1]) + (v0[2] * v0[2] + v0[3] * v0[3])) + ((v1[0] * v1[0] + v1[1] * v1[1]) + (v1[2] * v1[2] + v1[3] * v1[3]));
                    u32x4 w; w.x = cvt_pk_bf16(v0[0], v0[1]); w.y = cvt_pk_bf16(v0[2], v0[3]); w.z = cvt_pk_bf16(v1[0], v1[1]); w.w = cvt_pk_bf16(v1[2], v1[3]);
                    *(u32x4*)(rowp + bj * HALF) = w; }
                if (dosq) { ss += __shfl_xor(ss, 16); ss += __shfl_xor(ss, 32);
                    if (fq == 0) vsq[(size_t)(row0 + ai * HALF + m * 16) * 32 + ((u.pn * BM - vsq_col0) >> 8) * 4 + wc] = ss; } }
    }
};

struct PanelStats {
    unsigned* xbuf;
    unsigned* cnt;
    unsigned* tmo;
    int ntn; float eps;
    unsigned code;
    __device__ __forceinline__ bool run(const f32x4 (&v)[2][2][4][2], const Unit& u, int wr, int wc, int fr, int fq, PG8_LAS unsigned char* lds, int wid, int lane) const {
        typedef float f32x2v __attribute__((ext_vector_type(2)));
        PG8_LAS f32x2v* P = (PG8_LAS f32x2v*)lds;
        PG8_LAS f32x2v* S = (PG8_LAS f32x2v*)(lds + 8192);
        PG8_LAS unsigned* flag = (PG8_LAS unsigned*)(lds + 8192 + 2048);
#pragma unroll
        for (int ai = 0; ai < 2; ++ai)
#pragma unroll
            for (int m = 0; m < 4; ++m) {
                float s = 0.f;
#pragma unroll
                for (int bj = 0; bj < 2; ++bj)
#pragma unroll
                    for (int n = 0; n < 2; ++n) { const f32x4 x = v[ai][bj][m][n]; s += (x[0] + x[1]) + (x[2] + x[3]); }
                s += __shfl_xor(s, 16); s += __shfl_xor(s, 32);
                const float mw = s * (1.0f / 64.0f); float q = 0.f;
#pragma unroll
                for (int bj = 0; bj < 2; ++bj)
#pragma unroll
                    for (int n = 0; n < 2; ++n) { const f32x4 d = v[ai][bj][m][n] - mw; q += (d[0] * d[0] + d[1] * d[1]) + (d[2] * d[2] + d[3] * d[3]); }
                q += __shfl_xor(q, 16); q += __shfl_xor(q, 32);
                if (fq == 0) P[(ai * HALF + wr * 64 + m * 16 + fr) * 4 + wc] = (f32x2v){mw, q};
            }
        asm volatile("s_waitcnt lgkmcnt(0)" ::: "memory"); __builtin_amdgcn_s_barrier(); asm volatile("" ::: "memory");
#if defined(BROKEN_NO_WAIT)
        if (blockIdx.x >= 64) { const long long t0 = clock64(); while (clock64() - t0 < 60000) __builtin_amdgcn_s_sleep(8); }
#endif
        const int row = wid * 32 + (lane & 31);
        if (lane < 32) {
            const f32x2v a = P[row * 4 + 0], b = P[row * 4 + 1], c = P[row * 4 + 2], d = P[row * 4 + 3];
            const float mt = (a.x + b.x + c.x + d.x) * 0.25f;
            const float da = a.x - mt, db = b.x - mt, dc = c.x - mt, dd = d.x - mt;
            const float m2 = (a.y + b.y) + (c.y + d.y) + 64.0f * ((da * da + db * db) + (dc * dc + dd * dd));
            unsigned long long* slot = (unsigned long long*)xbuf + ((size_t)(u.pm * BM + row) * 4 + u.pn);
            __hip_atomic_store(slot, ((unsigned long long)__float_as_uint(m2) << 32) | __float_as_uint(mt), __ATOMIC_RELAXED, __HIP_MEMORY_SCOPE_AGENT);
        }
        asm volatile("s_waitcnt vmcnt(0)" ::: "memory");
        if (lane == 0) __hip_atomic_fetch_add(cnt + 64 * u.pm, 1u, __ATOMIC_RELAXED, __HIP_MEMORY_SCOPE_AGENT);
        if (wid == 0) {
            bool dead = false; const unsigned long long t0 = __builtin_amdgcn_s_memrealtime(); const unsigned want = 8u * (unsigned)ntn;
            for (;;) {
#if defined(BROKEN_NO_WAIT)
                break;
#endif
                if ((unsigned)__builtin_amdgcn_readfirstlane(__hip_atomic_load(cnt + 64 * u.pm, __ATOMIC_RELAXED, __HIP_MEMORY_SCOPE_AGENT)) >= want) break;
                if (__builtin_amdgcn_s_memrealtime() - t0 > 2000000ull) {
                    if (lane == 0) { unsigned expect = 0u; __hip_atomic_compare_exchange_strong(tmo + 1, &expect, code | (unsigned)(u.pm & 0xff), __ATOMIC_RELAXED, __ATOMIC_RELAXED, __HIP_MEMORY_SCOPE_AGENT);
                                     __hip_atomic_store(tmo, 1u, __ATOMIC_RELAXED, __HIP_MEMORY_SCOPE_AGENT); }
                    dead = true; break; }
                __builtin_amdgcn_s_sleep(2);
            }
            __builtin_amdgcn_fence(__ATOMIC_ACQUIRE, "agent");
            if (lane == 0) flag[0] = dead ? 1u : 0u;
        }
        asm volatile("s_waitcnt vmcnt(0) lgkmcnt(0)" ::: "memory"); __builtin_amdgcn_s_barrier(); asm volatile("" ::: "memory");
        const bool bad = flag[0] != 0u;
        if (lane < 32) {
            const unsigned long long* slot = (const unsigned long long*)xbuf + (size_t)(u.pm * BM + row) * 4; float mt[4], m2[4]; float ms = 0.f;
#pragma unroll
            for (int t = 0; t < 4; ++t) { if (t < ntn) { const unsigned long long w = __hip_atomic_load(slot + t, __ATOMIC_RELAXED, __HIP_MEMORY_SCOPE_AGENT); mt[t] = __uint_as_float((unsigned)w); m2[t] = __uint_as_float((unsigned)(w >> 32)); } else { mt[t] = 0.f; m2[t] = 0.f; } ms += mt[t]; }
            const float mean = ms / (float)ntn; float q = 0.f;
#pragma unroll
            for (int t = 0; t < 4; ++t) if (t < ntn) { const float dm = mt[t] - mean; q += m2[t] + 256.0f * dm * dm; }
            S[row] = (f32x2v){mean, 1.0f / sqrtf(q / (256.0f * (float)ntn) + eps)};
        }
        asm volatile("s_waitcnt lgkmcnt(0)" ::: "memory"); __builtin_amdgcn_s_barrier(); asm volatile("" ::: "memory");
        return bad;
    }
};
struct EpiLnRes {
    static constexpr bool PERM = false, AFTER_DRAIN = true;
    const float* base; float* out; int ldc; const float* bias; PanelStats st; unsigned poison;
    __device__ __forceinline__ void refuse(size_t i0, size_t stride, int M, int N) const { const float q = __builtin_nanf(""); for (size_t i = i0; i < (size_t)M * N; i += stride) out[(i / N) * ldc + i % N] = q;
        if (i0 == 0) { unsigned expect = 0u; __hip_atomic_compare_exchange_strong(st.tmo + 1, &expect, 0x7f0u, __ATOMIC_RELAXED, __ATOMIC_RELAXED, __HIP_MEMORY_SCOPE_AGENT); __hip_atomic_store(st.tmo, 1u, __ATOMIC_RELAXED, __HIP_MEMORY_SCOPE_AGENT); } }
    __device__ __forceinline__ void fused(f32x4 (&acc)[2][2][4][2], const Unit& u, int wr, int wc, int fr, int fq, PG8_LAS unsigned char* lds, int wid, int lane) const {
        typedef float f32x2v __attribute__((ext_vector_type(2)));
        const PG8_LAS f32x2v* S = (const PG8_LAS f32x2v*)(lds + 8192);
        const int col0 = u.pn * BM + wc * 32 + 4 * fq;
#pragma unroll
        for (int bj = 0; bj < 2; ++bj)
#pragma unroll
            for (int n = 0; n < 2; ++n) { const f32x4 bv = bias ? *(const f32x4*)(bias + col0 + bj * HALF + n * 16) : (f32x4){0.f, 0.f, 0.f, 0.f};
#pragma unroll
                for (int ai = 0; ai < 2; ++ai)
#pragma unroll
                    for (int m = 0; m < 4; ++m) acc[ai][bj][m][n] += bv; }
        const bool bad = st.run(acc, u, wr, wc, fr, fq, lds, wid, lane) || poison != 0u;
        const float qnan = __builtin_nanf("");
#pragma unroll
        for (int ai = 0; ai < 2; ++ai)
#pragma unroll
            for (int m = 0; m < 4; ++m) { const int r = ai * HALF + wr * 64 + m * 16 + fr; const f32x2v sr = S[r]; const size_t off = (size_t)(u.pm * BM + r) * ldc + col0;
#pragma unroll
                for (int bj = 0; bj < 2; ++bj)
#pragma unroll
                    for (int n = 0; n < 2; ++n) { const f32x4 bs = *(const f32x4*)(base + off + bj * HALF + n * 16); f32x4 o = bs + (acc[ai][bj][m][n] - sr.x) * sr.y;
                        if (bad) o = (f32x4){qnan, qnan, qnan, qnan}; *(f32x4*)(out + off + bj * HALF + n * 16) = o; }
                asm volatile("" ::: "memory"); }
    }
};
struct EpiLnResLn {
    static constexpr bool PERM = false, AFTER_DRAIN = true;
    const float* base; float* out; bf16_t* xn; int ldc; const float* bias; PanelStats st1, st2; unsigned poison;
    __device__ __forceinline__ void refuse(size_t i0, size_t stride, int M, int N) const { const float q = __builtin_nanf(""); for (size_t i = i0; i < (size_t)M * N; i += stride) { const size_t o = (i / N) * ldc + i % N; out[o] = q; xn[o] = (bf16_t)0x7fc0u; }
        if (i0 == 0) { unsigned expect = 0u; __hip_atomic_compare_exchange_strong(st1.tmo + 1, &expect, 0x7f0u, __ATOMIC_RELAXED, __ATOMIC_RELAXED, __HIP_MEMORY_SCOPE_AGENT); __hip_atomic_store(st1.tmo, 1u, __ATOMIC_RELAXED, __HIP_MEMORY_SCOPE_AGENT); } }
    __device__ __forceinline__ void fused(f32x4 (&acc)[2][2][4][2], const Unit& u, int wr, int wc, int fr, int fq, PG8_LAS unsigned char* lds, int wid, int lane) const {
        typedef float f32x2v __attribute__((ext_vector_type(2))); typedef unsigned u32x2v __attribute__((ext_vector_type(2)));
        const PG8_LAS f32x2v* S = (const PG8_LAS f32x2v*)(lds + 8192);
        const int col0 = u.pn * BM + wc * 32 + 4 * fq;
#pragma unroll
        for (int bj = 0; bj < 2; ++bj)
#pragma unroll
            for (int n = 0; n < 2; ++n) { const f32x4 bv = bias ? *(const f32x4*)(bias + col0 + bj * HALF + n * 16) : (f32x4){0.f, 0.f, 0.f, 0.f};
#pragma unroll
                for (int ai = 0; ai < 2; ++ai)
#pragma unroll
                    for (int m = 0; m < 4; ++m) acc[ai][bj][m][n] += bv; }
        bool bad = st1.run(acc, u, wr, wc, fr, fq, lds, wid, lane) || poison != 0u;
        const float qnan = __builtin_nanf("");
#pragma unroll
        for (int ai = 0; ai < 2; ++ai)
#pragma unroll
            for (int m = 0; m < 4; ++m) { const int r = ai * HALF + wr * 64 + m * 16 + fr; const f32x2v sr = S[r]; const size_t off = (size_t)(u.pm * BM + r) * ldc + col0;
#pragma unroll
                for (int bj = 0; bj < 2; ++bj)
#pragma unroll
                    for (int n = 0; n < 2; ++n) { const f32x4 bs = *(const f32x4*)(base + off + bj * HALF + n * 16); acc[ai][bj][m][n] = bs + (acc[ai][bj][m][n] - sr.x) * sr.y; }
                asm volatile("" : "+v"(acc[ai][0][m][0]), "+v"(acc[ai][0][m][1]), "+v"(acc[ai][1][m][0]), "+v"(acc[ai][1][m][1]));
                if (m & 1) asm volatile("" ::: "memory"); }
        const bool bad1 = bad;
        bad = st2.run(acc, u, wr, wc, fr, fq, lds, wid, lane) || bad;
#pragma unroll
        for (int ai = 0; ai < 2; ++ai)
#pragma unroll
            for (int m = 0; m < 4; ++m) { const int r = ai * HALF + wr * 64 + m * 16 + fr; const f32x2v sr = S[r]; const size_t off = (size_t)(u.pm * BM + r) * ldc + col0;
#pragma unroll
                for (int bj = 0; bj < 2; ++bj)
#pragma unroll
                    for (int n = 0; n < 2; ++n) { const f32x4 x1 = acc[ai][bj][m][n]; *(f32x4*)(out + off + bj * HALF + n * 16) = bad1 ? (f32x4){qnan, qnan, qnan, qnan} : x1;
                        const f32x4 o = (x1 - sr.x) * sr.y; u32x2v w; w.x = cvt_pk_bf16(o[0], o[1]); w.y = cvt_pk_bf16(o[2], o[3]);
                        if (bad) { w.x = 0x7fc07fc0u; w.y = 0x7fc07fc0u; } *(u32x2v*)(xn + off + bj * HALF + n * 16) = w; }
                asm volatile("" ::: "memory"); }
    }
};

template <class Epi, class Sched, bool STAMP = false, bool GATHER = false>
__device__ __forceinline__ void gemm_phase(PG8_LAS unsigned char* lds, const Gemm g, const Sched& S, const Epi& E, unsigned long long* stamps, int wid_in) {
    const int wid = wid_in, lane = lane_id(), tid = wid * 64 + lane, wr = wid >> 2, wc = wid & 3, fr = lane & 15, fq = lane >> 4;
    const int K = g.K, nt = K / BK;
    int ts_lo = 0, ts_hi = 0, nts = 0; const unsigned long long rt_entry = STAMP ? (unsigned long long)wall_clock64() : 0ull;
#define PG8_STAMP() do { if (STAMP && wid == 0 && nts < 64) { const unsigned long long _c = (unsigned long long)clock64(); \
        ts_lo = (lane == nts) ? (int)(unsigned)_c : ts_lo; ts_hi = (lane == nts) ? (int)(unsigned)(_c >> 32) : ts_hi; ++nts; } } while (0)
    PG8_STAMP();
    unsigned voffA[2], voffB[2]; int RA[2], CA[2];
#pragma unroll
    for (int i = 0; i < 2; ++i) { int R, C; stage_rc(tid * 16 + i * 8192, R, C); const int Rb = Epi::PERM ? ((R & ~31) + perm32(R & 31)) : R; RA[i] = R; CA[i] = C;
        voffA[i] = (unsigned)(R * K + C) * 2u; voffB[i] = (unsigned)(Rb * K + C) * 2u; }
    unsigned vga[2][2], vgn[2][2];
#define PG8_GIDX(dst, u_) do { _Pragma("unroll") for (int _h = 0; _h < 2; ++_h) _Pragma("unroll") for (int _i = 0; _i < 2; ++_i) { int _r = g.aidx[(u_).pm * BM + _h * HALF + RA[_i]]; _r = ((unsigned)_r < (unsigned)g.M) ? _r : 0; \
        dst[_h][_i] = (unsigned)(_r * K + CA[_i]) * 2u; } } while (0)
    const size_t kstep = (size_t)(BK * 2);
    const size_t hstep = (size_t)HALF * K * 2;
    const size_t tstep = 2 * hstep;
    const unsigned ldsw = (unsigned)wid * 1024u;
    const int aoff = lds_byte(wr * 64 + fr, fq * 8), boff = lds_byte(wc * 32 + fr, fq * 8);
#define PG8_SA(b, h) (((b) * 2 + (h)) * HTB)
#define PG8_SB(b, h) ((4 + (b) * 2 + (h)) * HTB)
#define PG8_STAGE(bufoff, gbase, voff) do { _Pragma("unroll") for (int _i = 0; _i < 2; ++_i) \
        __builtin_amdgcn_global_load_lds((const unsigned*)((const char*)(gbase) + (voff)[_i]), (PG8_LAS unsigned*)(lds + (bufoff) + ldsw + _i * 8192), 16, 0, 0); } while (0)
#define PG8_STA(bufoff, isnext, h, kt) do { if constexpr (GATHER) { const char* _gb = (const char*)g.A + (size_t)(kt) * kstep; \
        _Pragma("unroll") for (int _i = 0; _i < 2; ++_i) __builtin_amdgcn_global_load_lds((const unsigned*)(_gb + ((isnext) ? vgn[h][_i] : vga[h][_i])), (PG8_LAS unsigned*)(lds + (bufoff) + ldsw + _i * 8192), 16, 0, 0); } \
    else { const char* _gb = ((isnext) ? nA : cA) + (size_t)(h) * hstep + (size_t)(kt) * kstep; PG8_STAGE(bufoff, _gb, voffA); } } while (0)
#define PG8_LDA(dst, b, h) do { _Pragma("unroll") for (int m = 0; m < 4; ++m) _Pragma("unroll") for (int k = 0; k < 2; ++k) dst[m][k] = *(const PG8_LAS bf16x8*)(lds + PG8_SA(b, h) + aoff + m * 2048 + k * 1024); } while (0)
#define PG8_LDB(dst, b, h) do { _Pragma("unroll") for (int n = 0; n < 2; ++n) _Pragma("unroll") for (int k = 0; k < 2; ++k) dst[n][k] = *(const PG8_LAS bf16x8*)(lds + PG8_SB(b, h) + boff + n * 2048 + k * 1024); } while (0)
#define PG8_MMA(ai, bj, At, Bt) do { __builtin_amdgcn_s_setprio(1); _Pragma("unroll") for (int m = 0; m < 4; ++m) _Pragma("unroll") for (int n = 0; n < 2; ++n) _Pragma("unroll") for (int k = 0; k < 2; ++k) \
        acc[ai][bj][m][n] = __builtin_amdgcn_mfma_f32_16x16x32_bf16(Bt[n][k], At[m][k], acc[ai][bj][m][n], 0, 0, 0); __builtin_amdgcn_s_setprio(0); } while (0)
#define PG8_WAIT_V(n) asm volatile("s_waitcnt vmcnt(" #n ")" ::: "memory")
#define PG8_WAIT_L(n) asm volatile("s_waitcnt lgkmcnt(" #n ")" ::: "memory")
#define PG8_BAR __builtin_amdgcn_s_barrier()
#define PG8_SCHED __builtin_amdgcn_sched_barrier(0)
    Unit cur, nxt; int ui = 0;
    if (!S.next(0, cur)) return;
    f32x4 acc[2][2][4][2];
#pragma unroll
    for (int a = 0; a < 2; ++a)
#pragma unroll
        for (int b = 0; b < 2; ++b)
#pragma unroll
            for (int m = 0; m < 4; ++m)
#pragma unroll
                for (int n = 0; n < 2; ++n) acc[a][b][m][n] = (f32x4){0.f, 0.f, 0.f, 0.f};
    bf16x8 At[4][2], B0[2][2], B1[2][2];
    const char* cA = (const char*)g.A + (size_t)cur.pm * tstep; const char* cB = (const char*)g.Bt + (size_t)cur.pn * tstep;
    S.a_ready(cur);
    const char* nA = cA;
    if constexpr (GATHER) { PG8_GIDX(vga, cur); }
    PG8_STAGE(PG8_SB(0, 0), cB, voffB); PG8_STA(PG8_SA(0, 0), false, 0, 0); PG8_STAGE(PG8_SB(0, 1), cB + hstep, voffB); PG8_STA(PG8_SA(0, 1), false, 1, 0);
    if (wr == 1) PG8_BAR;
    PG8_WAIT_V(4); PG8_BAR;
    PG8_STAGE(PG8_SB(1, 0), cB + kstep, voffB); PG8_STA(PG8_SA(1, 0), false, 0, 1); PG8_STAGE(PG8_SB(1, 1), cB + hstep + kstep, voffB);
    PG8_WAIT_V(6); PG8_BAR;
    PG8_STAMP();
    for (;;) {
        const bool has_next = S.next(ui + 1, nxt);
        nA = has_next ? (const char*)g.A + (size_t)nxt.pm * tstep : cA; const char* nB = has_next ? (const char*)g.Bt + (size_t)nxt.pn * tstep : cB;
        if constexpr (GATHER) { if (has_next) { PG8_GIDX(vgn, nxt); } else { _Pragma("unroll") for (int _h = 0; _h < 2; ++_h) _Pragma("unroll") for (int _i = 0; _i < 2; ++_i) vgn[_h][_i] = vga[_h][_i]; } }
        for (int t = 0; t < nt; t += 2) {
            const bool last = (t == nt - 2);
            const char* b2 = last ? nB : cB + (size_t)(t + 2) * kstep;
            const char* b3 = b2 + kstep;
            const int kt2 = last ? 0 : t + 2;
            if (last && has_next) S.a_ready(nxt);
            PG8_LDB(B0, 0, 0); PG8_SCHED; PG8_LDA(At, 0, 0); PG8_STA(PG8_SA(1, 1), false, 1, t + 1);
            PG8_WAIT_L(8); PG8_BAR; PG8_WAIT_L(0); PG8_MMA(0, 0, At, B0); PG8_BAR; PG8_SCHED;
            PG8_LDB(B1, 0, 1); PG8_STAGE(PG8_SB(0, 0), b2, voffB);
            PG8_BAR; PG8_WAIT_L(0); PG8_MMA(0, 1, At, B1); PG8_BAR;
            PG8_LDA(At, 0, 1); PG8_STA(PG8_SA(0, 0), last, 0, kt2);
            PG8_BAR; PG8_WAIT_L(0); PG8_MMA(1, 0, At, B0); PG8_BAR; PG8_SCHED;
            PG8_STAGE(PG8_SB(0, 1), b2 + hstep, voffB);
            PG8_WAIT_V(6); PG8_BAR; PG8_MMA(1, 1, At, B1); PG8_BAR;
            PG8_LDB(B0, 1, 0); PG8_SCHED; PG8_LDA(At, 1, 0); PG8_STA(PG8_SA(0, 1), last, 1, kt2);
            PG8_WAIT_L(8); PG8_BAR; PG8_WAIT_L(0); PG8_MMA(0, 0, At, B0); PG8_BAR; PG8_SCHED;
            PG8_LDB(B1, 1, 1); PG8_STAGE(PG8_SB(1, 0), b3, voffB);
            PG8_BAR; PG8_WAIT_L(0); PG8_MMA(0, 1, At, B1); PG8_BAR;
            PG8_LDA(At, 1, 1); PG8_STA(PG8_SA(1, 0), last, 0, kt2 + 1);
            PG8_BAR; PG8_WAIT_L(0); PG8_MMA(1, 0, At, B0); PG8_BAR; PG8_SCHED;
            PG8_STAGE(PG8_SB(1, 1), b3 + hstep, voffB);
            PG8_WAIT_V(6); PG8_BAR; PG8_MMA(1, 1, At, B1); PG8_BAR;
        }
        PG8_STAMP();
        if constexpr (!Epi::AFTER_DRAIN) { E(acc, cur, wr, wc, fr, fq); S.done(cur); }
        PG8_STAMP();
        if (!has_next) break;
#pragma unroll
        for (int a = 0; a < 2; ++a)
#pragma unroll
            for (int b = 0; b < 2; ++b)
#pragma unroll
                for (int m = 0; m < 4; ++m)
#pragma unroll
                    for (int n = 0; n < 2; ++n) acc[a][b][m][n] = (f32x4){0.f, 0.f, 0.f, 0.f};
        cur = nxt; cA = nA; cB = nB; ++ui;
        if constexpr (GATHER) { _Pragma("unroll") for (int _h = 0; _h < 2; ++_h) _Pragma("unroll") for (int _i = 0; _i < 2; ++_i) vga[_h][_i] = vgn[_h][_i]; }
    }
    PG8_WAIT_V(0);
    if (wr == 0) PG8_BAR;
    PG8_BAR;
    if constexpr (Epi::AFTER_DRAIN) { E.fused(acc, cur, wr, wc, fr, fq, lds, wid, lane); S.done(cur); }
    PG8_STAMP();
    if (STAMP && wid == 0) { stamps[lane] = lane < nts ? (((unsigned long long)(unsigned)ts_hi << 32) | (unsigned)ts_lo) : 0ull;
        if (lane == 62) stamps[62] = rt_entry; if (lane == 63) stamps[63] = (unsigned long long)wall_clock64(); }
#undef PG8_STAMP
#undef PG8_SA
#undef PG8_SB
#undef PG8_STAGE
#undef PG8_STA
#undef PG8_GIDX
#undef PG8_LDA
#undef PG8_LDB
#undef PG8_MMA
#undef PG8_WAIT_V
#undef PG8_WAIT_L
#undef PG8_BAR
#undef PG8_SCHED
}
}
constexpr int D = 1024, NB = 2, SEQ = 8192, CTXL = 256;
constexpr int TX = NB * SEQ;
constexpr int TC = NB * CTXL;
constexpr int TR = TX + TC;
constexpr float EPS = 1e-6f;
constexpr int NEXP = 16, CAPX = 1024, CAPC = 32, EROWS = 2304;
constexpr int FF = 2048;
constexpr int NKEY = CTXL + SEQ;
constexpr int RRS = 16896;
constexpr float QSCALE = 0.125f * 1.4426950408889634f;

enum { I_X = 0, I_C, I_CTX, I_CCTX, I_ADAW, I_ADAB, I_SGWIN, I_SGBIN, I_SGVG, I_SGWS, I_SGBS, I_SGWOUT, I_SGBOUT,
       I_HYWIN, I_HYBIN, I_HYCW, I_HYCB, I_HYFW1, I_HYFB1, I_HYFW2, I_HYFB2, I_HYFW3, I_HYFB3, I_HYFREQ, I_HYFWOUT, I_HYSKIP, I_HYWOUT, I_HYBOUT,
       I_DAWIN, I_DAQG, I_DAKG, I_DALQ1, I_DALK1, I_DALQ2, I_DALK2, I_DASUB, I_DAWOUT, I_ROUTER, I_WGATE, I_WUP, I_WDOWN, N_IN };

constexpr size_t MiB = 1u << 20;
constexpr size_t WS_CTL = 0, CTL_ZERO_BYTES = 1 * MiB;
constexpr size_t WS_MOD = 1 * MiB;
constexpr size_t WS_ROPE = 2 * MiB;
constexpr size_t WS_WRT = 2 * MiB + 512 * 1024;
constexpr size_t WS_HID = 3 * MiB;
constexpr int UTS = 8192;
constexpr int FQ_LSEG = 16, FQ_CSEG = 4;
constexpr size_t WS_FSQP = 6 * MiB;
constexpr size_t WS_AFF = 9 * MiB;
constexpr int AFFC_OFF = 2 * 16 * 8192;
constexpr size_t WS_TOKSLOT = 11 * MiB;
constexpr size_t WS_SELTOK = 13 * MiB;
constexpr size_t WS_SELG = 13 * MiB + 512 * 1024;
constexpr size_t WS_WSBD = 14 * MiB;
constexpr size_t WS_WSGIN = 16 * MiB, WS_WSGOUT = 32 * MiB, WS_WHYIN = 40 * MiB, WS_WHYOUT = 46 * MiB, WS_WDAIN = 48 * MiB, WS_WDAOUT = 54 * MiB;
constexpr size_t WS_VSQ = 56 * MiB;
constexpr size_t WS_WGU = 64 * MiB;
constexpr size_t WS_WDN = 576 * MiB;
constexpr size_t WS_X = 832 * MiB;
constexpr size_t WS_H = 898 * MiB;
constexpr size_t WS_BUF1 = 932 * MiB;
constexpr size_t WS_BUF2 = 1064 * MiB;
constexpr size_t WS_BUF3 = 1164 * MiB;
constexpr size_t WS_Y = 1232 * MiB;
constexpr size_t WS_RR = 1304 * MiB;
constexpr size_t WS_RRC = 1436 * MiB;
constexpr size_t WS_END = 1440 * MiB;
constexpr int CW_PRO = 8192;
constexpr int CW_BAR = 4096;

constexpr int RING_BYTES = 131072;
constexpr int LDS_BYTES = 163840;
constexpr int MISC_OFF = LDS_BYTES - 256;
constexpr int NWAVES = 8, NTHR = 512;

struct Args { const float* in[N_IN]; float* out; unsigned char* ws; int ph_lo, ph_hi; };
static_assert(sizeof(Args) == N_IN * 8 + 8 + 8 + 8, "Args has no padding");

DI int mod_index(int row) { return row < TX ? (row >> 13) : 2; }
DI const float* modp(const Args& a, int layer, int mi, int piece) { return (const float*)(a.ws + WS_MOD) + ((size_t)(layer * 3 + mi) * 6 + piece) * 1024; }

namespace pg8 {
struct MoeOrder {
    int MT, NT, G, c;
    __device__ bool next(int i, Unit& u) const {
        int e, r;
        if ((G & 7) == 0) { const int per = 2 * MT * NT; const int uu = i * (G >> 3) + (c >> 3); if (uu >= per) return false; e = (c & 7) * 2 + uu / (MT * NT); r = uu % (MT * NT); }
        else { const int L = i * G + c; if (L >= 16 * MT * NT) return false; e = L / (MT * NT); r = L - e * (MT * NT); }
        const int nt = r / MT, mt = r - nt * MT;
        u.pm = e * 9 + mt; u.pn = e * NT + nt; return true;
    }
    __device__ __forceinline__ void a_ready(const Unit&) const {}
    __device__ __forceinline__ void done(const Unit&) const {}
};
struct SpatOrder {
    int nunits, G, c;
    __device__ bool next(int i, Unit& u) const {
        const int L = i * G + c; if (L >= nunits) return false;
        u.pm = L & 3; u.pn = L; return true;
    }
    __device__ __forceinline__ void a_ready(const Unit&) const {}
    __device__ __forceinline__ void done(const Unit&) const {}
};
struct EpiRes {
    static constexpr bool PERM = false, AFTER_DRAIN = false;
    float* X; const float* bias; const float* gate0;
    __device__ __forceinline__ void operator()(const f32x4 (&acc)[2][2][4][2], const Unit& u, int wr, int wc, int fr, int fq) const {
        const int row0 = u.pm * BM + wr * 64 + fr, col0 = u.pn * BM + wc * 32 + 4 * fq;
        const int mi = (u.pm * BM) < TX ? ((u.pm * BM) >> 13) : 2;
        const float* gate = gate0 + (size_t)mi * 6 * 1024;
#pragma unroll
        for (int bj = 0; bj < 2; ++bj)
#pragma unroll
            for (int n = 0; n < 2; ++n) {
                const f32x4 bv = bias ? *(const f32x4*)(bias + col0 + bj * HALF + n * 16) : (f32x4){0.f, 0.f, 0.f, 0.f}; const f32x4 gv = *(const f32x4*)(gate + col0 + bj * HALF + n * 16);
#pragma unroll
                for (int ai = 0; ai < 2; ++ai)
#pragma unroll
                    for (int m = 0; m < 4; ++m) { f32x4* p = (f32x4*)(X + (size_t)(row0 + ai * HALF + m * 16) * 1024 + col0 + bj * HALF + n * 16); *p = *p + gv * (acc[ai][bj][m][n] + bv); }
                asm volatile("" ::: "memory"); }
    }
};
struct EpiSwiGLU {
    static constexpr bool PERM = true, AFTER_DRAIN = false;
    bf16_t* O;
    __device__ __forceinline__ void operator()(const f32x4 (&acc)[2][2][4][2], const Unit& u, int wr, int wc, int fr, int fq) const {
        const int row0 = u.pm * BM + wr * 64 + fr; const int e = u.pm / 9; const int pnl = u.pn - e * 16;
        const int col0 = pnl * 128 + wc * 16 + 4 * fq;
#pragma unroll
        for (int ai = 0; ai < 2; ++ai)
#pragma unroll
            for (int m = 0; m < 4; ++m) { bf16_t* rowp = O + (size_t)(row0 + ai * HALF + m * 16) * 2048 + col0;
#pragma unroll
                for (int bj = 0; bj < 2; ++bj) { const f32x4 g = acc[ai][bj][m][0], up = acc[ai][bj][m][1]; f32x4 h;
#pragma unroll
                    for (int j = 0; j < 4; ++j) h[j] = g[j] * __builtin_amdgcn_rcpf(1.0f + __expf(-g[j])) * up[j];
                    u32x2 w; w.x = cvt_pk_bf16(h[0], h[1]); w.y = cvt_pk_bf16(h[2], h[3]);
                    *(u32x2*)(rowp + bj * 64) = w; } }
    }
};
struct EpiDown {
    static constexpr bool PERM = true, AFTER_DRAIN = false;
    bf16_t* O; const float* g;
    __device__ __forceinline__ void operator()(const f32x4 (&acc)[2][2][4][2], const Unit& u, int wr, int wc, int fr, int fq) const {
        const int row0 = u.pm * BM + wr * 64 + fr; const int e = u.pm / 9; const int pnl = u.pn - e * 4;
        const int col0 = pnl * BM + wc * 32 + 8 * fq;
        float gsv[2][4];
#pragma unroll
        for (int ai = 0; ai < 2; ++ai)
#pragma unroll
            for (int m = 0; m < 4; ++m) gsv[ai][m] = g[row0 + ai * HALF + m * 16];
#pragma unroll
        for (int ai = 0; ai < 2; ++ai)
#pragma unroll
            for (int m = 0; m < 4; ++m) { const int row = row0 + ai * HALF + m * 16; const float gs = gsv[ai][m]; bf16_t* rowp = O + (size_t)row * 1024 + col0;
#pragma unroll
                for (int bj = 0; bj < 2; ++bj) { const f32x4 v0 = acc[ai][bj][m][0] * gs, v1 = acc[ai][bj][m][1] * gs;
                    u32x4 w; w.x = cvt_pk_bf16(v0[0], v0[1]); w.y = cvt_pk_bf16(v0[2], v0[3]); w.z = cvt_pk_bf16(v1[0], v1[1]); w.w = cvt_pk_bf16(v1[2], v1[3]);
                    *(u32x4*)(rowp + bj * HALF) = w; } }
    }
};
struct EpiSpat {
    static constexpr bool PERM = true, AFTER_DRAIN = false;
    bf16_t* TT; const bf16_t* ZZ; const float* bs;
    __device__ __forceinline__ void operator()(const f32x4 (&acc)[2][2][4][2], const Unit& u, int wr, int wc, int fr, int fq) const {
        const int chunk = u.pn >> 2, gp = u.pn & 3;
        asm volatile("" : "+v"(fr), "+v"(fq));
        const unsigned lz = (unsigned)(fr * 4096 + 8 * fq) * 2u, lt = (unsigned)(fr * 2048 + 8 * fq) * 2u;
#pragma unroll
        for (int ai = 0; ai < 2; ++ai)
#pragma unroll
            for (int mp = 0; mp < 2; ++mp) {
                const int g = 2 * gp + ai;
                u32x4 uu[2][2]; float bb[2];
#pragma unroll
                for (int mm = 0; mm < 2; ++mm) { const int pu = wr * 64 + (2 * mp + mm) * 16; bb[mm] = bs[g * 128 + pu + fr];
#pragma unroll
                    for (int bj = 0; bj < 2; ++bj) { const int chu = g * 256 + bj * HALF + wc * 32; uu[mm][bj] = *(const u32x4*)((const char*)(ZZ + ((size_t)chunk * 128 + pu) * 4096 + chu) + lz); } }
#pragma unroll
                for (int mm = 0; mm < 2; ++mm) { const int m = 2 * mp + mm; const int pu = wr * 64 + m * 16; const float b = bb[mm];
#pragma unroll
                    for (int bj = 0; bj < 2; ++bj) { const int chu = g * 256 + bj * HALF + wc * 32; const u32x4 u4 = uu[mm][bj];
                        const f32x4 v0 = acc[ai][bj][m][0] + b, v1 = acc[ai][bj][m][1] + b;
                        u32x4 w;
                        w.x = cvt_pk_bf16(__uint_as_float(u4.x << 16) * v0[0], __uint_as_float(u4.x & 0xffff0000u) * v0[1]);
                        w.y = cvt_pk_bf16(__uint_as_float(u4.y << 16) * v0[2], __uint_as_float(u4.y & 0xffff0000u) * v0[3]);
                        w.z = cvt_pk_bf16(__uint_as_float(u4.z << 16) * v1[0], __uint_as_float(u4.z & 0xffff0000u) * v1[1]);
                        w.w = cvt_pk_bf16(__uint_as_float(u4.w << 16) * v1[2], __uint_as_float(u4.w & 0xffff0000u) * v1[3]);
                        *(u32x4*)((char*)(TT + ((size_t)chunk * 128 + pu) * 2048 + chu) + lt) = w; } }
                asm volatile("" ::: "memory"); }
    }
};
}
struct CvtTile { const float* src; bf16_t* dst; int K, N, mode; };
constexpr int CVT_SG = 384, CVT_MOE = 6144, CVT_PROJ = 256;
constexpr int CVT_T_MOE0 = CVT_SG, CVT_T_HY = CVT_T_MOE0 + CVT_MOE, CVT_T_MOE1 = CVT_T_HY + CVT_PROJ, CVT_T_DA = CVT_T_MOE1 + CVT_MOE, CVT_T_MOE2 = CVT_T_DA + CVT_PROJ,
              CVT_T_SG3 = CVT_T_MOE2 + CVT_MOE, CVT_T_MOE3 = CVT_T_SG3 + CVT_SG, CVT_NTILES = CVT_T_MOE3 + CVT_MOE;
DI void cvt_sg(const Args& a, int j, int& r, CvtTile& d) {
    unsigned char* ws = a.ws;
    if (r < 256) { d.K = 1024; d.N = 4096; d.mode = 0; d.src = a.in[I_SGWIN] + (size_t)j * 1024 * 4096; d.dst = (bf16_t*)(ws + WS_WSGIN) + (size_t)j * 4096 * 1024; }
    else { r -= 256; d.K = 2048; d.N = 1024; d.mode = 0; d.src = a.in[I_SGWOUT] + (size_t)j * 2048 * 1024; d.dst = (bf16_t*)(ws + WS_WSGOUT) + (size_t)j * 1024 * 2048; }
}
DI void cvt_moe(const Args& a, int layer, int& r, CvtTile& d) {
    unsigned char* ws = a.ws; const int which = r >> 11, mm = layer * 16 + ((r >> 7) & 15); r &= 127;
    if (which == 0) { d.K = 1024; d.N = 2048; d.mode = 1; d.src = a.in[I_WGATE] + (size_t)mm * 1024 * 2048; d.dst = (bf16_t*)(ws + WS_WGU) + (size_t)mm * 4096 * 1024; }
    else if (which == 1) { d.K = 1024; d.N = 2048; d.mode = 2; d.src = a.in[I_WUP] + (size_t)mm * 1024 * 2048; d.dst = (bf16_t*)(ws + WS_WGU) + (size_t)mm * 4096 * 1024; }
    else { d.K = 2048; d.N = 1024; d.mode = 0; d.src = a.in[I_WDOWN] + (size_t)mm * 2048 * 1024; d.dst = (bf16_t*)(ws + WS_WDN) + (size_t)mm * 1024 * 2048; }
}
DI void cvt_decode(const Args& a, int t, CvtTile& d) {
    unsigned char* ws = a.ws; int r = t;
    if (r < CVT_T_MOE0) cvt_sg(a, 0, r, d);
    else if (r < CVT_T_HY) { r -= CVT_T_MOE0; cvt_moe(a, 0, r, d); }
    else if (r < CVT_T_MOE1) { r -= CVT_T_HY; if (r < 192) { d.K = 1024; d.N = 3072; d.mode = 0; d.src = a.in[I_HYWIN]; d.dst = (bf16_t*)(ws + WS_WHYIN); } else { r -= 192; d.K = 1024; d.N = 1024; d.mode = 0; d.src = a.in[I_HYWOUT]; d.dst = (bf16_t*)(ws + WS_WHYOUT); } }
    else if (r < CVT_T_DA) { r -= CVT_T_MOE1; cvt_moe(a, 1, r, d); }
    else if (r < CVT_T_MOE2) { r -= CVT_T_DA; if (r < 192) { d.K = 1024; d.N = 3072; d.mode = 0; d.src = a.in[I_DAWIN]; d.dst = (bf16_t*)(ws + WS_WDAIN); } else { r -= 192; d.K = 1024; d.N = 1024; d.mode = 0; d.src = a.in[I_DAWOUT]; d.dst = (bf16_t*)(ws + WS_WDAOUT); } }
    else if (r < CVT_T_SG3) { r -= CVT_T_MOE2; cvt_moe(a, 2, r, d); }
    else if (r < CVT_T_MOE3) { r -= CVT_T_SG3; cvt_sg(a, 1, r, d); }
    else { r -= CVT_T_MOE3; cvt_moe(a, 3, r, d); }
    const int ntn = d.N >> 7; const int kt = r / ntn, nt = r - kt * ntn;
    d.src += (size_t)(kt * 128) * d.N + nt * 128; d.dst += kt * 128;
    d.mode |= (nt << 8);
}
DI void cvt_load(const CvtTile& d, float (&v)[32], int tid) {
    const int nl = tid & 127, kq = tid >> 7; const float* p = d.src + (size_t)(kq * 32) * d.N + nl;
#pragma unroll
    for (int i = 0; i < 32; ++i) v[i] = p[(size_t)i * d.N];
}
DI void cvt_pack(LAS unsigned* L, const float (&v)[32], int tid) {
    const int nl = tid & 127, kq = tid >> 7;
#pragma unroll
    for (int i = 0; i < 16; ++i) L[nl * 65 + kq * 16 + i] = pkbf(v[2 * i], v[2 * i + 1]);
}
DI void cvt_store(const LAS unsigned* L, const CvtTile& cur, int tid) {
    const int kq2 = tid & 15, nb = cur.mode >> 8, mode = cur.mode & 255;
#pragma unroll
    for (int j = 0; j < 4; ++j) { const int n = (tid >> 4) + 32 * j; const LAS unsigned* lp = L + n * 65 + 4 * kq2;
        u32x4 o; o.x = lp[0]; o.y = lp[1]; o.z = lp[2]; o.w = lp[3];
        const int na = nb * 128 + n; const int row = mode == 0 ? na : (((na >> 2) << 3) + (na & 3) + (mode == 2 ? 4 : 0));
        *(u32x4*)(cur.dst + (size_t)row * cur.K + 8 * kq2) = o; }
}
DI void cvt_load_w(const CvtTile& d, float (&v)[32], int wave, int lane) {
    const int nl = lane & 15, kg = lane >> 4; const float* p = d.src + (size_t)(kg * 32) * d.N + wave * 16 + nl;
#pragma unroll
    for (int i = 0; i < 32; ++i) v[i] = p[(size_t)i * d.N];
}
DI void cvt_pack_w(LAS unsigned* Lw, const float (&v)[32], int lane) {
    const int nl = lane & 15, kg = lane >> 4;
#pragma unroll
    for (int i = 0; i < 16; ++i) Lw[nl * 65 + kg * 16 + i] = pkbf(v[2 * i], v[2 * i + 1]);
}
DI void cvt_store_w(const LAS unsigned* Lw, const CvtTile& cur, int wave, int lane) {
    const int kq2 = lane & 15, nb = cur.mode >> 8, mode = cur.mode & 255;
#pragma unroll
    for (int j = 0; j < 4; ++j) { const int n = (lane >> 4) + 4 * j; const LAS unsigned* lp = Lw + n * 65 + 4 * kq2;
        u32x4 o; o.x = lp[0]; o.y = lp[1]; o.z = lp[2]; o.w = lp[3];
        const int na = nb * 128 + wave * 16 + n; const int row = mode == 0 ? na : (((na >> 2) << 3) + (na & 3) + (mode == 2 ? 4 : 0));
        *(u32x4*)(cur.dst + (size_t)row * cur.K + 8 * kq2) = o; }
}
DI void cvt_range(const Args& a, LAS unsigned char* lds, int tid, int lo, int hi) {
    LAS unsigned* L = (LAS unsigned*)lds;
    int t = lo + blockIdx.x;
    if (t >= hi) return;
    CvtTile cur; cvt_decode(a, t, cur);
    float v[32]; cvt_load(cur, v, tid);
    for (;;) {
        const int tn = t + gridDim.x; const bool more = tn < hi;
        CvtTile nxt = cur; float vn[32];
        if (more) { cvt_decode(a, tn, nxt); cvt_load(nxt, vn, tid); }
        cvt_pack(L, v, tid);
        __syncthreads();
        cvt_store(L, cur, tid);
        __syncthreads();
        if (!more) break;
        t = tn; cur = nxt;
#pragma unroll
        for (int i = 0; i < 32; ++i) v[i] = vn[i];
    }
}
DI void pro0_small(const Args& a, int gtid, int gthreads) {
    bf16_t* sbd = (bf16_t*)(a.ws + WS_WSBD);
    for (int i = gtid; i < 2 * 4 * 256 * 256; i += gthreads) {
        const int col = i & 255, row = (i >> 8) & 255, gp = (i >> 16) & 3, j = i >> 18;
        const int gsel = row >> 7, p = row & 127, gl = col >> 7, q = col & 127;
        const float v = (gsel == gl) ? a.in[I_SGWS][(((size_t)j * 8 + 2 * gp + gsel) * 128 + p) * 128 + q] : 0.f;
        sbd[i] = f2bf1(v);
    }
    float* rope = (float*)(a.ws + WS_ROPE);
    for (int i = gtid; i < 2048; i += gthreads) {
        const int pos = i >> 4, f = i & 15;
        const float inv = powf(10000.0f, -(float)f / 16.0f);
        const float ang = (float)pos * inv;
        rope[2 * i] = cosf(ang); rope[2 * i + 1] = sinf(ang);
    }
    float* wrt = (float*)(a.ws + WS_WRT);
    for (int i = gtid; i < 4 * 16384; i += gthreads) wrt[i] = a.in[I_ROUTER][(size_t)(i >> 14) * 16384 + (i & 1023) * 16 + ((i >> 10) & 15)];
    bf16_t* rr = (bf16_t*)(a.ws + WS_RR);
    for (int i = gtid; i < 2048 * 513; i += gthreads) {
        const int row = i / 513, k = i % 513;
        const int idx = k == 512 ? 0 : 16384 + k;
        rr[(size_t)row * RRS + idx] = 0;
    }
}
DI void pro0_mod(const Args& a, LAS unsigned char* lds, int tid, int lane, int wave) {
    LAS float* sc = (LAS float*)lds;
    for (int i = tid; i < 3072; i += NTHR) { const int r = i >> 10, k = i & 1023; const float v = (r < 2) ? a.in[I_C][r * 1024 + k] : a.in[I_CCTX][k]; sc[i] = v / (1.0f + expf(-v)); }
    __syncthreads();
    LAS float* red = (LAS float*)(lds + 12288);
    float* MOD = (float*)(a.ws + WS_MOD);
    for (int it = blockIdx.x; it < 384; it += gridDim.x) {
        const int l = it / 96, cg = it % 96, col = cg * 64 + lane;
        const float* w = a.in[I_ADAW] + (size_t)l * 1024 * 6144 + col;
        float a0 = 0.f, a1 = 0.f, a2 = 0.f;
#pragma unroll 16
        for (int k = wave * 128; k < wave * 128 + 128; ++k) { const float wv = w[(size_t)k * 6144]; a0 += sc[k] * wv; a1 += sc[1024 + k] * wv; a2 += sc[2048 + k] * wv; }
        red[(wave * 3 + 0) * 64 + lane] = a0; red[(wave * 3 + 1) * 64 + lane] = a1; red[(wave * 3 + 2) * 64 + lane] = a2;
        __syncthreads();
        if (wave < 3) { float s = 0.f;
#pragma unroll
            for (int w8 = 0; w8 < 8; ++w8) s += red[(w8 * 3 + wave) * 64 + lane];
            MOD[(size_t)(l * 3 + wave) * 6144 + col] = s + a.in[I_ADAB][l * 6144 + col]; }
        __syncthreads();
    }
}
DI void pro0_filter1(const Args& a, int lane, int gw, int NGW) {
    float w1c[33], w2c[64], w3c[64];
#pragma unroll
    for (int i = 0; i < 33; ++i) w1c[i] = a.in[I_HYFW1][i * 64 + lane];
#pragma unroll
    for (int i = 0; i < 64; ++i) { w2c[i] = a.in[I_HYFW2][i * 64 + lane]; w3c[i] = a.in[I_HYFW3][i * 64 + lane]; }
    const float b1 = a.in[I_HYFB1][lane], b2 = a.in[I_HYFB2][lane], b3 = a.in[I_HYFB3][lane], fr = a.in[I_HYFREQ][lane];
    float* HID = (float*)(a.ws + WS_HID);
    for (int tt = gw; tt < 8448; tt += NGW) {
        const int n = tt < 8192 ? 8192 : 256, t = tt < 8192 ? tt : tt - 8192;
        const float tl = (float)t / (float)(n - 1);
        const float w = (6.283185307179586f / (float)n) * (float)t;
        float z = tl;
        if (lane >= 1 && lane <= 16) { const float f = 1e-4f + (float)(lane - 1) * ((15.0f - 1e-4f) / 15.0f); z = cosf(f * w); }
        else if (lane >= 17 && lane <= 32) { const float f = 1e-4f + (float)(lane - 17) * ((15.0f - 1e-4f) / 15.0f); z = -sinf(f * w); }
        float p = b1;
#pragma unroll
        for (int i = 0; i < 33; ++i) p += __uint_as_float(__builtin_amdgcn_readlane(__float_as_uint(z), i)) * w1c[i];
        float h = sinf(fr * p);
        p = b2;
#pragma unroll
        for (int i = 0; i < 64; ++i) p += __uint_as_float(__builtin_amdgcn_readlane(__float_as_uint(h), i)) * w2c[i];
        h = sinf(fr * p);
        p = b3;
#pragma unroll
        for (int i = 0; i < 64; ++i) p += __uint_as_float(__builtin_amdgcn_readlane(__float_as_uint(h), i)) * w3c[i];
        h = sinf(fr * p);
        HID[(size_t)tt * 64 + lane] = h;
    }
}
DI void split_bf16(const float (&x)[8], bf16x8& hi, bf16x8& lo) {
    u32x4 h, l;
    unsigned hw[4], lw[4];
#pragma unroll
    for (int i = 0; i < 4; ++i) { const unsigned p = pkbf(x[2 * i], x[2 * i + 1]); hw[i] = p; lw[i] = pkbf(x[2 * i] - bflo(p), x[2 * i + 1] - bfhi(p)); }
    h.x = hw[0]; h.y = hw[1]; h.z = hw[2]; h.w = hw[3]; l.x = lw[0]; l.y = lw[1]; l.z = lw[2]; l.w = lw[3];
    hi = __builtin_bit_cast(bf16x8, h); lo = __builtin_bit_cast(bf16x8, l);
}
DI void pro1_filter2(const Args& a, LAS unsigned char* lds, int lane, int gw, int NGW) {
    LAS unsigned char* SG = lds + 34816 + (gw & 7) * 4608;
    const float* HID = (const float*)(a.ws + WS_HID);
    const float* wout = a.in[I_HYFWOUT];
    float* FSQP = (float*)(a.ws + WS_FSQP);
    bf16_t* RR0 = (bf16_t*)(a.ws + WS_RR);
    float* RRC = (float*)(a.ws + WS_RRC);
    const float dmin = logf(0.01f) / 1.5f, dmax = logf(0.01f) / 0.3f;
    const int l32 = lane & 31, kg = lane >> 5;
    const int G_ = NGW >> 3, uw = (gw & 7) * G_ + (gw >> 3);
    for (int unit = uw; unit < 128 * (FQ_LSEG + FQ_CSEG); unit += NGW) {
        const int ct = unit & 127, seg = unit >> 7;
        const int col0 = ct * 32, o = col0 >> 11, side = (col0 >> 10) & 1;
        bf16x8 whi[4], wlo[4];
#pragma unroll
        for (int ks = 0; ks < 4; ++ks) { float w[8];
#pragma unroll
            for (int j = 0; j < 8; ++j) w[j] = wout[(size_t)(16 * ks + 8 * kg + j) * 4096 + col0 + l32];
            split_bf16(w, whi[ks], wlo[ks]); }
        const unsigned cc = (unsigned)((col0 + l32) & 1023), row = (unsigned)(o * 1024) + cc;
        const float dl2 = -fabsf(dmin + (float)cc * ((dmax - dmin) / 1023.0f)) * 1.4426950408889634f;
        const bool lat = seg < FQ_LSEG;
        const int n = lat ? 8192 : 256, ntile = lat ? 8192 / FQ_LSEG / 32 : 256 / FQ_CSEG / 32, tbase = lat ? seg * (8192 / FQ_LSEG) : (seg - FQ_LSEG) * (256 / FQ_CSEG), ttoff = lat ? 0 : 8192;
        const float rn1 = 1.0f / (float)(n - 1);
        const int toff = side == 0 ? 1 : 0;
        const bool extra = (side == 0) && tbase == 0;
        const int ntl = ntile + (extra ? 1 : 0);
        float sq = 0.f;
        f32x4 hq[8];
#define FQ_TB(tile) ((tile) == ntile ? 0 : tbase + toff + (tile) * 32)
#define FQ_LOAD(tile) do { int tl_ = FQ_TB(tile) + l32; tl_ = tl_ < n ? tl_ : n - 1;   \
            const f32x4* hp = (const f32x4*)(HID + (size_t)(ttoff + tl_) * 64 + 8 * kg); _Pragma("unroll") for (int ks = 0; ks < 4; ++ks) { hq[2 * ks] = hp[4 * ks]; hq[2 * ks + 1] = hp[4 * ks + 1]; } } while (0)
        FQ_LOAD(0);
        for (int tile = 0; tile < ntl; ++tile) {
            const bool ex = tile == ntile;
            const int tb = FQ_TB(tile);
            f32x16 acc;
#pragma unroll
            for (int r = 0; r < 16; ++r) acc[r] = 0.f;
#pragma unroll
            for (int ks = 0; ks < 4; ++ks) { const f32x4 h0 = hq[2 * ks], h1 = hq[2 * ks + 1]; const float hv[8] = {h0[0], h0[1], h0[2], h0[3], h1[0], h1[1], h1[2], h1[3]};
                bf16x8 hhi, hlo; split_bf16(hv, hhi, hlo);
                acc = MFMA32(hhi, whi[ks], acc); acc = MFMA32(hlo, whi[ks], acc); acc = MFMA32(hhi, wlo[ks], acc); }
            if (tile + 1 < ntl) FQ_LOAD(tile + 1);
#pragma unroll
            for (int g = 0; g < 4; ++g) {
                const int t0g = tb + 8 * g + 4 * kg;
                float v[4];
#pragma unroll
                for (int q = 0; q < 4; ++q) { const int t = t0g + q; const bool ok = ex ? (t == 0) : ((t < n) && !(side == 1 && t == 0));
                    const float x = acc[4 * g + q] * __builtin_amdgcn_exp2f((float)t * rn1 * dl2); v[q] = ok ? x : 0.f; sq += v[q] * v[q]; }
                if (ex) { if (g == 0 && kg == 0) { if (lat) RR0[row * (unsigned)RRS + (unsigned)n] = f2bf1(v[0]); else RRC[row * 512u + (unsigned)n] = v[0]; } }
                else if (lat) { const int tl = (tile & 1) * 32 + 8 * g + 4 * kg;
                    u32x2 w; if (side == 0) { w.x = pkbf(v[3], v[2]); w.y = pkbf(v[1], v[0]); } else { w.x = pkbf(v[0], v[1]); w.y = pkbf(v[2], v[3]); }
                    *(LAS u32x2*)(SG + l32 * 144 + (side == 0 ? 60 - tl : tl) * 2) = w; }
                else if (side == 0) { const unsigned idx = (unsigned)(n - t0g - 3);
                    if (lat) { u32x2 w; w.x = pkbf(v[3], v[2]); w.y = pkbf(v[1], v[0]); *(u32x2*)(RR0 + (row * (unsigned)RRS + idx)) = w; }
                    else *(f32x4*)(RRC + (row * 512u + idx)) = (f32x4){v[3], v[2], v[1], v[0]}; }
                else { const unsigned idx = (unsigned)(n + t0g);
                    if (t0g == 0) {
#pragma unroll
                        for (int q = 1; q < 4; ++q) { if (lat) RR0[row * (unsigned)RRS + idx + q] = f2bf1(v[q]); else RRC[row * 512u + idx + q] = v[q]; } }
                    else if (lat) { u32x2 w; w.x = pkbf(v[0], v[1]); w.y = pkbf(v[2], v[3]); *(u32x2*)(RR0 + (row * (unsigned)RRS + idx)) = w; }
                    else *(f32x4*)(RRC + (row * 512u + idx)) = (f32x4){v[0], v[1], v[2], v[3]}; }
            }
            if (lat && !ex && (tile & 1)) {
                LDS_WAIT(); __builtin_amdgcn_wave_barrier();
                const int tp0 = tb - 32;
                const unsigned idx0 = side == 0 ? (unsigned)(n - tp0 - 63) : (unsigned)(n + tp0);
                const int piece = lane & 7;
#pragma unroll
                for (int j = 0; j < 4; ++j) { const int col = (lane >> 3) + 8 * j;
                    const u32x4 ov = *(const LAS u32x4*)(SG + col * 144 + piece * 16);
                    bf16_t* dp = RR0 + (((unsigned)(o * 1024) + (unsigned)((col0 + col) & 1023)) * (unsigned)RRS + idx0 + (unsigned)piece * 8u);
                    if (side == 1 && tp0 == 0 && piece == 0) {
                        dp[1] = (bf16_t)(ov.x >> 16); *(unsigned*)(dp + 2) = ov.y; *(u32x2*)(dp + 4) = (u32x2){ov.z, ov.w}; }
                    else *(u32x4*)dp = ov; }
                __builtin_amdgcn_wave_barrier();
            }
        }
#undef FQ_TB
#undef FQ_LOAD
        sq += __shfl_xor(sq, 32);
        if (kg == 0) FSQP[(size_t)seg * 4096 + col0 + l32] = sq;
    }
}

template <int LAYER> DI void phase_A(const Args& a, int lane, int gw, int NGW) {
    constexpr int nrows = (LAYER >= 3) ? TX : TR;
    float* X = (float*)(a.ws + WS_X); bf16_t* H = (bf16_t*)(a.ws + WS_H);
    const int* TS = (const int*)(a.ws + WS_TOKSLOT); const bf16_t* Y = (const bf16_t*)(a.ws + WS_Y);
    for (int r = gw; r < nrows; r += NGW) {
        const int mi = mod_index(r);
        f32x4 v[4];
        if (LAYER == 0) { const f32x4* src = (const f32x4*)(r < TX ? a.in[I_X] + (size_t)r * 1024 : a.in[I_CTX] + (size_t)(r - TX) * 1024) + lane;
#pragma unroll
            for (int j = 0; j < 4; ++j) v[j] = src[64 * j]; }
        else {
            const f32x4* src = (const f32x4*)(X + (size_t)r * 1024) + lane;
#pragma unroll
            for (int j = 0; j < 4; ++j) v[j] = src[64 * j];
            const bool has = (r < TX) || (LAYER - 1 <= 1);
            if (has) {
                f32x4 acc[4];
#pragma unroll
                for (int j = 0; j < 4; ++j) acc[j] = (f32x4){0.f, 0.f, 0.f, 0.f};
                const int tsv = lane < 16 ? (r < TX ? TS[(size_t)((r >> 13) * 16 + lane) * 8192 + (r & 8191)] : TS[AFFC_OFF + (((r - TX) >> 8) * 16 + lane) * 256 + ((r - TX) & 255)]) : -1;
                unsigned long long msk = __ballot(tsv >= 0);
                while (msk) {
                    int sl[4], ex[4];
#pragma unroll
                    for (int q = 0; q < 4; ++q) { if (msk) { const int e = __builtin_ctzll(msk); msk &= msk - 1; ex[q] = e; sl[q] = __builtin_amdgcn_readlane(tsv, e); } else { ex[q] = 0; sl[q] = -1; } }
                    u32x2 w[4][4];
#pragma unroll
                    for (int q = 0; q < 4; ++q) { if (sl[q] >= 0) { const u32x2* yp = (const u32x2*)(Y + ((size_t)ex[q] * EROWS + sl[q]) * 1024) + lane;
#pragma unroll
                            for (int j = 0; j < 4; ++j) w[q][j] = yp[64 * j]; }
                        else {
#pragma unroll
                            for (int j = 0; j < 4; ++j) w[q][j] = (u32x2){0u, 0u}; } }
#pragma unroll
                    for (int q = 0; q < 4; ++q)
#pragma unroll
                        for (int j = 0; j < 4; ++j) acc[j] += (f32x4){bflo(w[q][j].x), bfhi(w[q][j].x), bflo(w[q][j].y), bfhi(w[q][j].y)};
                }
                const f32x4* g2 = (const f32x4*)modp(a, LAYER - 1, mi, 5) + lane;
#pragma unroll
                for (int j = 0; j < 4; ++j) v[j] += g2[64 * j] * acc[j];
            }
        }
        if (LAYER == 4) { f32x4* o = (f32x4*)(a.out + (size_t)r * 1024) + lane;
#pragma unroll
            for (int j = 0; j < 4; ++j) o[64 * j] = v[j];
            continue; }
        { f32x4* o = (f32x4*)(X + (size_t)r * 1024) + lane;
#pragma unroll
          for (int j = 0; j < 4; ++j) o[64 * j] = v[j]; }
        float ss = 0.f;
#pragma unroll
        for (int j = 0; j < 4; ++j) ss += (v[j][0] * v[j][0] + v[j][1] * v[j][1]) + (v[j][2] * v[j][2] + v[j][3] * v[j][3]);
        const float rs = 1.0f / sqrtf(wave_sum(ss) * (1.0f / 1024.0f) + EPS);
        constexpr int LY = LAYER < 4 ? LAYER : 0;
        const f32x4* sh = (const f32x4*)modp(a, LY, mi, 0) + lane; const f32x4* sc = (const f32x4*)modp(a, LY, mi, 1) + lane;
        u32x2* ho = (u32x2*)(H + (size_t)r * 1024) + lane;
#pragma unroll
        for (int j = 0; j < 4; ++j) { const f32x4 y = v[j] * rs * (sc[64 * j] + 1.0f) + sh[64 * j]; u32x2 w; w.x = pkbf(y[0], y[1]); w.y = pkbf(y[2], y[3]); ho[64 * j] = w; }
    }
}

template <int LAYER> DI void phase_moe_prep(const Args& a, LAS unsigned char* lds, int tid, int lane, int gw, int NGW) {
    constexpr int nrows = (LAYER >= 2) ? TX : TR;
    LAS float* wr = (LAS float*)lds;
    { const u32x4* src = (const u32x4*)(a.ws + WS_WRT) + (size_t)LAYER * 4096;
#pragma unroll
      for (int n = 0; n < 8; ++n) ((LAS u32x4*)lds)[tid + NTHR * n] = src[tid + NTHR * n]; }
    __syncthreads();
    const float* X = (const float*)(a.ws + WS_X); bf16_t* H = (bf16_t*)(a.ws + WS_H); float* AFF = (float*)(a.ws + WS_AFF);
    const bool b0 = lane & 1, b1 = lane & 2, b2 = lane & 4, b3 = lane & 8, b4 = lane & 16;
    constexpr int NR = 2, NG = nrows / NR, NGX = TX / NR;
    const int nlat = (NGX - gw + NGW - 1) / NGW, tstride = NGW >> 3, ntail = ((gw & 7) == 5 && (gw >> 3) < NG - NGX) ? (NG - NGX - (gw >> 3) + tstride - 1) / tstride : 0;
    const int ntrip = nlat + ntail;
#define MP_GROUP(it) ((it) < nlat ? gw + (it) * NGW : NGX + (gw >> 3) + ((it) - nlat) * tstride)
    f32x4 v[NR][4], nx[NR][4];
    if (ntrip > 0) { const int r0 = NR * MP_GROUP(0);
#pragma unroll
        for (int q = 0; q < NR; ++q) { const f32x4* src = (const f32x4*)(X + (size_t)(r0 + q) * 1024) + lane;
#pragma unroll
            for (int j = 0; j < 4; ++j) v[q][j] = src[64 * j]; } }
    for (int it = 0; it < ntrip; ++it) {
        const int r0 = NR * MP_GROUP(it), mi = mod_index(r0);
        const f32x4* sh = (const f32x4*)modp(a, LAYER, mi, 3) + lane; const f32x4* sc = (const f32x4*)modp(a, LAYER, mi, 4) + lane;
        f32x4 shv[4], scv[4];
#pragma unroll
        for (int j = 0; j < 4; ++j) { shv[j] = sh[64 * j]; scv[j] = sc[64 * j] + 1.0f; }
        if (it + 1 < ntrip) { const int r1 = NR * MP_GROUP(it + 1);
#pragma unroll
            for (int q = 0; q < NR; ++q) { const f32x4* src = (const f32x4*)(X + (size_t)(r1 + q) * 1024) + lane;
#pragma unroll
                for (int j = 0; j < 4; ++j) nx[q][j] = src[64 * j]; } }
#pragma unroll
        for (int q = 0; q < NR; ++q) {
            float ss = 0.f;
#pragma unroll
            for (int j = 0; j < 4; ++j) ss += (v[q][j][0] * v[q][j][0] + v[q][j][1] * v[q][j][1]) + (v[q][j][2] * v[q][j][2] + v[q][j][3] * v[q][j][3]);
            const float rs = 1.0f / sqrtf(wave_sum(ss) * (1.0f / 1024.0f) + EPS);
            u32x2* ho = (u32x2*)(H + (size_t)(r0 + q) * 1024) + lane;
#pragma unroll
            for (int j = 0; j < 4; ++j) { v[q][j] = v[q][j] * rs * scv[j] + shv[j]; u32x2 w; w.x = pkbf(v[q][j][0], v[q][j][1]); w.y = pkbf(v[q][j][2], v[q][j][3]); ho[64 * j] = w; }
        }
        float u[NR];
#pragma unroll
        for (int h = 0; h < 2; ++h) {
            float s[NR][8];
#pragma unroll
            for (int e = 0; e < 8; ++e) {
                f32x4 w4[4];
#pragma unroll
                for (int j = 0; j < 4; ++j) w4[j] = *(const LAS f32x4*)(wr + (8 * h + e) * 1024 + j * 256 + lane * 4);
#pragma unroll
                for (int q = 0; q < NR; ++q) { f32x2 t = (f32x2){0.f, 0.f};
#pragma unroll
                    for (int j = 0; j < 4; ++j) { t += (f32x2){v[q][j][0], v[q][j][1]} * (f32x2){w4[j][0], w4[j][1]}; t += (f32x2){v[q][j][2], v[q][j][3]} * (f32x2){w4[j][2], w4[j][3]}; }
                    s[q][e] = t.x + t.y; }
            }
#pragma unroll
            for (int q = 0; q < NR; ++q) {
                float t4[4], t2[2];
#pragma unroll
                for (int i = 0; i < 4; ++i) t4[i] = (b0 ? s[q][2 * i + 1] : s[q][2 * i]) + dppf<DPP_XOR1>(b0 ? s[q][2 * i] : s[q][2 * i + 1]);
#pragma unroll
                for (int i = 0; i < 2; ++i) t2[i] = (b1 ? t4[2 * i + 1] : t4[2 * i]) + dppf<DPP_XOR2>(b1 ? t4[2 * i] : t4[2 * i + 1]);
                float t1 = (b2 ? t2[1] : t2[0]) + dppf<DPP_ROR(4)>(b2 ? t2[0] : t2[1]);
                t1 += dppf<DPP_ROR(8)>(t1);
                u[q] = (h == 0) ? t1 : (b3 ? t1 : u[q]);
            }
        }
        float lg = (b4 ? u[1] : u[0]) + __shfl_xor(b4 ? u[0] : u[1], 16);
        lg += __shfl_xor(lg, 32);
        const float ex = expf(lg - row_max16(lg)), pr = ex / row_sum16(ex);
        if (lane < 32) { const int r = r0 + (lane >> 4), e = lane & 15;
            if (r < TX) AFF[(size_t)((r >> 13) * 16 + e) * 8192 + (r & 8191)] = pr; else AFF[AFFC_OFF + (((r - TX) >> 8) * 16 + e) * 256 + ((r - TX) & 255)] = pr; }
#pragma unroll
        for (int q = 0; q < NR; ++q)
#pragma unroll
            for (int j = 0; j < 4; ++j) v[q][j] = nx[q][j];
    }
#undef MP_GROUP
}

template <int LAYER> DI void phase_topk(const Args& a, LAS unsigned char* lds, int tid, int lane, int wave) {
    constexpr int nprob = (LAYER >= 2) ? 32 : 64;
    const float* AFF = (const float*)(a.ws + WS_AFF);
    int* TS = (int*)(a.ws + WS_TOKSLOT); int* SELTOK = (int*)(a.ws + WS_SELTOK); float* SELG = (float*)(a.ws + WS_SELG);
    LAS unsigned* red = (LAS unsigned*)lds;
    LAS unsigned* scan = (LAS unsigned*)(lds + 256);
    LAS unsigned* hist = (LAS unsigned*)(lds + 512);
    for (int p = blockIdx.x; p < nprob; p += gridDim.x) {
        const bool isx = p < 32; const int pb = isx ? p : p - 32; const int b = pb >> 4, e = pb & 15;
        const int N = isx ? 8192 : 256, cap = isx ? CAPX : CAPC, rowbase = isx ? b * 8192 : TX + b * 256, slotbase = isx ? b * 1024 : 2048 + b * 32;
        const size_t pbase = isx ? (size_t)pb * 8192 : (size_t)AFFC_OFF + pb * 256;
        unsigned key[16];
        const bool active = tid * 16 < N;
#pragma unroll
        for (int i4 = 0; i4 < 4; ++i4) { u32x4 k4 = (u32x4){0u, 0u, 0u, 0u}; if (active) k4 = *(const u32x4*)(AFF + pbase + tid * 16 + i4 * 4);
            key[4 * i4] = k4.x; key[4 * i4 + 1] = k4.y; key[4 * i4 + 2] = k4.z; key[4 * i4 + 3] = k4.w; }
        unsigned T = 0u; unsigned kneed = (unsigned)cap;
#pragma unroll 1
        for (int pass = 0; pass < 4; ++pass) {
            const int shift = pass == 0 ? 23 : pass == 1 ? 15 : pass == 2 ? 7 : 0;
            const int nbits = pass == 3 ? 7 : 8;
            if (tid < 256) hist[tid] = 0u;
            __syncthreads();
            if (active) {
#pragma unroll
                for (int i = 0; i < 16; ++i) { const unsigned kk = key[i]; if ((kk >> (shift + nbits)) == (T >> (shift + nbits))) __hip_atomic_fetch_add(&hist[(kk >> shift) & ((1u << nbits) - 1u)], 1u, __ATOMIC_RELAXED, __HIP_MEMORY_SCOPE_WORKGROUP); }
            }
            __syncthreads();
            if (wave == 0) {
                const unsigned h0 = hist[4 * lane], h1 = hist[4 * lane + 1], h2 = hist[4 * lane + 2], h3 = hist[4 * lane + 3];
                unsigned suf = h0 + h1 + h2 + h3;
#pragma unroll
                for (int o = 1; o < 64; o <<= 1) { const unsigned t2 = __shfl_down(suf, o); if (lane + o < 64) suf += t2; }
                const unsigned above = suf - (h0 + h1 + h2 + h3);
                unsigned a3 = above, a2 = a3 + h3, a1 = a2 + h2, a0 = a1 + h1;
                int dsel = -1; unsigned asel = 0;
                if (a3 < kneed && kneed <= a3 + h3) { dsel = 4 * lane + 3; asel = a3; }
                else if (a2 < kneed && kneed <= a2 + h2) { dsel = 4 * lane + 2; asel = a2; }
                else if (a1 < kneed && kneed <= a1 + h1) { dsel = 4 * lane + 1; asel = a1; }
                else if (a0 < kneed && kneed <= a0 + h0) { dsel = 4 * lane; asel = a0; }
                if (dsel >= 0) { red[0] = (unsigned)dsel; red[1] = kneed - asel; }
            }
            __syncthreads();
            T |= red[0] << shift; kneed = red[1];
        }
        unsigned cg = 0, ce = 0;
#pragma unroll
        for (int i = 0; i < 16; ++i) { cg += (active && key[i] > T) ? 1u : 0u; ce += (active && key[i] == T) ? 1u : 0u; }
        unsigned ig = cg, ie = ce;
#pragma unroll
        for (int o = 1; o < 64; o <<= 1) { const unsigned tg = __shfl_up(ig, o), te = __shfl_up(ie, o); if (lane >= o) { ig += tg; ie += te; } }
        __syncthreads();
        if (lane == 63) { scan[wave * 2] = ig; scan[wave * 2 + 1] = ie; }
        __syncthreads();
        unsigned bg = 0, be = 0, totg = 0;
#pragma unroll
        for (int w8 = 0; w8 < 8; ++w8) { const unsigned g8 = scan[w8 * 2], e8 = scan[w8 * 2 + 1]; if (w8 < wave) { bg += g8; be += e8; } totg += g8; }
        unsigned pg = bg + ig - cg, pe = be + ie - ce;
        const unsigned need_eq = (unsigned)cap - totg;
        if (active) {
            int slots[16];
#pragma unroll
            for (int i = 0; i < 16; ++i) {
                const int row = rowbase + tid * 16 + i;
                const bool gt = key[i] > T, eq = key[i] == T;
                const bool sel = gt || (eq && pe < need_eq);
                int slot = -1;
                if (sel) { slot = slotbase + (int)(pg + (pe < need_eq ? pe : need_eq)); SELTOK[e * EROWS + slot] = row; SELG[e * EROWS + slot] = __uint_as_float(key[i]); }
                slots[i] = slot;
                pg += gt ? 1u : 0u; pe += eq ? 1u : 0u;
            }
#pragma unroll
            for (int i4 = 0; i4 < 4; ++i4) *(u32x4*)(TS + pbase + tid * 16 + i4 * 4) = (u32x4){(unsigned)slots[4 * i4], (unsigned)slots[4 * i4 + 1], (unsigned)slots[4 * i4 + 2], (unsigned)slots[4 * i4 + 3]};
        }
        __syncthreads();
    }
}

template <int LAYER> DI void phase_gather(const Args& a, int lane, int gw, int NGW) {
    constexpr int ER = (LAYER >= 2) ? 2048 : 2304, VALID = (LAYER >= 2) ? 2048 : 2112;
    const int* SELTOK = (const int*)(a.ws + WS_SELTOK); const bf16_t* H = (const bf16_t*)(a.ws + WS_H); bf16_t* XS = (bf16_t*)(a.ws + WS_BUF1);
    for (int sr = gw; sr < 16 * ER; sr += NGW) {
        const int e = sr / ER, s = sr - e * ER;
        u32x4* dst = (u32x4*)(XS + ((size_t)e * EROWS + s) * 1024) + lane;
        if (s < VALID) { const int row = __builtin_amdgcn_readfirstlane(SELTOK[e * EROWS + s]); const u32x4* src = (const u32x4*)(H + (size_t)row * 1024) + lane; dst[0] = src[0]; dst[64] = src[64]; }
        else { dst[0] = (u32x4){0u, 0u, 0u, 0u}; dst[64] = (u32x4){0u, 0u, 0u, 0u}; }
    }
}

template <int J, int NCHUNK> DI void phase_sg_vnt(const Args& a, LAS unsigned char* lds, int tid, int lane, int wave) {
    const bf16_t* ZZ = (const bf16_t*)(a.ws + WS_BUF1); bf16_t* VNT = (bf16_t*)(a.ws + WS_BUF2);
    const float* VSQ = (const float*)(a.ws + WS_VSQ);
    const float* gain = a.in[I_SGVG] + J * 2048;
    LAS float* rsq = (LAS float*)lds;
    LAS bf16_t* T = (LAS bf16_t*)(lds + 512);
    constexpr int NLAT = TX / 64, NCTXU = (NCHUNK * 2 - NLAT) * 8;
    for (int unit = blockIdx.x; unit < NLAT + NCTXU; unit += gridDim.x) {
        const bool lat = unit < NLAT;
        const int hc = lat ? unit : NLAT + ((unit - NLAT) >> 3);
        const int chunk = hc >> 1, q0 = (hc & 1) * 64;
        const int g0 = lat ? 0 : ((unit - NLAT) & 7), g1 = lat ? 8 : g0 + 1;
        if (lat) {
            const f32x4 p = *(const f32x4*)(VSQ + ((size_t)chunk * 128 + q0 + (tid >> 3)) * 32 + (tid & 7) * 4);
            float ss = (p[0] + p[1]) + (p[2] + p[3]);
            ss += dppf<DPP_XOR1>(ss); ss += dppf<DPP_XOR2>(ss); ss += dppf<0x141>(ss);
            if ((tid & 7) == 0) rsq[tid >> 3] = 1.0f / sqrtf(ss * (1.0f / 2048.0f) + EPS);
        } else {
#pragma unroll
            for (int qb = 0; qb < 2; ++qb) {
                u32x4 w[4][4];
#pragma unroll
                for (int qi = 0; qi < 4; ++qi) { const u32x4* vp = (const u32x4*)(ZZ + ((size_t)chunk * 128 + q0 + wave * 8 + qb * 4 + qi) * 4096 + 2048) + lane;
#pragma unroll
                    for (int j = 0; j < 4; ++j) w[qi][j] = vp[64 * j]; }
#pragma unroll
                for (int qi = 0; qi < 4; ++qi) { float ss = 0.f;
#pragma unroll
                    for (int j = 0; j < 4; ++j) { const u32x4 x = w[qi][j]; const float x0 = bflo(x.x), x1 = bfhi(x.x), x2 = bflo(x.y), x3 = bfhi(x.y), x4 = bflo(x.z), x5 = bfhi(x.z), x6 = bflo(x.w), x7 = bfhi(x.w);
                        ss += (x0 * x0 + x1 * x1) + (x2 * x2 + x3 * x3) + (x4 * x4 + x5 * x5) + (x6 * x6 + x7 * x7); }
                    ss = wave_sum(ss);
                    if (lane == 0) rsq[wave * 8 + qb * 4 + qi] = 1.0f / sqrtf(ss * (1.0f / 2048.0f) + EPS); }
            }
        }
        const int qa = tid >> 5, c8 = (tid & 31) * 8, ng = lat ? 8 : 1;
        u32x4 buf[8][4];
#pragma unroll
        for (int gi = 0; gi < 8; ++gi) if (gi < ng) {
#pragma unroll
            for (int k = 0; k < 4; ++k) buf[gi][k] = *(const u32x4*)(ZZ + ((size_t)chunk * 128 + q0 + qa + 16 * k) * 4096 + 2048 + (g0 + gi) * 256 + c8); }
        __syncthreads();
#pragma unroll
        for (int gi = 0; gi < 8; ++gi) if (gi < ng) {
            const int g = g0 + gi;
            const f32x4 g0v = *(const f32x4*)(gain + g * 256 + c8), g1v = *(const f32x4*)(gain + g * 256 + c8 + 4);
#pragma unroll
            for (int k = 0; k < 4; ++k) { const int q = qa + 16 * k; const u32x4 w = buf[gi][k]; const float r = rsq[q];
                LAS unsigned* tp = (LAS unsigned*)(T + q * 258 + c8);
                tp[0] = pkbf(bflo(w.x) * r * g0v[0], bfhi(w.x) * r * g0v[1]); tp[1] = pkbf(bflo(w.y) * r * g0v[2], bfhi(w.y) * r * g0v[3]);
                tp[2] = pkbf(bflo(w.z) * r * g1v[0], bfhi(w.z) * r * g1v[1]); tp[3] = pkbf(bflo(w.w) * r * g1v[2], bfhi(w.w) * r * g1v[3]); }
            __syncthreads();
#pragma unroll
            for (int i4 = 0; i4 < 4; ++i4) { const int it = tid + NTHR * i4, q8 = it & 7, c = it >> 3;
                const LAS bf16_t* tp = T + (q8 * 8) * 258 + c;
                u32x4 o; o.x = (unsigned)tp[0] | ((unsigned)tp[258] << 16); o.y = (unsigned)tp[2 * 258] | ((unsigned)tp[3 * 258] << 16);
                o.z = (unsigned)tp[4 * 258] | ((unsigned)tp[5 * 258] << 16); o.w = (unsigned)tp[6 * 258] | ((unsigned)tp[7 * 258] << 16);
                *(u32x4*)(VNT + ((size_t)(chunk * 4 + (g >> 1)) * 256 + c) * 256 + (g & 1) * 128 + q0 + q8 * 8) = o; }
            __syncthreads();
        }
    }
}

DI void phase_hy_shortconv(const Args& a, LAS unsigned char* lds, int tid) {
    const bf16_t* UP = (const bf16_t*)(a.ws + WS_BUF1); bf16_t* UT = (bf16_t*)(a.ws + WS_BUF2); bf16_t* UTC = UT + (size_t)3 * 2 * 1024 * UTS;
    const float* cw = a.in[I_HYCW]; const float* cb = a.in[I_HYCB];
    LAS bf16_t* T = (LAS bf16_t*)lds;
    u32x4 w[3], nw[3]; f32x4 fw[2], nfw[2];
#define SC_LOAD(unit_, dw, dfw) do { const int tblk_ = (unit_) / 24, chb_ = (unit_) % 24; const bool isx_ = tblk_ < 256; \
        _Pragma("unroll") for (int i = 0; i < 2; ++i) { const int chg_ = chb_ * 128 + (tid >> 3) + 64 * i; dfw[i] = (f32x4){cw[chg_], cw[3072 + chg_], cw[2 * 3072 + chg_], cb[chg_]}; } \
        const int b_ = isx_ ? tblk_ >> 7 : (tblk_ - 256) >> 2, tb0_ = isx_ ? (tblk_ & 127) * 64 : ((tblk_ - 256) & 3) * 64, n_ = isx_ ? 8192 : 256; \
        const size_t rowbase_ = isx_ ? (size_t)b_ * 8192 : (size_t)TX + b_ * 256; \
        _Pragma("unroll") for (int k = 0; k < 3; ++k) { const int it = tid + NTHR * k; const int rr = it >> 4, c8 = (it & 15) * 8; const int t = tb0_ - 1 + rr; dw[k] = (u32x4){0u, 0u, 0u, 0u}; \
            if (it < 66 * 16 && t >= 0 && t < n_) dw[k] = *(const u32x4*)(UP + (rowbase_ + t) * 3072 + chb_ * 128 + c8); } } while (0)
    if ((int)blockIdx.x < 264 * 24) SC_LOAD((int)blockIdx.x, w, fw);
    for (int unit = blockIdx.x; unit < 264 * 24; unit += gridDim.x) {
        const int tblk = unit / 24, chb = unit % 24;
        const bool isx = tblk < 256;
        const int b = isx ? tblk >> 7 : (tblk - 256) >> 2, tb0 = isx ? (tblk & 127) * 64 : ((tblk - 256) & 3) * 64;
        if (unit + (int)gridDim.x < 264 * 24) SC_LOAD(unit + (int)gridDim.x, nw, nfw);
#pragma unroll
        for (int k = 0; k < 3; ++k) { const int it = tid + NTHR * k; const int rr = it >> 4, c8 = (it & 15) * 8;
            if (it < 66 * 16) { LAS unsigned* tp = (LAS unsigned*)(T + rr * 130 + c8); tp[0] = w[k].x; tp[1] = w[k].y; tp[2] = w[k].z; tp[3] = w[k].w; } }
        __syncthreads();
#pragma unroll
        for (int i2 = 0; i2 < 2; ++i2) { const int t8 = tid & 7, ch = (tid >> 3) + 64 * i2; const int chg = chb * 128 + ch;
            const float w0 = fw[i2][0], w1 = fw[i2][1], w2 = fw[i2][2], bb = fw[i2][3];
            float in[10];
#pragma unroll
            for (int k = 0; k < 10; ++k) in[k] = bf1(T[(t8 * 8 + k) * 130 + ch]);
            float o[8];
#pragma unroll
            for (int j = 0; j < 8; ++j) o[j] = w0 * in[j] + w1 * in[j + 1] + w2 * in[j + 2] + bb;
            u32x4 ov; ov.x = pkbf(o[0], o[1]); ov.y = pkbf(o[2], o[3]); ov.z = pkbf(o[4], o[5]); ov.w = pkbf(o[6], o[7]);
            const int part = chg >> 10, c = chg & 1023;
            if (isx) *(u32x4*)(UT + ((size_t)(part * 2 + b) * 1024 + c) * UTS + tb0 + t8 * 8) = ov;
            else *(u32x4*)(UTC + ((size_t)(part * 2 + b) * 1024 + c) * 256 + tb0 + t8 * 8) = ov; }
        __syncthreads();
#pragma unroll
        for (int k = 0; k < 3; ++k) w[k] = nw[k];
        fw[0] = nfw[0]; fw[1] = nfw[1];
    }
#undef SC_LOAD
}
DI void phase_hy_transpose(const Args& a, LAS unsigned char* lds, int lane, int wave, int gw, int NGW) {
    const bf16_t* Z2 = (const bf16_t*)(a.ws + WS_BUF3); const bf16_t* Z2C = Z2 + (size_t)2 * 1024 * UTS; bf16_t* ZA = (bf16_t*)(a.ws + WS_H);
    LAS bf16_t* T = (LAS bf16_t*)(lds + wave * 8704);
    const int l8 = lane >> 3, p8 = lane & 7;
    u32x4 w[8], nw[8];
#define TR_LOAD(unit_, dw) do { const bool isx_ = (unit_) < 4096; const int u_ = isx_ ? (unit_) : (unit_) - 4096; const int ntb_ = isx_ ? 128 : 4; const int b_ = u_ / (16 * ntb_), cb_ = (u_ / ntb_) & 15, tb_ = u_ % ntb_; \
        const size_t rs_ = isx_ ? (size_t)UTS : (size_t)256; const bf16_t* base_ = (isx_ ? Z2 : Z2C) + ((size_t)b_ * 1024 + cb_ * 64 + l8) * rs_ + tb_ * 64 + p8 * 8; \
        _Pragma("unroll") for (int k = 0; k < 8; ++k) dw[k] = *(const u32x4*)(base_ + (size_t)(8 * k) * rs_); } while (0)
    if (gw < 4096 + 128) TR_LOAD(gw, w);
    for (int unit = gw; unit < 4096 + 128; unit += NGW) {
        const bool isx = unit < 4096; const int u = isx ? unit : unit - 4096;
        const int ntb = isx ? 128 : 4; const int b = u / (16 * ntb), cb = (u / ntb) & 15, tb = u % ntb;
        if (unit + NGW < 4096 + 128) TR_LOAD(unit + NGW, nw);
#pragma unroll
        for (int k = 0; k < 8; ++k) { LAS unsigned* tp = (LAS unsigned*)(T + (8 * k + l8) * 66 + p8 * 8); tp[0] = w[k].x; tp[1] = w[k].y; tp[2] = w[k].z; tp[3] = w[k].w; }
        LDS_WAIT(); __builtin_amdgcn_wave_barrier();
        bf16_t* dst = ZA + ((isx ? (size_t)b * 8192 : (size_t)TX + b * 256) + tb * 64 + l8) * 1024 + cb * 64 + p8 * 8;
#pragma unroll
        for (int k = 0; k < 8; ++k) { const LAS bf16_t* tp = T + (p8 * 8) * 66 + 8 * k + l8; u32x4 o;
            o.x = (unsigned)tp[0] | ((unsigned)tp[66] << 16); o.y = (unsigned)tp[2 * 66] | ((unsigned)tp[3 * 66] << 16);
            o.z = (unsigned)tp[4 * 66] | ((unsigned)tp[5 * 66] << 16); o.w = (unsigned)tp[6 * 66] | ((unsigned)tp[7 * 66] << 16);
            *(u32x4*)(dst + (size_t)(8 * k) * 1024) = o; }
        LDS_WAIT(); __builtin_amdgcn_wave_barrier();
#pragma unroll
        for (int k = 0; k < 8; ++k) w[k] = nw[k];
    }
#undef TR_LOAD
}

DI void phase_da_prep(const Args& a, LAS unsigned char* lds, int tid) {
    const bf16_t* QKV = (const bf16_t*)(a.ws + WS_BUF1);
    bf16_t* Qn = (bf16_t*)(a.ws + WS_BUF2); bf16_t* Kn = Qn + (size_t)2 * 8 * 2 * 8192 * 64; bf16_t* VT = Kn + (size_t)2 * 8 * 2 * NKEY * 64;
    const float* rope = (const float*)(a.ws + WS_ROPE);
    LAS bf16_t* T = (LAS bf16_t*)lds;
    const int vid = tid >> 1, half = tid & 1, rl = vid & 63, which = vid >> 6; const int isk = which >> 1, m = which & 1;
    u32x4 wv[2], wq[4], nv[2], nq[4]; f32x4 rp4[8], nrp4[8];
    f32x4 gn4[8];
    { const f32x4* gp = (const f32x4*)((isk ? a.in[I_DAKG] : a.in[I_DAQG]) + half * 32);
#pragma unroll
      for (int k = 0; k < 8; ++k) gn4[k] = gp[k]; }
#define DP_LOAD(unit_, dv, dq, drp) do { const int rb_ = (unit_) >> 3, h_ = (unit_) & 7, r0_ = rb_ * 64; \
        if (r0_ < TX) { const int t_ = (r0_ + rl) & 8191; const f32x4* rq_ = (const f32x4*)(rope + (half == 0 ? (t_ >> 6) : (t_ & 63)) * 32); _Pragma("unroll") for (int k = 0; k < 8; ++k) drp[k] = rq_[k]; } \
        _Pragma("unroll") for (int k = 0; k < 2; ++k) { const int it = tid + NTHR * k; const int rl_ = it >> 4, c8 = (it & 15) * 8; dv[k] = *(const u32x4*)(QKV + (size_t)(r0_ + rl_) * 3072 + 2048 + h_ * 128 + c8); } \
        if (isk || r0_ < TX) { const u32x4* sp = (const u32x4*)(QKV + (size_t)(r0_ + rl) * 3072 + isk * 1024 + h_ * 128 + m * 64 + half * 32); _Pragma("unroll") for (int k = 0; k < 4; ++k) dq[k] = sp[k]; } } while (0)
    if ((int)blockIdx.x < 264 * 8) DP_LOAD((int)blockIdx.x, wv, wq, rp4);
    for (int unit = blockIdx.x; unit < 264 * 8; unit += gridDim.x) {
        const int rb = unit >> 3, h = unit & 7; const int r0 = rb * 64;
        const bool isx = r0 < TX;
        const int b = isx ? r0 >> 13 : (r0 - TX) >> 8;
        const int key0 = isx ? 256 + (r0 & 8191) : (r0 - TX) & 255;
        if (unit + (int)gridDim.x < 264 * 8) DP_LOAD(unit + (int)gridDim.x, nv, nq, nrp4);
#pragma unroll
        for (int k = 0; k < 2; ++k) { const int it = tid + NTHR * k; const int rl_ = it >> 4, c8 = (it & 15) * 8; LAS unsigned* tp = (LAS unsigned*)(T + rl_ * 130 + c8); tp[0] = wv[k].x; tp[1] = wv[k].y; tp[2] = wv[k].z; tp[3] = wv[k].w; }
        { const int r = r0 + rl;
          if (isk || isx) {
            float x[32];
#pragma unroll
            for (int k = 0; k < 4; ++k) { const u32x4 w = wq[k]; x[8 * k] = bflo(w.x); x[8 * k + 1] = bfhi(w.x); x[8 * k + 2] = bflo(w.y); x[8 * k + 3] = bfhi(w.y); x[8 * k + 4] = bflo(w.z); x[8 * k + 5] = bfhi(w.z); x[8 * k + 6] = bflo(w.w); x[8 * k + 7] = bfhi(w.w); }
            float ss = 0.f;
#pragma unroll
            for (int k = 0; k < 32; ++k) ss += x[k] * x[k];
            ss += dppf<DPP_XOR1>(ss);
            const float rinv = 1.0f / sqrtf(ss * (1.0f / 64.0f) + EPS);
#pragma unroll
            for (int k = 0; k < 32; ++k) x[k] = x[k] * rinv * gn4[k >> 2][k & 3];
            if (isx) {
#pragma unroll
                for (int f = 0; f < 16; ++f) { const float cs = rp4[f >> 1][2 * (f & 1)], sn = rp4[f >> 1][2 * (f & 1) + 1]; const float x1 = x[f], x2 = x[16 + f]; x[f] = x1 * cs - x2 * sn; x[16 + f] = x2 * cs + x1 * sn; } }
            if (!isk) {
#pragma unroll
                for (int k = 0; k < 32; ++k) x[k] *= QSCALE; }
            LAS u32x4* sp = (LAS u32x4*)(lds + 16640 + which * 8192 + rl * 128 + half * 64);
#pragma unroll
            for (int k = 0; k < 4; ++k) { u32x4 o; o.x = pkbf(x[8 * k], x[8 * k + 1]); o.y = pkbf(x[8 * k + 2], x[8 * k + 3]); o.z = pkbf(x[8 * k + 4], x[8 * k + 5]); o.w = pkbf(x[8 * k + 6], x[8 * k + 7]); sp[k ^ (rl & 3)] = o; }
          } }
        __syncthreads();
#pragma unroll
        for (int j = 0; j < 4; ++j) { const int xx = tid + NTHR * j, wh = xx >> 9, xr = xx & 511, rr = xr >> 3, pp = xr & 7;
            if (wh >= 2 || isx) {
                const u32x4 o = *(const LAS u32x4*)(lds + 16640 + wh * 8192 + rr * 128 + (pp >> 2) * 64 + ((pp & 3) ^ (rr & 3)) * 16);
                bf16_t* dp = (wh >> 1) ? Kn + ((size_t)((b * 8 + h) * 2 + (wh & 1)) * NKEY + key0) * 64 : Qn + ((size_t)((b * 8 + h) * 2 + (wh & 1)) * 8192 + (r0 & 8191)) * 64;
                ((u32x4*)dp)[xr] = o; } }
        for (int it = tid; it < 1024; it += NTHR) { const int e = it >> 3, j8 = it & 7; const int kb = 16 * (j8 >> 1) + 4 * (j8 & 1);
            const LAS bf16_t* tp = T + e;
            u32x4 o; o.x = (unsigned)tp[(kb + 0) * 130] | ((unsigned)tp[(kb + 1) * 130] << 16); o.y = (unsigned)tp[(kb + 2) * 130] | ((unsigned)tp[(kb + 3) * 130] << 16);
            o.z = (unsigned)tp[(kb + 8) * 130] | ((unsigned)tp[(kb + 9) * 130] << 16); o.w = (unsigned)tp[(kb + 10) * 130] | ((unsigned)tp[(kb + 11) * 130] << 16);
            *(u32x4*)(VT + ((size_t)(b * 8 + h) * 128 + e) * NKEY + key0 + j8 * 8) = o; }
        __syncthreads();
#pragma unroll
        for (int k = 0; k < 2; ++k) wv[k] = nv[k];
#pragma unroll
        for (int k = 0; k < 4; ++k) wq[k] = nq[k];
#pragma unroll
        for (int k = 0; k < 8; ++k) rp4[k] = nrp4[k];
    }
#undef DP_LOAD
}
DI bf16x8 pack8(const f32x16& x, int s) {
    u32x4 p;
    if (s == 0) { p.x = pkbf(x[0], x[1]); p.y = pkbf(x[2], x[3]); p.z = pkbf(x[4], x[5]); p.w = pkbf(x[6], x[7]); }
    else { p.x = pkbf(x[8], x[9]); p.y = pkbf(x[10], x[11]); p.z = pkbf(x[12], x[13]); p.w = pkbf(x[14], x[15]); }
    return __builtin_bit_cast(bf16x8, p);
}
constexpr int AT_STAGE = 32768;
DI void attn_issue_tile(LAS unsigned char* lds, int stage, const bf16_t* K0t, const bf16_t* K1t, const bf16_t* VTt, unsigned koff, unsigned voff0, unsigned voff1, int wave) {
    LAS unsigned char* sb = lds + stage * AT_STAGE;
    __builtin_amdgcn_global_load_lds((const unsigned*)((const char*)K0t + koff), (LAS unsigned*)(sb + wave * 1024), 16, 0, 0);
    __builtin_amdgcn_global_load_lds((const unsigned*)((const char*)K1t + koff), (LAS unsigned*)(sb + 8192 + wave * 1024), 16, 0, 0);
    __builtin_amdgcn_global_load_lds((const unsigned*)((const char*)VTt + voff0), (LAS unsigned*)(sb + 16384 + wave * 1024), 16, 0, 0);
    __builtin_amdgcn_global_load_lds((const unsigned*)((const char*)(VTt + (size_t)64 * NKEY) + voff1), (LAS unsigned*)(sb + 16384 + 8192 + wave * 1024), 16, 0, 0);
}
DI void phase_attn(const Args& a, LAS unsigned char* lds, int tid, int lane, int wave) {
    const bf16_t* Qn = (const bf16_t*)(a.ws + WS_BUF2); const bf16_t* Kn = Qn + (size_t)2 * 8 * 2 * 8192 * 64; const bf16_t* VT = Kn + (size_t)2 * 8 * 2 * NKEY * 64;
    bf16_t* AO = (bf16_t*)(a.ws + WS_BUF3);
    const float lam_init = 0.8f - 0.6f * expf(-0.3f * 2.0f);
    const int G = gridDim.x, blk = blockIdx.x;
    const int ql = lane & 31, kg = lane >> 5;
    const int pr = wave >> 1, m = wave & 1;
    for (int i = 0;; ++i) {
        int bh, qb;
        if (G == 256) { if (i >= 2) break; bh = (blk & 7) + 8 * i; qb = blk >> 3; }
        else { const int L = i * G + blk; if (L >= 512) break; bh = L >> 5; qb = L & 31; }
        const int b = bh >> 3, h = bh & 7;
        const int t0 = qb * 256 + pr * 64;
        const bf16_t* K0g = Kn + (size_t)(bh * 2 + 0) * NKEY * 64; const bf16_t* K1g = Kn + (size_t)(bh * 2 + 1) * NKEY * 64; const bf16_t* VTg = VT + (size_t)bh * 128 * NKEY;
        unsigned koff, voff0, voff1;
        { const int key = tid >> 3, cl = (tid & 7) ^ ((key >> 1) & 7); koff = (unsigned)(key * 64 + cl * 8) * 2u;
          const int e0 = tid >> 3, c0 = (tid & 7) ^ ((e0 >> 1) & 7); voff0 = (unsigned)(e0 * NKEY + c0 * 8) * 2u;
          voff1 = voff0; }
        __syncthreads();
        attn_issue_tile(lds, 0, K0g, K1g, VTg, koff, voff0, voff1, wave);
        bf16x8 qf[4];
        LAS unsigned char* qlds = lds + 3 * AT_STAGE + wave * 4096;
        { int qlv = ql, kgv = kg; asm volatile("" : "+v"(qlv), "+v"(kgv));
          const unsigned qoff = (unsigned)(qlv * 64 + kgv * 8);
          const bf16_t* qbase = Qn + ((size_t)(bh * 2 + m) * 8192 + t0) * 64;
#pragma unroll
          for (int ks = 0; ks < 4; ++ks) qf[ks] = *(const bf16x8*)(qbase + (qoff + ks * 16));
#pragma unroll
          for (int ks = 0; ks < 4; ++ks) { const bf16x8 qb_ = *(const bf16x8*)(qbase + (qoff + 2048 + ks * 16)); *(LAS bf16x8*)(qlds + ks * 1024 + (qlv + 32 * kgv) * 16) = qb_; } }
        f32x16 O[2][4];
#pragma unroll
        for (int g2 = 0; g2 < 2; ++g2)
#pragma unroll
            for (int et = 0; et < 4; ++et)
#pragma unroll
                for (int r = 0; r < 16; ++r) O[g2][et][r] = 0.f;
        float lsum[2] = {0.f, 0.f};
        attn_issue_tile(lds, 1, K0g + 4096, K1g + 4096, VTg + 64, koff, voff0, voff1, wave);
        asm volatile("s_waitcnt vmcnt(4)" ::: "memory"); __builtin_amdgcn_s_barrier(); asm volatile("" ::: "memory");
        int st = 0, st2 = 2;
        for (int kt = 0; kt < NKEY / 64; ++kt) {
            int lanev = lane; asm volatile("" : "+v"(lanev));
            const int tidv = wave * 64 + lanev, qlv = lanev & 31, kgv = lanev >> 5;
            unsigned koff, voff0, voff1;
            { const int key = tidv >> 3, cl = (tidv & 7) ^ ((key >> 1) & 7); koff = (unsigned)(key * 64 + cl * 8) * 2u; voff0 = (unsigned)(key * NKEY + cl * 8) * 2u; voff1 = voff0; }
            unsigned kro[4];
            { const int ksw = (qlv >> 1) & 7;
#pragma unroll
              for (int ks = 0; ks < 4; ++ks) kro[ks] = (unsigned)(qlv * 128 + (((2 * ks + kgv) ^ ksw) << 4)); }
            if (kt + 2 < NKEY / 64) attn_issue_tile(lds, st2, K0g + (size_t)(kt + 2) * 4096, K1g + (size_t)(kt + 2) * 4096, VTg + (size_t)(kt + 2) * 64, koff, voff0, voff1, wave);
            const LAS unsigned char* sb = lds + st * AT_STAGE + m * 8192;
            const LAS unsigned char* sv = lds + st * AT_STAGE + 16384;
#pragma unroll
            for (int k2 = 0; k2 < 2; ++k2) {
                bf16x8 kf[4];
#pragma unroll
                for (int ks = 0; ks < 4; ++ks) kf[ks] = *(const LAS bf16x8*)(sb + kro[ks] + k2 * 4096);
                f32x16 SA, SB;
#pragma unroll
                for (int r = 0; r < 16; ++r) { SA[r] = 0.f; SB[r] = 0.f; }
#pragma unroll
                for (int ks = 0; ks < 4; ++ks) { const bf16x8 qb_ = *(const LAS bf16x8*)(qlds + ks * 1024 + lanev * 16); SA = MFMA32(kf[ks], qf[ks], SA); SB = MFMA32(kf[ks], qb_, SB); }
                __builtin_amdgcn_sched_barrier(0);
                { float ps = 0.f;
#pragma unroll
                  for (int r = 0; r < 16; ++r) { SA[r] = __builtin_amdgcn_exp2f(SA[r]); ps += SA[r]; }
                  lsum[0] += ps; }
                { float ps = 0.f;
#pragma unroll
                  for (int r = 0; r < 16; ++r) { SB[r] = __builtin_amdgcn_exp2f(SB[r]); ps += SB[r]; }
                  lsum[1] += ps; }
                const bf16x8 pA0 = pack8(SA, 0), pA1 = pack8(SA, 1), pB0 = pack8(SB, 0), pB1 = pack8(SB, 1);
#pragma unroll
                for (int s2 = 0; s2 < 2; ++s2) {
#pragma unroll
                    for (int eh = 0; eh < 2; ++eh) {
                        const bf16x8 va_ = *(const LAS bf16x8*)(sv + kro[2 * k2 + s2] + (2 * eh) * 4096), vb_ = *(const LAS bf16x8*)(sv + kro[2 * k2 + s2] + (2 * eh + 1) * 4096);
                        const bf16x8 pa_ = s2 ? pA1 : pA0, pb_ = s2 ? pB1 : pB0;
                        O[0][2 * eh] = MFMA32(va_, pa_, O[0][2 * eh]); O[0][2 * eh + 1] = MFMA32(vb_, pa_, O[0][2 * eh + 1]);
                        O[1][2 * eh] = MFMA32(va_, pb_, O[1][2 * eh]); O[1][2 * eh + 1] = MFMA32(vb_, pb_, O[1][2 * eh + 1]); } }
                __builtin_amdgcn_sched_barrier(0);
            }
            if (kt + 2 < NKEY / 64) asm volatile("s_waitcnt vmcnt(4) lgkmcnt(0)" ::: "memory"); else asm volatile("s_waitcnt vmcnt(0) lgkmcnt(0)" ::: "memory");
            __builtin_amdgcn_s_barrier(); asm volatile("" ::: "memory");
            st = (st == 2) ? 0 : st + 1; st2 = (st2 == 2) ? 0 : st2 + 1;
        }
        float lam;
        { int lv = lane; asm volatile("" : "+v"(lv)); const float q1 = a.in[I_DALQ1][lv] * a.in[I_DALK1][lv], q2 = a.in[I_DALQ2][lv] * a.in[I_DALK2][lv];
          lam = expf(wave_sum(q1)) - expf(wave_sum(q2)) + lam_init; }
        LAS float* xb = (LAS float*)lds + pr * 8192 + lane;
#pragma unroll
        for (int g2 = 0; g2 < 2; ++g2) {
            const float ltot = lsum[g2] + __shfl_xor(lsum[g2], 32);
            if (m == 1) { const float i1 = lam / ltot;
#pragma unroll
                for (int et = 0; et < 4; ++et)
#pragma unroll
                    for (int r = 0; r < 16; ++r) xb[(g2 * 64 + et * 16 + r) * 64] = O[g2][et][r] * i1; }
            else lsum[g2] = 1.0f / ltot;
        }
        __syncthreads();
        if (m == 0) {
            int ql2 = ql, kg2 = kg; asm volatile("" : "+v"(ql2), "+v"(kg2));
            const float* sg = a.in[I_DASUB];
#pragma unroll
            for (int g2 = 0; g2 < 2; ++g2) {
                const float i0 = lsum[g2];
                float ss = 0.f;
#pragma unroll
                for (int et = 0; et < 4; ++et)
#pragma unroll
                    for (int r = 0; r < 16; ++r) { const float o = O[g2][et][r] * i0 - xb[(g2 * 64 + et * 16 + r) * 64]; O[g2][et][r] = o; ss += o * o; }
                ss += __shfl_xor(ss, 32);
                const float rn = (1.0f / sqrtf(ss * (1.0f / 128.0f) + EPS)) * (1.0f - lam_init);
                bf16_t* obase = AO + ((size_t)b * 8192 + t0 + g2 * 32) * 1024 + h * 128; const unsigned ooff = (unsigned)(ql2 * 1024 + 4 * kg2);
#pragma unroll
                for (int et = 0; et < 4; ++et)
#pragma unroll
                    for (int g4 = 0; g4 < 4; ++g4) { const int e0 = et * 32 + 8 * g4; const f32x4 gv = *(const f32x4*)(sg + (unsigned)(e0 + 4 * kg2));
                        u32x2 w; w.x = pkbf(O[g2][et][4 * g4] * rn * gv[0], O[g2][et][4 * g4 + 1] * rn * gv[1]); w.y = pkbf(O[g2][et][4 * g4 + 2] * rn * gv[2], O[g2][et][4 * g4 + 3] * rn * gv[3]);
                        *(u32x2*)(obase + (ooff + e0)) = w; }
            }
        }
    }
}
constexpr int CV_ZB = 25856;
constexpr int CV_FB = RRS * 2;
constexpr int CV_FO = 2 * CV_ZB;
DI int cv_pad(int y) { return y + ((y >> 7) << 3); }
DI void cv_filter_dma(LAS unsigned char* dst, const bf16_t* src, int lane, int wave) {
#pragma unroll
    for (int j = 0; j < 5; ++j) { const int i = wave + 8 * j; if (i < 33) __builtin_amdgcn_global_load_lds((const unsigned*)((const char*)src + i * 1024 + lane * 16), (LAS unsigned*)(dst + i * 1024), 16, 0, 0); }
}
DI void phase_hy_conv(const Args& a, LAS unsigned char* lds, int tid, int lane, int wave, int gw, int NGW) {
    const bf16_t* UT = (const bf16_t*)(a.ws + WS_BUF2); const bf16_t* UTC = UT + (size_t)3 * 2 * 1024 * UTS;
    bf16_t* Z2 = (bf16_t*)(a.ws + WS_BUF3); bf16_t* Z2C = Z2 + (size_t)2 * 1024 * UTS;
    const float* FSQP = (const float*)(a.ws + WS_FSQP);
    const bf16_t* RR = (const bf16_t*)(a.ws + WS_RR);
    const float* skip = a.in[I_HYSKIP];
    const int nt = wave & 3, kh = wave >> 2;
    const int ql = lane & 31, kg = lane >> 5, bcol = ql >> 4, ii = ql & 15, i0 = 16 * nt;
    const int par = ql & 1;
    LAS unsigned char* const fA = lds + CV_FO; LAS unsigned char* const fB = lds + CV_FO + CV_FB + 64;
    LAS unsigned* const CVL = (LAS unsigned*)(lds + 119808);
    float cv[32]; CvtTile ctile; ctile.src = nullptr; ctile.dst = nullptr; ctile.K = 0; ctile.N = 0; ctile.mode = 0;
    int gi = 0, cstage = 0, cslot = 0;
    __syncthreads();
    if ((int)blockIdx.x < 1024) cv_filter_dma(fA, RR + (size_t)blockIdx.x * RRS, lane, wave);
    for (int c = blockIdx.x; c < 1024; c += gridDim.x) {
        { u32x4 w[2][3];
#pragma unroll
          for (int b = 0; b < 2; ++b) { const bf16_t* vsrc = UT + ((size_t)(0 * 2 + b) * 1024 + c) * UTS;
#pragma unroll
              for (int k = 0; k < 3; ++k) { const int y = (tid + NTHR * k) * 8; w[b][k] = (u32x4){0u, 0u, 0u, 0u}; if (y >= 1920 && y < 1920 + 8192) w[b][k] = *(const u32x4*)(vsrc + (y - 1920)); } }
#pragma unroll
          for (int b = 0; b < 2; ++b)
#pragma unroll
              for (int k = 0; k < 3; ++k) { const int y = (tid + NTHR * k) * 8; if (y < 12160) *(LAS u32x4*)(lds + b * CV_ZB + cv_pad(y) * 2) = w[b][k]; } }
        float scl0, scl1;
        { float s0 = 0.f, s1 = 0.f;
          if (lane < FQ_LSEG) { s0 = FSQP[(size_t)lane * 4096 + c] + FSQP[(size_t)lane * 4096 + 1024 + c]; s1 = FSQP[(size_t)lane * 4096 + 2048 + c] + FSQP[(size_t)lane * 4096 + 3072 + c]; }
          scl0 = 1.0f / sqrtf(wave_sum(s0) + EPS); scl1 = 1.0f / sqrtf(wave_sum(s1) + EPS); }
        const LAS unsigned char* zrd = lds + bcol * CV_ZB;
        const int ybase = 128 * ii + 8 * kg;
#pragma unroll 1
        for (int o = 0; o < 2; ++o) {
            VM_WAIT(); __syncthreads();
            for (int d = tid; d < RRS / 2 - 1; d += NTHR) { const LAS unsigned* sa = (const LAS unsigned*)fA + d; ((LAS unsigned*)fB)[d] = __builtin_amdgcn_alignbit(sa[1], sa[0], 16); }
            __syncthreads();
            const LAS unsigned char* rp = (par ? fB : fA) + 2 * (6272 - 128 * i0 + 8 * kg - ql - par);
            f32x16 acc[4];
#pragma unroll
            for (int mt = 0; mt < 4; ++mt)
#pragma unroll
                for (int r = 0; r < 16; ++r) acc[mt][r] = 0.f;
            bf16x8 F[8];
            const int ks0 = kh * 320;
#define CV_RAW(d_, ks_) do { const LAS unsigned* q_ = (const LAS unsigned*)(rp + 32 * (ks_)); d_[0] = q_[0]; d_[1] = q_[1]; d_[2] = q_[2]; d_[3] = q_[3]; } while (0)
#define CV_MK(dst, d_) do { u32x4 f_; f_.x = d_[0]; f_.y = d_[1]; f_.z = d_[2]; f_.w = d_[3]; dst = __builtin_bit_cast(bf16x8, f_); } while (0)
#pragma unroll
            for (int d = -6; d < 0; ++d) { unsigned t_[4]; CV_RAW(t_, ks0 + d); CV_MK(F[d & 7], t_); }
            const LAS unsigned char* zq = zrd + 272 * (ii + (ks0 >> 3)) + 16 * kg;
            unsigned ra[4]; bf16x8 Bf;
            CV_RAW(ra, ks0); Bf = *(const LAS bf16x8*)(zq);
#pragma unroll 1
            for (int it = 0; it < 40; ++it) {
#pragma unroll
                for (int j = 0; j < 8; ++j) {
                    const int ks = ks0 + it * 8 + j;
                    CV_MK(F[j], ra);
                    const bf16x8 Bc = Bf;
                    const bool lastst = (it == 39 && j == 7);
                    CV_RAW(ra, lastst ? ks : ks + 1);
                    Bf = *(const LAS bf16x8*)(zq + (lastst ? 32 * j : (j == 7 ? 272 : 32 * (j + 1))));
                    acc[0] = MFMA32(F[j], Bc, acc[0]);
                    acc[1] = MFMA32(F[(j + 6) & 7], Bc, acc[1]);
                    acc[2] = MFMA32(F[(j + 4) & 7], Bc, acc[2]);
                    acc[3] = MFMA32(F[(j + 2) & 7], Bc, acc[3]);
                }
                zq += 272;
                { const int ph = (gi + (int)blockIdx.x) & 3;
                  if (ph == 0) { if (cstage == 2) { cvt_store_w(CVL + wave * (16 * 65), ctile, wave, lane_id()); cstage = 0; }
                      const int t = CVT_T_MOE1 + (int)blockIdx.x + (int)gridDim.x * cslot; if (t < CVT_NTILES) { cvt_decode(a, t, ctile); cvt_load_w(ctile, cv, wave, lane_id()); cstage = 1; } ++cslot; }
                  else if (ph == 3) { if (cstage == 1) { cvt_pack_w(CVL + wave * (16 * 65), cv, lane_id()); cstage = 2; } }
                  ++gi; }
            }
#undef CV_RAW
#undef CV_MK
            __syncthreads();
            { const int cn = (o == 0) ? c : c + (int)gridDim.x; if (cn < 1024) cv_filter_dma(fA, RR + ((size_t)(o ^ 1) * 1024 + cn) * RRS, lane, wave); }
            LAS float* red = (LAS float*)fB + nt * 2048 + lane;
            const float sk = skip[o * 1024 + c], sc = o == 0 ? scl0 : scl1;
            const bf16_t* gsrc = UT + ((size_t)((1 + o) * 2 + bcol) * 1024 + c) * UTS;
            LAS unsigned char* zw = lds + bcol * CV_ZB;
#pragma unroll
            for (int hp = 0; hp < 2; ++hp) {
                if (kh == 1) {
#pragma unroll
                    for (int m2 = 0; m2 < 2; ++m2)
#pragma unroll
                        for (int r = 0; r < 16; ++r) red[(m2 * 16 + r) * 64] = acc[2 * hp + m2][r];
                }
                __syncthreads();
                if (kh == 0) {
                    u32x2 gq[2][4];
#pragma unroll
                    for (int m2 = 0; m2 < 2; ++m2)
#pragma unroll
                        for (int g4 = 0; g4 < 4; ++g4) gq[m2][g4] = *(const u32x2*)(gsrc + (128 * (i0 + ii) + 32 * (2 * hp + m2) + 8 * g4 + 4 * kg));
                    u32x2 wq[2][4];
#pragma unroll
                    for (int m2 = 0; m2 < 2; ++m2)
#pragma unroll
                        for (int g4 = 0; g4 < 4; ++g4) {
                            const int mt = 2 * hp + m2;
                            const int t4 = 128 * (i0 + ii) + 32 * mt + 8 * g4 + 4 * kg;
                            const u32x2 gw2 = gq[m2][g4];
                            LAS u32x2* zp = (LAS u32x2*)(zw + cv_pad(t4 + 1920) * 2);
                            const u32x2 zo = *zp;
                            const float y0 = acc[mt][4 * g4] + red[(m2 * 16 + 4 * g4) * 64], y1 = acc[mt][4 * g4 + 1] + red[(m2 * 16 + 4 * g4 + 1) * 64];
                            const float y2 = acc[mt][4 * g4 + 2] + red[(m2 * 16 + 4 * g4 + 2) * 64], y3 = acc[mt][4 * g4 + 3] + red[(m2 * 16 + 4 * g4 + 3) * 64];
                            const float r0 = bflo(gw2.x) * (y0 * sc + sk * bflo(zo.x)), r1 = bfhi(gw2.x) * (y1 * sc + sk * bfhi(zo.x));
                            const float r2 = bflo(gw2.y) * (y2 * sc + sk * bflo(zo.y)), r3 = bfhi(gw2.y) * (y3 * sc + sk * bfhi(zo.y));
                            u32x2 w; w.x = pkbf(r0, r1); w.y = pkbf(r2, r3);
                            wq[m2][g4] = w;
                            if (o == 0) *zp = w;
                        }
                    if (o != 0) {
#pragma unroll
                        for (int m2 = 0; m2 < 2; ++m2)
#pragma unroll
                            for (int g4 = 0; g4 < 4; ++g4) *(u32x2*)(Z2 + ((size_t)bcol * 1024 + c) * UTS + (128 * (i0 + ii) + 32 * (2 * hp + m2) + 8 * g4 + 4 * kg)) = wq[m2][g4];
                    }
                }
                __syncthreads();
            }
        }
    }
    VM_WAIT();
    __syncthreads();
    if (cstage == 1) { cvt_pack_w(CVL + wave * (16 * 65), cv, lane_id()); cstage = 2; }
    if (cstage == 2) { cvt_store_w(CVL + wave * (16 * 65), ctile, wave, lane_id()); cstage = 0; }
    for (int sl = cslot;; ++sl) { const int t = CVT_T_MOE1 + (int)blockIdx.x + (int)gridDim.x * sl; if (t >= CVT_NTILES) break;
        cvt_decode(a, t, ctile); cvt_load_w(ctile, cv, wave, lane_id()); cvt_pack_w(CVL + wave * (16 * 65), cv, lane_id()); cvt_store_w(CVL + wave * (16 * 65), ctile, wave, lane_id()); }
    __syncthreads();
    {
        const float* RRC = (const float*)(a.ws + WS_RRC);
        LAS float* zc = (LAS float*)(lds + wave * 6144);
        LAS float* rc = zc + 512;
        for (int c = gw; c < 1024; c += NGW) {
            float scl[2];
#pragma unroll
            for (int o = 0; o < 2; ++o) { float s = 0.f; if (lane < FQ_CSEG) s = FSQP[(size_t)(FQ_LSEG + lane) * 4096 + o * 2048 + c] + FSQP[(size_t)(FQ_LSEG + lane) * 4096 + o * 2048 + 1024 + c]; scl[o] = 1.0f / sqrtf(wave_sum(s) + EPS); }
            for (int k = lane; k < 1024; k += 64) { const int o = k >> 9, idx = k & 511; rc[k] = idx == 0 ? 0.f : RRC[(size_t)(o * 1024 + c) * 512 + idx]; }
            for (int k = lane; k < 512; k += 64) { const int b = k >> 8, t = k & 255; zc[k] = bf1(UTC[((size_t)(0 * 2 + b) * 1024 + c) * 256 + t]); }
            LDS_WAIT(); __builtin_amdgcn_wave_barrier();
#pragma unroll 1
            for (int o = 0; o < 2; ++o) {
                float y[2][4];
#pragma unroll
                for (int b = 0; b < 2; ++b)
#pragma unroll
                    for (int j = 0; j < 4; ++j) y[b][j] = 0.f;
                for (int s = 0; s < 256; ++s) { const float z0 = zc[s], z1 = zc[256 + s];
#pragma unroll
                    for (int j = 0; j < 4; ++j) { const float rv = rc[o * 512 + s - (lane + 64 * j) + 256]; y[0][j] += rv * z0; y[1][j] += rv * z1; } }
                float zn[2][4];
                const float sk = skip[o * 1024 + c];
#pragma unroll
                for (int b = 0; b < 2; ++b)
#pragma unroll
                    for (int j = 0; j < 4; ++j) { const int t = lane + 64 * j; const float g = bf1(UTC[((size_t)((1 + o) * 2 + b) * 1024 + c) * 256 + t]); zn[b][j] = g * (y[b][j] * (o == 0 ? scl[0] : scl[1]) + sk * zc[b * 256 + t]); }
                LDS_WAIT(); __builtin_amdgcn_wave_barrier();
#pragma unroll
                for (int b = 0; b < 2; ++b)
#pragma unroll
                    for (int j = 0; j < 4; ++j) { const int t = lane + 64 * j; if (o == 0) zc[b * 256 + t] = zn[b][j]; else Z2C[((size_t)b * 1024 + c) * 256 + t] = f2bf1(zn[b][j]); }
                LDS_WAIT(); __builtin_amdgcn_wave_barrier();
            }
        }
    }
}
template <class Epi> DI void small_gemm(LAS unsigned char* lds, int tid, int lane, int wave, int ntiles, int ntn, int K, const Epi& E) {
    const int rl = lane & 31, kg = lane >> 5;
    const int kslice = K >> 3, k0 = wave * kslice;
    LAS float* red = (LAS float*)lds;
    for (int t = blockIdx.x; t < ntiles; t += gridDim.x) {
        const int tm = t / ntn, tn = t - tm * ntn;
        const bf16_t* a0 = E.arow(tm, rl) + k0 + 8 * kg; const bf16_t* a1 = E.arow(tm, 32 + rl) + k0 + 8 * kg;
        const bf16_t* b0 = E.brow(tm, tn, rl) + k0 + 8 * kg; const bf16_t* b1 = E.brow(tm, tn, 32 + rl) + k0 + 8 * kg;
        f32x16 acc[2][2];
#pragma unroll
        for (int i = 0; i < 2; ++i)
#pragma unroll
            for (int j = 0; j < 2; ++j)
#pragma unroll
                for (int r = 0; r < 16; ++r) acc[i][j][r] = 0.f;
#pragma unroll 4
        for (int k = 0; k < kslice; k += 16) {
            const bf16x8 fa0 = *(const bf16x8*)(a0 + k), fa1 = *(const bf16x8*)(a1 + k), fb0 = *(const bf16x8*)(b0 + k), fb1 = *(const bf16x8*)(b1 + k);
            acc[0][0] = MFMA32(fa0, fb0, acc[0][0]); acc[0][1] = MFMA32(fa0, fb1, acc[0][1]);
            acc[1][0] = MFMA32(fa1, fb0, acc[1][0]); acc[1][1] = MFMA32(fa1, fb1, acc[1][1]);
        }
        __syncthreads();
#pragma unroll
        for (int i = 0; i < 2; ++i)
#pragma unroll
            for (int j = 0; j < 2; ++j)
#pragma unroll
                for (int r = 0; r < 16; ++r) red[wave * 4096 + ((i * 2 + j) * 16 + r) * 64 + lane] = acc[i][j][r];
        __syncthreads();
        { const int row = tid >> 3, c8 = (tid & 7) * 8;
          const int mt = row >> 5, rr = row & 31, kgs = (rr >> 2) & 1, r = (rr & 3) + 4 * (rr >> 3);
          const int nt = c8 >> 5;
          const LAS float* rp = red + ((mt * 2 + nt) * 16 + r) * 64 + (c8 & 31) + 32 * kgs;
          float v[8];
#pragma unroll
          for (int j = 0; j < 8; ++j) { float s = 0.f;
#pragma unroll
              for (int w = 0; w < 8; ++w) s += rp[w * 4096 + j];
              v[j] = s; }
          E.store(tm, tn, row, c8, v); }
    }
    __syncthreads();
}
DI float gelu1(float x) { const pg8::f32x2 r = pg8::gelu_pk((pg8::f32x2){x, x}); return r.x; }
struct SmDense {
    const bf16_t* A; int lda; const bf16_t* Bt; int K;
    int mode;
    bf16_t* O; int ldo; const float* bias; float* X; const float* gate;
    DI const bf16_t* arow(int tm, int r) const { return A + (size_t)(TX + 64 * tm + r) * lda; }
    DI const bf16_t* brow(int tm, int tn, int c) const { return Bt + (size_t)(64 * tn + c) * K; }
    DI void store(int tm, int tn, int r, int c8, const float (&v)[8]) const {
        const size_t row = (size_t)TX + 64 * tm + r; const int col = 64 * tn + c8;
        float y[8];
#pragma unroll
        for (int j = 0; j < 8; ++j) y[j] = v[j] + (bias ? bias[col + j] : 0.f);
        if (mode == 2) { float* xp = X + row * 1024 + col;
#pragma unroll
            for (int j = 0; j < 8; ++j) xp[j] += gate[col + j] * y[j]; }
        else { if (mode == 1) {
#pragma unroll
                for (int j = 0; j < 8; ++j) y[j] = gelu1(y[j]); }
            u32x4 w; w.x = pkbf(y[0], y[1]); w.y = pkbf(y[2], y[3]); w.z = pkbf(y[4], y[5]); w.w = pkbf(y[6], y[7]);
            *(u32x4*)(O + row * ldo + col) = w; }
    }
};
struct SmMoeUp {
    const bf16_t* H; const int* seltok; const bf16_t* Wgu; bf16_t* HM;
    DI const bf16_t* arow(int tm, int r) const { int row = seltok[tm * EROWS + 2048 + r]; row = ((unsigned)row < (unsigned)TR) ? row : 0; return H + (size_t)row * 1024; }
    DI const bf16_t* brow(int tm, int tn, int c) const { return Wgu + ((size_t)tm * 4096 + 64 * tn + c) * 1024; }
    DI void store(int tm, int tn, int r, int c8, const float (&v)[8]) const {
        float h[4];
#pragma unroll
        for (int j = 0; j < 4; ++j) h[j] = v[j] * __builtin_amdgcn_rcpf(1.0f + __expf(-v[j])) * v[4 + j];
        u32x2 w; w.x = pkbf(h[0], h[1]); w.y = pkbf(h[2], h[3]);
        *(u32x2*)(HM + ((size_t)tm * EROWS + 2048 + r) * 2048 + (64 * tn + c8) / 2) = w;
    }
};
struct SmMoeDown {
    const bf16_t* HM; const bf16_t* Wdn; bf16_t* Y; const float* g;
    DI const bf16_t* arow(int tm, int r) const { return HM + ((size_t)tm * EROWS + 2048 + r) * 2048; }
    DI const bf16_t* brow(int tm, int tn, int c) const { return Wdn + ((size_t)tm * 1024 + 64 * tn + c) * 2048; }
    DI void store(int tm, int tn, int r, int c8, const float (&v)[8]) const {
        const size_t row = (size_t)tm * EROWS + 2048 + r; const float gs = g[row];
        u32x4 w; w.x = pkbf(v[0] * gs, v[1] * gs); w.y = pkbf(v[2] * gs, v[3] * gs); w.z = pkbf(v[4] * gs, v[5] * gs); w.w = pkbf(v[6] * gs, v[7] * gs);
        *(u32x4*)(Y + row * 1024 + 64 * tn + c8) = w;
    }
};
enum { P_PRO0 = 0, P_A0, P_SG0, P_MOE0 = P_SG0 + 4, P_A1 = P_MOE0 + 4, P_HYIN, P_HYSC, P_HYCONV, P_HYTR, P_HYOUT, P_MOE1, P_A2 = P_MOE1 + 4, P_DAIN, P_DAPREP, P_ATTN, P_DAOUT, P_MOE2,
       P_A3 = P_MOE2 + 4, P_SG3, P_MOE3 = P_SG3 + 4, P_FINAL = P_MOE3 + 4, NPHASE };
template <int LAYER, int PH0, class BarT> DI void moe_block(const Args& a, LAS unsigned char* lds, const BarT& bar, int lo, int hi, int wave, int gw, int NGW) {
    constexpr int MT = 8;
    unsigned char* ws = a.ws;
#ifndef PROBE_MASK
#define PROBE_MASK 0ull
#define PROBE_N 1
#endif
#define PH_REPS(k) (((PROBE_MASK >> (k)) & 1ull) ? PROBE_N : 1)
#ifdef TPROBE_MASK
#define TP_BEGIN(k) if (((TPROBE_MASK >> (k)) & 1ull) && threadIdx.x == 0) { ((volatile LAS unsigned*)(lds + MISC_OFF))[16] = (unsigned)__builtin_amdgcn_s_memrealtime(); }
#define TP_END(k) if (((TPROBE_MASK >> (k)) & 1ull) && threadIdx.x == 0) { volatile LAS unsigned* _tp = (volatile LAS unsigned*)(lds + MISC_OFF); _tp[17] += (unsigned)__builtin_amdgcn_s_memrealtime() - _tp[16]; }
#else
#define TP_BEGIN(k)
#define TP_END(k)
#endif
#define PH_BEGIN(k) if (lo <= (k) && (k) < hi) { TP_BEGIN(k) for (int _rep = 0; _rep < PH_REPS(k); ++_rep) { if (_rep) xcd_barrier(bar); const int lane = lane_id(); const int tid = wave * 64 + lane; (void)tid; (void)lane;
#define PH_END(k) } if ((k) + 1 < hi) xcd_barrier(bar); TP_END(k) }
    PH_BEGIN(PH0 + 0) phase_moe_prep<LAYER>(a, lds, tid, lane, gw, NGW); __syncthreads(); PH_END(PH0 + 0)
    PH_BEGIN(PH0 + 1) phase_topk<LAYER>(a, lds, tid, lane, wave); PH_END(PH0 + 1)
    PH_BEGIN(PH0 + 2) {
        pg8::Gemm g{(const bf16_t*)(ws + WS_H), (const bf16_t*)(ws + WS_WGU) + (size_t)LAYER * 16 * 4096 * 1024, TR, 16 * 4096, 1024, (const int*)(ws + WS_SELTOK)};
        pg8::MoeOrder S{MT, 16, (int)gridDim.x, (int)blockIdx.x}; pg8::EpiSwiGLU E{(bf16_t*)(ws + WS_BUF2)};
        pg8::gemm_phase<pg8::EpiSwiGLU, pg8::MoeOrder, false, true>(lds, g, S, E, nullptr, wave);
        if (LAYER <= 1) { SmMoeUp Es{(const bf16_t*)(ws + WS_H), (const int*)(ws + WS_SELTOK), (const bf16_t*)(ws + WS_WGU) + (size_t)LAYER * 16 * 4096 * 1024, (bf16_t*)(ws + WS_BUF2)};
            small_gemm(lds, tid, lane, wave, 16 * 64, 64, 1024, Es); } } PH_END(PH0 + 2)
    PH_BEGIN(PH0 + 3) {
        pg8::Gemm g{(const bf16_t*)(ws + WS_BUF2), (const bf16_t*)(ws + WS_WDN) + (size_t)LAYER * 16 * 1024 * 2048, 16 * EROWS, 16 * 1024, 2048, nullptr};
        pg8::MoeOrder S{MT, 4, (int)gridDim.x, (int)blockIdx.x}; pg8::EpiDown E{(bf16_t*)(ws + WS_Y), (const float*)(ws + WS_SELG)};
        pg8::gemm_phase<pg8::EpiDown, pg8::MoeOrder, false>(lds, g, S, E, nullptr, wave);
        if (LAYER <= 1) { SmMoeDown Es{(const bf16_t*)(ws + WS_BUF2), (const bf16_t*)(ws + WS_WDN) + (size_t)LAYER * 16 * 1024 * 2048, (bf16_t*)(ws + WS_Y), (const float*)(ws + WS_SELG)};
            small_gemm(lds, tid, lane, wave, 16 * 16, 16, 2048, Es); } } PH_END(PH0 + 3)
}
template <int LAYER, int J, int PH0, class BarT> DI void sg_block(const Args& a, LAS unsigned char* lds, const BarT& bar, int lo, int hi, int wave) {
    constexpr int M = TX, NCHUNK = ((LAYER == 3) ? TX : TR) / 128;
    unsigned char* ws = a.ws;
    PH_BEGIN(PH0 + 0) {
        pg8::Gemm g{(const bf16_t*)(ws + WS_H), (const bf16_t*)(ws + WS_WSGIN) + (size_t)J * 4096 * 1024, M, 4096, 1024, nullptr};
        pg8::StaticOrder S; S.init(M, 4096, (int)gridDim.x, (int)blockIdx.x);
        pg8::EpiBf16<1> E{(bf16_t*)(ws + WS_BUF1), 4096, a.in[I_SGBIN] + J * 4096, 0, 0, (float*)(ws + WS_VSQ), 2048};
        pg8::gemm_phase<pg8::EpiBf16<1>, pg8::StaticOrder, false>(lds, g, S, E, nullptr, wave);
        if (LAYER == 0) { SmDense Es{(const bf16_t*)(ws + WS_H), 1024, (const bf16_t*)(ws + WS_WSGIN) + (size_t)J * 4096 * 1024, 1024, 1, (bf16_t*)(ws + WS_BUF1), 4096, a.in[I_SGBIN] + J * 4096, nullptr, nullptr};
            small_gemm(lds, tid, lane, wave, 8 * 64, 64, 1024, Es); } } PH_END(PH0 + 0)
    PH_BEGIN(PH0 + 1) phase_sg_vnt<J, NCHUNK>(a, lds, tid, lane, wave); PH_END(PH0 + 1)
    PH_BEGIN(PH0 + 2) {
        pg8::Gemm g{(const bf16_t*)(ws + WS_WSBD) + (size_t)J * 4 * 256 * 256, (const bf16_t*)(ws + WS_BUF2), 1024, NCHUNK * 4 * 256, 256, nullptr};
        pg8::SpatOrder S{NCHUNK * 4, (int)gridDim.x, (int)blockIdx.x};
        pg8::EpiSpat E{(bf16_t*)(ws + WS_BUF3), (const bf16_t*)(ws + WS_BUF1), a.in[I_SGBS] + J * 8 * 128};
        pg8::gemm_phase<pg8::EpiSpat, pg8::SpatOrder, false>(lds, g, S, E, nullptr, wave); } PH_END(PH0 + 2)
    PH_BEGIN(PH0 + 3) {
        pg8::Gemm g{(const bf16_t*)(ws + WS_BUF3), (const bf16_t*)(ws + WS_WSGOUT) + (size_t)J * 1024 * 2048, M, 1024, 2048, nullptr};
        pg8::StaticOrder S; S.init(M, 1024, (int)gridDim.x, (int)blockIdx.x);
        pg8::EpiRes E{(float*)(ws + WS_X), a.in[I_SGBOUT] + J * 1024, modp(a, LAYER, 0, 2)};
        pg8::gemm_phase<pg8::EpiRes, pg8::StaticOrder, false>(lds, g, S, E, nullptr, wave);
        if (LAYER == 0) { SmDense Es{(const bf16_t*)(ws + WS_BUF3), 2048, (const bf16_t*)(ws + WS_WSGOUT) + (size_t)J * 1024 * 2048, 2048, 2, nullptr, 0, a.in[I_SGBOUT] + J * 1024, (float*)(ws + WS_X), modp(a, LAYER, 2, 2)};
            small_gemm(lds, tid, lane, wave, 8 * 16, 16, 2048, Es); } } PH_END(PH0 + 3)
}

__global__ void __launch_bounds__(NTHR, 2) mk_fwd(Args a) {
    extern __shared__ __attribute__((aligned(16))) unsigned char lds_raw[];
    LAS unsigned char* lds = (LAS unsigned char*)lds_raw;
    const int wave = __builtin_amdgcn_readfirstlane((int)threadIdx.x >> 6);
    const int G = gridDim.x, gw = blockIdx.x * NWAVES + wave, NGW = G * NWAVES;
    volatile LAS unsigned* MISC = (volatile LAS unsigned*)(lds + MISC_OFF);
    if (threadIdx.x < 32) MISC[threadIdx.x] = 0u;
    __syncthreads();
    unsigned char* ws = a.ws;
    XcdBarrier bar = xcd_barrier_post((unsigned*)(ws + WS_CTL) + CW_BAR, MISC + 8);
    const int lo = a.ph_lo, hi = a.ph_hi;

    if (lo <= P_PRO0 && P_PRO0 < hi) {
        TP_BEGIN(P_PRO0)
        const int lane = lane_id(); const int tid = wave * 64 + lane;
        pro0_mod(a, lds, tid, lane, wave);
        pro0_small(a, blockIdx.x * NTHR + tid, G * NTHR);
        pro0_filter1(a, lane, gw, NGW);
        asm volatile("s_waitcnt vmcnt(0)" ::: "memory");
        __syncthreads();
        unsigned* pcnt = (unsigned*)(ws + WS_CTL) + CW_PRO;
        if (threadIdx.x == 0) { __builtin_amdgcn_fence(__ATOMIC_RELEASE, "agent"); asm volatile("s_waitcnt vmcnt(0)" ::: "memory"); (void)xb_add(pcnt, 1u); }
        cvt_range(a, lds, tid, 0, CVT_T_MOE1);
        asm volatile("s_waitcnt vmcnt(0)" ::: "memory");
        __syncthreads();
        if (P_PRO0 + 1 < hi) {
            if (threadIdx.x == 0) { unsigned sp = 0; while (xb_ld(pcnt) < gridDim.x) { __builtin_amdgcn_s_sleep(2); if (++sp > (1u << 22)) break; }
                __builtin_amdgcn_fence(__ATOMIC_ACQUIRE, "agent"); asm volatile("s_waitcnt vmcnt(0)" ::: "memory"); }
            __syncthreads();
        }
        TP_END(P_PRO0)
    }
#ifndef TPROBE_SUB
#define TPROBE_SUB 0
#endif
#define TPS_BEGIN(n) if (TPROBE_SUB == (n)) { __syncthreads(); if (threadIdx.x == 0) MISC[16] = (unsigned)__builtin_amdgcn_s_memrealtime(); }
#define TPS_END(n) if (TPROBE_SUB == (n)) { asm volatile("s_waitcnt vmcnt(0)" ::: "memory"); __syncthreads(); if (threadIdx.x == 0) MISC[17] += (unsigned)__builtin_amdgcn_s_memrealtime() - MISC[16]; }
    PH_BEGIN(P_A0)
        TPS_BEGIN(1) phase_A<0>(a, lane, gw, NGW); TPS_END(1)
        TPS_BEGIN(2) pro1_filter2(a, lds, lane, gw, NGW); TPS_END(2)
        __syncthreads();
    PH_END(P_A0)
    sg_block<0, 0, P_SG0>(a, lds, bar, lo, hi, wave);
    moe_block<0, P_MOE0>(a, lds, bar, lo, hi, wave, gw, NGW);
    PH_BEGIN(P_A1) phase_A<1>(a, lane, gw, NGW); PH_END(P_A1)
    PH_BEGIN(P_HYIN) {
        pg8::Gemm g{(const bf16_t*)(ws + WS_H), (const bf16_t*)(ws + WS_WHYIN), TX, 3072, 1024, nullptr};
        pg8::StaticOrder S; S.init(TX, 3072, G, (int)blockIdx.x);
        pg8::EpiBf16<0> E{(bf16_t*)(ws + WS_BUF1), 3072, a.in[I_HYBIN], 0, 0};
        pg8::gemm_phase<pg8::EpiBf16<0>, pg8::StaticOrder, false>(lds, g, S, E, nullptr, wave);
        SmDense Es{(const bf16_t*)(ws + WS_H), 1024, (const bf16_t*)(ws + WS_WHYIN), 1024, 0, (bf16_t*)(ws + WS_BUF1), 3072, a.in[I_HYBIN], nullptr, nullptr};
        small_gemm(lds, tid, lane, wave, 8 * 48, 48, 1024, Es); } PH_END(P_HYIN)
    PH_BEGIN(P_HYSC) phase_hy_shortconv(a, lds, tid); PH_END(P_HYSC)
    PH_BEGIN(P_HYCONV) phase_hy_conv(a, lds, tid, lane, wave, gw, NGW); __syncthreads(); PH_END(P_HYCONV)
    PH_BEGIN(P_HYTR) phase_hy_transpose(a, lds, lane, wave, gw, NGW); __syncthreads(); PH_END(P_HYTR)
    PH_BEGIN(P_HYOUT) {
        pg8::Gemm g{(const bf16_t*)(ws + WS_H), (const bf16_t*)(ws + WS_WHYOUT), TX, 1024, 1024, nullptr};
        pg8::StaticOrder S; S.init(TX, 1024, G, (int)blockIdx.x);
        pg8::EpiRes E{(float*)(ws + WS_X), a.in[I_HYBOUT], modp(a, 1, 0, 2)};
        pg8::gemm_phase<pg8::EpiRes, pg8::StaticOrder, false>(lds, g, S, E, nullptr, wave);
        SmDense Es{(const bf16_t*)(ws + WS_H), 1024, (const bf16_t*)(ws + WS_WHYOUT), 1024, 2, nullptr, 0, a.in[I_HYBOUT], (float*)(ws + WS_X), modp(a, 1, 2, 2)};
        small_gemm(lds, tid, lane, wave, 8 * 16, 16, 1024, Es); } PH_END(P_HYOUT)
    moe_block<1, P_MOE1>(a, lds, bar, lo, hi, wave, gw, NGW);
    PH_BEGIN(P_A2) phase_A<2>(a, lane, gw, NGW); PH_END(P_A2)
    PH_BEGIN(P_DAIN) {
        pg8::Gemm g{(const bf16_t*)(ws + WS_H), (const bf16_t*)(ws + WS_WDAIN), TX, 3072, 1024, nullptr};
        pg8::StaticOrder S; S.init(TX, 3072, G, (int)blockIdx.x);
        pg8::EpiBf16<0> E{(bf16_t*)(ws + WS_BUF1), 3072, nullptr, 0, 0};
        pg8::gemm_phase<pg8::EpiBf16<0>, pg8::StaticOrder, false>(lds, g, S, E, nullptr, wave);
        SmDense Es{(const bf16_t*)(ws + WS_H), 1024, (const bf16_t*)(ws + WS_WDAIN), 1024, 0, (bf16_t*)(ws + WS_BUF1), 3072, nullptr, nullptr, nullptr};
        small_gemm(lds, tid, lane, wave, 8 * 48, 48, 1024, Es); } PH_END(P_DAIN)
    PH_BEGIN(P_DAPREP) phase_da_prep(a, lds, tid); PH_END(P_DAPREP)
    PH_BEGIN(P_ATTN) phase_attn(a, lds, tid, lane, wave); __syncthreads(); PH_END(P_ATTN)
    PH_BEGIN(P_DAOUT) {
        pg8::Gemm g{(const bf16_t*)(ws + WS_BUF3), (const bf16_t*)(ws + WS_WDAOUT), TX, 1024, 1024, nullptr};
        pg8::StaticOrder S; S.init(TX, 1024, G, (int)blockIdx.x);
        pg8::EpiRes E{(float*)(ws + WS_X), nullptr, modp(a, 2, 0, 2)};
        pg8::gemm_phase<pg8::EpiRes, pg8::StaticOrder, false>(lds, g, S, E, nullptr, wave); } PH_END(P_DAOUT)
    moe_block<2, P_MOE2>(a, lds, bar, lo, hi, wave, gw, NGW);
    PH_BEGIN(P_A3) phase_A<3>(a, lane, gw, NGW); PH_END(P_A3)
    sg_block<3, 1, P_SG3>(a, lds, bar, lo, hi, wave);
    moe_block<3, P_MOE3>(a, lds, bar, lo, hi, wave, gw, NGW);
    PH_BEGIN(P_FINAL) phase_A<4>(a, lane, gw, NGW); PH_END(P_FINAL)
#ifdef TPROBE_MASK
    __syncthreads();
    if (threadIdx.x == 0) { const unsigned long long w = (unsigned long long)MISC[17] * TPROBE_MULT, t0 = __builtin_amdgcn_s_memrealtime(); while (__builtin_amdgcn_s_memrealtime() - t0 < w) __builtin_amdgcn_s_sleep(20); }
#endif
}

extern "C" void kernel_launch(void* const* d_in, const int* in_sizes, int n_in, void* d_out, int out_size, void* d_ws, size_t ws_size, hipStream_t stream) {
    static int grid = 0;
    if (grid == 0) {
        if (n_in != N_IN || out_size != TX * D || ws_size < WS_END) { fprintf(stderr, "kernel_launch: unexpected problem (n_in %d, out %d, ws %zu < %zu)\n", n_in, out_size, ws_size, (size_t)WS_END); grid = -1; return; }
        int dev = 0, cus = 0, per_cu = 0;
        if (hipGetDevice(&dev) != hipSuccess || hipDeviceGetAttribute(&cus, hipDeviceAttributeMultiprocessorCount, dev) != hipSuccess) { grid = -1; return; }
        if (hipFuncSetAttribute((const void*)mk_fwd, hipFuncAttributeMaxDynamicSharedMemorySize, LDS_BYTES) != hipSuccess) { fprintf(stderr, "kernel_launch: hipFuncSetAttribute failed\n"); grid = -1; return; }
        if (hipOccupancyMaxActiveBlocksPerMultiprocessor(&per_cu, (const void*)mk_fwd, NTHR, LDS_BYTES) != hipSuccess || per_cu < 1)
            fprintf(stderr, "kernel_launch: occupancy query reports %d workgroups per CU\n", per_cu);
        (void)hipGetLastError();
        grid = cus;
    }
    if (grid < 0) return;
    if (hipMemsetAsync((char*)d_ws + WS_CTL, 0, CTL_ZERO_BYTES, stream) != hipSuccess) return;
    Args a{};
    for (int i = 0; i < N_IN; ++i) a.in[i] = (const float*)d_in[i];
    a.out = (float*)d_out; a.ws = (unsigned char*)d_ws;
#if MK_LAUNCHES == 1
    a.ph_lo = 0; a.ph_hi = NPHASE;
    hipLaunchKernelGGL(mk_fwd, dim3(grid), dim3(NTHR), LDS_BYTES, stream, a);
#else
    for (int p = 0; p < NPHASE; ++p) { a.ph_lo = p; a.ph_hi = p + 1; hipLaunchKernelGGL(mk_fwd, dim3(grid), dim3(NTHR), LDS_BYTES, stream, a); }
#endif
}
```
